# Optimizing an MI355X kernel written in HIP

```python
import math
import jax, jax.numpy as jnp
from jax import lax
import numpy as np

D_MODEL = 2048
BATCH = 4
SEQ = 2048
DEPTH = 4

EPS = 1e-6
D_FF = 5632
MLA_HEADS = 8
MLA_Q_LORA = 512
MLA_KV_LORA = 512
MLA_NOPE = 128
MLA_ROPE = 64
MLA_V = 128
ROPE_BASE = 10000.0
NSA_HEADS = 8
NSA_KV_HEADS = 2
NSA_GROUP = NSA_HEADS // NSA_KV_HEADS
NSA_DK = 192
NSA_DV = 128
CMP_LEN = 32
CMP_STRIDE = 16
CMP_HIDDEN = 256
SLC_LEN = 64
SLC_TOPN = 16
WINDOW = 512
FORCED_SCORE = 1e6
REL_BUCKETS = 32
REL_MAX_DIST = 128
Q_BLOCK = 128
SLC_Q_BLOCK = 64
NEG = -1e30

IN_SPLITS = [MLA_Q_LORA, MLA_KV_LORA, MLA_ROPE,
             NSA_HEADS * NSA_DK,
             NSA_KV_HEADS * NSA_DK, NSA_KV_HEADS * NSA_DV,
             NSA_KV_HEADS * NSA_DK, NSA_KV_HEADS * NSA_DV,
             NSA_KV_HEADS * NSA_DK, NSA_KV_HEADS * NSA_DV,
             NSA_HEADS * 3, 2 * D_MODEL]
IN_OFFSETS = [int(v) for v in np.cumsum(IN_SPLITS)[:-1]]
D_IN = int(sum(IN_SPLITS))

kernel_name = "hybrid_mla_nsa_macaron_block"


def rmsnorm(x, g):
    x32 = x.astype(jnp.float32)
    y = x32 * lax.rsqrt(jnp.mean(x32 * x32, axis=-1, keepdims=True) + EPS)
    return (y * g.astype(jnp.float32)).astype(x.dtype)


def swiglu_half_step(x, pre_g, post_g, w_gate, w_up, w_down):
    u = rmsnorm(x, pre_g)
    y = (jax.nn.silu(u @ w_gate) * (u @ w_up)) @ w_down
    return x + 0.5 * rmsnorm(y, post_g)


def rope(x, positions):
    d = x.shape[-1]
    half = d // 2
    inv = ROPE_BASE ** (-jnp.arange(half, dtype=jnp.float32) * 2.0 / d)
    ang = positions.astype(jnp.float32)[..., None] * inv
    cos = jnp.cos(ang)[:, :, None, :]
    sin = jnp.sin(ang)[:, :, None, :]
    x32 = x.astype(jnp.float32)
    x1, x2 = x32[..., :half], x32[..., half:]
    return jnp.concatenate([x1 * cos - x2 * sin, x1 * sin + x2 * cos], axis=-1).astype(x.dtype)


def rel_bucket(dist):
    n = jnp.maximum(dist, 0)
    max_exact = REL_BUCKETS // 2
    large = max_exact + (jnp.log(jnp.maximum(n, 1).astype(jnp.float32) / max_exact)
                         / math.log(REL_MAX_DIST / max_exact)
                         * (REL_BUCKETS - max_exact)).astype(jnp.int32)
    large = jnp.minimum(large, REL_BUCKETS - 1)
    return jnp.where(n < max_exact, n, large).astype(jnp.int32)


def mla_mixer(c_q, c_kv, k_rope, positions, q_norm_g, w_q_up, kv_norm_g, w_uk, w_uv):
    B, S, _ = c_q.shape
    H = MLA_HEADS
    q = (rmsnorm(c_q, q_norm_g) @ w_q_up).reshape(B, S, H, MLA_NOPE + MLA_ROPE)
    q = jnp.concatenate([q[..., :MLA_NOPE], rope(q[..., MLA_NOPE:], positions)], axis=-1)
    ckv = rmsnorm(c_kv, kv_norm_g)
    k_nope = (ckv @ w_uk).reshape(B, S, H, MLA_NOPE)
    v = (ckv @ w_uv).reshape(B, S, H, MLA_V)
    k_pe = rope(k_rope[:, :, None, :], positions)
    k = jnp.concatenate([k_nope, jnp.broadcast_to(k_pe, (B, S, H, MLA_ROPE))], axis=-1)
    scale = (MLA_NOPE + MLA_ROPE) ** -0.5
    n_blk = S // Q_BLOCK
    q_blocks = q.reshape(B, n_blk, Q_BLOCK, H, -1).transpose(1, 0, 2, 3, 4)
    kpos = jnp.arange(S)

    def block(args):
        qi, i = args
        tq = i * Q_BLOCK + jnp.arange(Q_BLOCK)
        s = jnp.einsum('bqhd,bkhd->bhqk', qi, k).astype(jnp.float32) * scale
        s = jnp.where(kpos[None, :] <= tq[:, None], s, NEG)
        p = jax.nn.softmax(s, axis=-1).astype(v.dtype)
        return jnp.einsum('bhqk,bkhd->bqhd', p, v)

    out = lax.map(block, (q_blocks, jnp.arange(n_blk, dtype=jnp.int32)))
    return out.transpose(1, 0, 2, 3, 4).reshape(B, S, H * MLA_V)


def nsa_mixer(q, k_c, v_c, k_s, v_s, k_w, v_w, gate_logits, positions, rel_bias,
              pe_k, w1_k, w2_k, pe_v, w1_v, w2_v):
    B, S, _ = q.shape
    G, J = NSA_KV_HEADS, NSA_GROUP
    scale = NSA_DK ** -0.5
    q = q.reshape(B, S, G, J, NSA_DK)
    k_c = k_c.reshape(B, S, G, NSA_DK)
    v_c = v_c.reshape(B, S, G, NSA_DV)
    k_s = k_s.reshape(B, S, G, NSA_DK)
    v_s = v_s.reshape(B, S, G, NSA_DV)
    k_w = k_w.reshape(B, S, G, NSA_DK)
    v_w = v_w.reshape(B, S, G, NSA_DV)
    t = jnp.arange(S)

    n_cmp = (S - CMP_LEN) // CMP_STRIDE + 1
    idx = np.arange(n_cmp)[:, None] * CMP_STRIDE + np.arange(CMP_LEN)[None, :]

    def compress(z, pe, w1, w2):
        zb = z[:, idx] + pe[None, None, :, None, :]
        zb = zb.transpose(0, 1, 3, 2, 4).reshape(B, n_cmp, G, -1)
        return jax.nn.silu(zb @ w1) @ w2

    kc = compress(k_c, pe_k, w1_k, w2_k)
    vc = compress(v_c, pe_v, w1_v, w2_v)
    ends = jnp.asarray(idx[:, -1])
    mask_c = ends[None, :] <= t[:, None]
    dist_c = positions[:, :, None] - positions[:, ends][:, None, :]
    bias_c = rel_bias[rel_bucket(dist_c)].astype(jnp.float32)
    bias_c = bias_c.reshape(B, S, n_cmp, G, J).transpose(0, 3, 4, 1, 2)
    s_c = jnp.einsum('bsgjd,bngd->bgjsn', q, kc).astype(jnp.float32) * scale + bias_c
    p_c = jnp.where(mask_c, jax.nn.softmax(jnp.where(mask_c, s_c, NEG), axis=-1), 0.0)
    o_cmp = jnp.einsum('bgjsn,bngd->bsgjd', p_c.astype(vc.dtype), vc)

    n_slc = S // SLC_LEN
    cs = np.arange(n_cmp) * CMP_STRIDE
    ce = cs + CMP_LEN - 1
    bs = np.arange(n_slc) * SLC_LEN
    be = bs + SLC_LEN - 1
    overlap = ((cs[:, None] <= be[None, :]) & (ce[:, None] >= bs[None, :])).astype(np.float32)
    imp = jnp.einsum('bgjsn,nm->bgsm', p_c, jnp.asarray(overlap))
    cur = t // SLC_LEN
    jb = jnp.arange(n_slc)
    valid = jb[None, :] <= cur[:, None]
    forced = valid & ((jb[None, :] == 0) | (jb[None, :] >= cur[:, None] - 1))
    score = jnp.where(forced, FORCED_SCORE, jnp.where(valid, imp, -1.0))
    topn = min(SLC_TOPN, n_slc)
    vals, sel = lax.top_k(score, topn)
    sel_ok = vals >= 0.0

    k_blk = k_s.reshape(B, n_slc, SLC_LEN, G, NSA_DK).transpose(0, 3, 1, 2, 4)
    v_blk = v_s.reshape(B, n_slc, SLC_LEN, G, NSA_DV).transpose(0, 3, 1, 2, 4)
    nq = S // SLC_Q_BLOCK
    q_ch = q.reshape(B, nq, SLC_Q_BLOCK, G, J, NSA_DK).transpose(1, 0, 2, 3, 4, 5)
    sel_ch = sel.reshape(B, G, nq, SLC_Q_BLOCK, topn).transpose(2, 0, 1, 3, 4)
    ok_ch = sel_ok.reshape(B, G, nq, SLC_Q_BLOCK, topn).transpose(2, 0, 1, 3, 4)
    table_g = rel_bias.reshape(REL_BUCKETS, G, J)
    g_idx = jnp.arange(G).reshape(1, G, 1, 1, 1)
    gather = jax.vmap(jax.vmap(lambda blocks, ix: blocks[ix]))
    pos_gather = jax.vmap(lambda p, k: p[k])

    def slc_block(args):
        qi, si, oki, i = args
        tq = i * SLC_Q_BLOCK + jnp.arange(SLC_Q_BLOCK)
        ks = gather(k_blk, si)
        vs = gather(v_blk, si)
        kpos = si[..., None] * SLC_LEN + jnp.arange(SLC_LEN)
        mask = oki[..., None] & (kpos <= tq[None, None, :, None, None])
        qpos = lax.dynamic_slice_in_dim(positions, i * SLC_Q_BLOCK, SLC_Q_BLOCK, axis=1)
        kp = pos_gather(positions, kpos)
        bias = table_g[rel_bucket(qpos[:, None, :, None, None] - kp), g_idx]
        bias = jnp.moveaxis(bias, -1, 2).astype(jnp.float32)
        s = jnp.einsum('bqgjd,bgqnrd->bgjqnr', qi, ks).astype(jnp.float32) * scale + bias
        s = jnp.where(mask[:, :, None], s, NEG)
        shp = s.shape
        p = jax.nn.softmax(s.reshape(shp[:4] + (-1,)), axis=-1).reshape(shp)
        return jnp.einsum('bgjqnr,bgqnrd->bqgjd', p.astype(vs.dtype), vs)

    o_slc = lax.map(slc_block, (q_ch, sel_ch, ok_ch, jnp.arange(nq, dtype=jnp.int32)))
    o_slc = o_slc.transpose(1, 0, 2, 3, 4, 5).reshape(B, S, G, J, NSA_DV)

    span = WINDOW + Q_BLOCK
    kp_w = jnp.pad(k_w, ((0, 0), (WINDOW, 0), (0, 0), (0, 0)))
    vp_w = jnp.pad(v_w, ((0, 0), (WINDOW, 0), (0, 0), (0, 0)))
    pos_p = jnp.pad(positions, ((0, 0), (WINDOW, 0)))
    nb = S // Q_BLOCK
    q_wb = q.reshape(B, nb, Q_BLOCK, G, J, NSA_DK).transpose(1, 0, 2, 3, 4, 5)

    def win_block(args):
        qi, i = args
        s0 = i * Q_BLOCK
        kw = lax.dynamic_slice_in_dim(kp_w, s0, span, axis=1)
        vw = lax.dynamic_slice_in_dim(vp_w, s0, span, axis=1)
        pw = lax.dynamic_slice_in_dim(pos_p, s0, span, axis=1)
        kidx = s0 - WINDOW + jnp.arange(span)
        tq = s0 + jnp.arange(Q_BLOCK)
        diff = tq[:, None] - kidx[None, :]
        mask = (diff >= 0) & (diff < WINDOW) & (kidx >= 0)[None, :]
        qpos = lax.dynamic_slice_in_dim(positions, s0, Q_BLOCK, axis=1)
        bias = rel_bias[rel_bucket(qpos[:, :, None] - pw[:, None, :])].astype(jnp.float32)
        bias = bias.reshape(B, Q_BLOCK, span, G, J).transpose(0, 3, 4, 1, 2)
        s = jnp.einsum('bqgjd,bkgd->bgjqk', qi, kw).astype(jnp.float32) * scale + bias
        p = jax.nn.softmax(jnp.where(mask, s, NEG), axis=-1)
        return jnp.einsum('bgjqk,bkgd->bqgjd', p.astype(vw.dtype), vw)

    o_win = lax.map(win_block, (q_wb, jnp.arange(nb, dtype=jnp.int32)))
    o_win = o_win.transpose(1, 0, 2, 3, 4, 5).reshape(B, S, G, J, NSA_DV)

    g = jax.nn.sigmoid(gate_logits.astype(jnp.float32)).reshape(B, S, G, J, 3).astype(q.dtype)
    o = g[..., 0:1] * o_cmp + g[..., 1:2] * o_slc + g[..., 2:3] * o_win
    return o.reshape(B, S, NSA_HEADS * NSA_DV)


def setup_inputs(seed: int = 0) -> dict:
    key = jax.random.key(seed)
    ks = iter(jax.random.split(key, 40))
    f32 = jnp.float32

    def dense(shape, fan_in):
        return jax.random.normal(next(ks), shape, f32) * (fan_in ** -0.5)

    def gain(n):
        return 1.0 + 0.05 * jax.random.normal(next(ks), (DEPTH, n), f32)

    x = jax.random.normal(next(ks), (BATCH, SEQ, D_MODEL), f32)
    offs = jax.random.randint(next(ks), (BATCH, 1), 0, 4096, dtype=jnp.int32)
    positions = offs + jnp.arange(SEQ, dtype=jnp.int32)[None, :]
    rel_bias = 0.5 * jax.random.normal(next(ks), (REL_BUCKETS, NSA_HEADS), f32)
    inp = {"x": x, "positions": positions, "rel_bias": rel_bias}
    inp["ffn1_pre_g"] = gain(D_MODEL)
    inp["ffn1_post_g"] = gain(D_MODEL)
    inp["ffn1_w_gate"] = dense((DEPTH, D_MODEL, D_FF), D_MODEL)
    inp["ffn1_w_up"] = dense((DEPTH, D_MODEL, D_FF), D_MODEL)
    inp["ffn1_w_down"] = dense((DEPTH, D_FF, D_MODEL), D_FF)
    inp["mix_pre_g"] = gain(D_MODEL)
    inp["mix_post_g"] = gain(D_MODEL)
    inp["w_in"] = dense((DEPTH, D_MODEL, D_IN), D_MODEL)
    inp["mla_q_norm_g"] = gain(MLA_Q_LORA)
    inp["mla_w_q_up"] = dense((DEPTH, MLA_Q_LORA, MLA_HEADS * (MLA_NOPE + MLA_ROPE)), MLA_Q_LORA)
    inp["mla_kv_norm_g"] = gain(MLA_KV_LORA)
    inp["mla_w_uk"] = dense((DEPTH, MLA_KV_LORA, MLA_HEADS * MLA_NOPE), MLA_KV_LORA)
    inp["mla_w_uv"] = dense((DEPTH, MLA_KV_LORA, MLA_HEADS * MLA_V), MLA_KV_LORA)
    inp["cmp_pe_k"] = 0.1 * jax.random.normal(next(ks), (DEPTH, CMP_LEN, NSA_DK), f32)
    inp["cmp_w1_k"] = dense((DEPTH, CMP_LEN * NSA_DK, CMP_HIDDEN), CMP_LEN * NSA_DK)
    inp["cmp_w2_k"] = dense((DEPTH, CMP_HIDDEN, NSA_DK), CMP_HIDDEN)
    inp["cmp_pe_v"] = 0.1 * jax.random.normal(next(ks), (DEPTH, CMP_LEN, NSA_DV), f32)
    inp["cmp_w1_v"] = dense((DEPTH, CMP_LEN * NSA_DV, CMP_HIDDEN), CMP_LEN * NSA_DV)
    inp["cmp_w2_v"] = dense((DEPTH, CMP_HIDDEN, NSA_DV), CMP_HIDDEN)
    inp["w_branch_mla"] = dense((DEPTH, MLA_HEADS * MLA_V, D_MODEL), MLA_HEADS * MLA_V)
    inp["w_branch_nsa"] = dense((DEPTH, NSA_HEADS * NSA_DV, D_MODEL), NSA_HEADS * NSA_DV)
    inp["w_out"] = dense((DEPTH, D_MODEL, D_MODEL), D_MODEL)
    inp["ffn2_pre_g"] = gain(D_MODEL)
    inp["ffn2_post_g"] = gain(D_MODEL)
    inp["ffn2_w_gate"] = dense((DEPTH, D_MODEL, D_FF), D_MODEL)
    inp["ffn2_w_up"] = dense((DEPTH, D_MODEL, D_FF), D_MODEL)
    inp["ffn2_w_down"] = dense((DEPTH, D_FF, D_MODEL), D_FF)
    return inp


def reference(x, positions, rel_bias,
              ffn1_pre_g, ffn1_post_g, ffn1_w_gate, ffn1_w_up, ffn1_w_down,
              mix_pre_g, mix_post_g, w_in,
              mla_q_norm_g, mla_w_q_up, mla_kv_norm_g, mla_w_uk, mla_w_uv,
              cmp_pe_k, cmp_w1_k, cmp_w2_k, cmp_pe_v, cmp_w1_v, cmp_w2_v,
              w_branch_mla, w_branch_nsa, w_out,
              ffn2_pre_g, ffn2_post_g, ffn2_w_gate, ffn2_w_up, ffn2_w_down):
    for l in range(DEPTH):
        h = swiglu_half_step(x, ffn1_pre_g[l], ffn1_post_g[l], ffn1_w_gate[l], ffn1_w_up[l], ffn1_w_down[l])
        u = rmsnorm(h, mix_pre_g[l])
        z = u @ w_in[l]
        (c_q, c_kv, k_rope, nsa_q, k_c, v_c, k_s, v_s, k_w, v_w,
         nsa_g, merge_g) = jnp.split(z, IN_OFFSETS, axis=-1)
        a = mla_mixer(c_q, c_kv, k_rope, positions, mla_q_norm_g[l], mla_w_q_up[l],
                      mla_kv_norm_g[l], mla_w_uk[l], mla_w_uv[l])
        b = nsa_mixer(nsa_q, k_c, v_c, k_s, v_s, k_w, v_w, nsa_g, positions, rel_bias,
                      cmp_pe_k[l], cmp_w1_k[l], cmp_w2_k[l], cmp_pe_v[l], cmp_w1_v[l], cmp_w2_v[l])
        gates = jax.nn.sigmoid(merge_g.astype(jnp.float32)).astype(h.dtype)
        m = gates[..., :D_MODEL] * (a @ w_branch_mla[l]) + gates[..., D_MODEL:] * (b @ w_branch_nsa[l])
        h = h + rmsnorm(m @ w_out[l], mix_post_g[l])
        x = swiglu_half_step(h, ffn2_pre_g[l], ffn2_post_g[l], ffn2_w_gate[l], ffn2_w_up[l], ffn2_w_down[l])
    return x
```

```cpp
#include <hip/hip_runtime.h>
#include <cstdio>
#include <cstdint>

#ifndef MK_PER_PHASE
#define MK_PER_PHASE 0
#endif

#define GAS __attribute__((address_space(1)))
#define LAS __attribute__((address_space(3)))
typedef unsigned short bf16_t;
typedef short bf16x8 __attribute__((ext_vector_type(8)));
typedef float f32x4 __attribute__((ext_vector_type(4)));
typedef float f32x2 __attribute__((ext_vector_type(2)));
typedef unsigned u32x4 __attribute__((ext_vector_type(4)));
typedef unsigned u32x2 __attribute__((ext_vector_type(2)));
typedef __bf16 bf16x2_t __attribute__((ext_vector_type(2)));

constexpr int NB = 4, SEQ = 2048, M = NB * SEQ, D = 2048, NL = 4, FF = 5632;
constexpr int DIN = 8664, DINP = 8704;
constexpr int ZO_CQ = 0, ZO_CKV = 512, ZO_KR = 1024, ZO_NQ = 1088, ZO_KC = 2624, ZO_VC = 3008, ZO_KS = 3264, ZO_VS = 3648, ZO_KW = 3904, ZO_VW = 4288, ZO_NG = 4544, ZO_GA = 4568, ZO_GB = 6616;
constexpr float EPS = 1e-6f;
constexpr int NCMP = 127;

constexpr size_t MiB = 1u << 20;
constexpr size_t alup(size_t x) { return (x + MiB - 1) / MiB * MiB; }
constexpr size_t WS_CTL = 0, CTL_ZERO_BYTES = 1 * MiB;
constexpr size_t WS_TBL = WS_CTL + CTL_ZERO_BYTES;
constexpr size_t WS_ROPE = WS_TBL + MiB;
constexpr size_t WS_X = WS_ROPE + alup((size_t)M * 32 * 8);
constexpr size_t WS_U = WS_X + alup((size_t)M * D * 4);
constexpr size_t WS_H = WS_U + alup((size_t)M * D * 2);
constexpr size_t WS_Y = WS_H + alup((size_t)M * FF * 2);
constexpr size_t WS_Z = WS_Y + alup((size_t)M * D * 2);
constexpr size_t WS_CQKV = WS_Z + alup((size_t)(M + 64) * DINP * 2);
constexpr size_t WS_KPE = WS_CQKV + alup((size_t)M * 1024 * 2);
constexpr size_t WS_QM = WS_KPE + alup((size_t)M * 64 * 2);
constexpr size_t WS_KV = WS_QM + alup((size_t)M * 1536 * 2);
constexpr size_t WS_AB = WS_KV + alup((size_t)M * 2048 * 2);
constexpr size_t WS_MG = WS_AB + alup((size_t)M * 2048 * 2);
constexpr size_t WS_OC = WS_MG + alup((size_t)M * 2048 * 2);
constexpr size_t WS_PART = WS_OC + alup((size_t)M * 1024 * 4);
constexpr size_t WS_KC = WS_PART + alup((size_t)64 * 256 * 256 * 4);
constexpr size_t WS_SEL = WS_KC + MiB;
constexpr size_t WS_W = WS_SEL + MiB;
constexpr size_t WO_GU1 = 0, WO_D1 = WO_GU1 + (size_t)2 * FF * D, WO_GU2 = WO_D1 + (size_t)D * FF, WO_D2 = WO_GU2 + (size_t)2 * FF * D,
                 WO_IN = WO_D2 + (size_t)D * FF, WO_Q = WO_IN + (size_t)DINP * D, WO_UKV = WO_Q + (size_t)1536 * 512, WO_1K = WO_UKV + (size_t)2048 * 512,
                 WO_1V = WO_1K + (size_t)256 * 6144, WO_AB = WO_1V + (size_t)256 * 4096, WO_OUT = WO_AB + (size_t)2048 * 2048, WO_END = WO_OUT + (size_t)2048 * 2048;
constexpr size_t WS_END = WS_W + alup(WO_END * 2 * NL);
constexpr int CW_BAR = 4096;

constexpr int RING_BYTES = 131072, MISC_OFF = RING_BYTES + 320, LDS_BYTES = 147456;

#define RLX_AGENT __ATOMIC_RELAXED, __HIP_MEMORY_SCOPE_AGENT
__device__ __forceinline__ unsigned cvtpk(float lo, float hi) { f32x2 v = {lo, hi}; bf16x2_t b = __builtin_convertvector(v, bf16x2_t); return __builtin_bit_cast(unsigned, b); }
__device__ __forceinline__ float bflo(unsigned u) { return __uint_as_float(u << 16); }
__device__ __forceinline__ float bfhi(unsigned u) { return __uint_as_float(u & 0xffff0000u); }
__device__ __forceinline__ float bf1(bf16_t h) { return __uint_as_float((unsigned)h << 16); }
__device__ __forceinline__ float wave_sum(float v) {
#pragma unroll
    for (int o = 1; o < 64; o <<= 1) v += __shfl_xor(v, o);
    return v;
}
__device__ __forceinline__ float wave_max(float v) {
#pragma unroll
    for (int o = 1; o < 64; o <<= 1) v = fmaxf(v, __shfl_xor(v, o));
    return v;
}
__device__ __forceinline__ float sigmoidf_(float x) { return 1.0f / (1.0f + __expf(-x)); }

__device__ const float ROPE_INV[32] = {
    1.000000000e+00f, 7.498942614e-01f, 5.623413324e-01f, 4.216965139e-01f, 3.162277639e-01f, 2.371373773e-01f, 1.778279394e-01f, 1.333521307e-01f,
    1.000000015e-01f, 7.498941571e-02f, 5.623413250e-02f, 4.216965288e-02f, 3.162277490e-02f, 2.371373773e-02f, 1.778279431e-02f, 1.333521493e-02f,
    9.999999776e-03f, 7.498941850e-03f, 5.623413250e-03f, 4.216964822e-03f, 3.162277630e-03f, 2.371373586e-03f, 1.778279431e-03f, 1.333521446e-03f,
    1.000000047e-03f, 7.498942432e-04f, 5.623413017e-04f, 4.216965172e-04f, 3.162277571e-04f, 2.371373703e-04f, 1.778279402e-04f, 1.333521504e-04f};
__device__ const unsigned char REL_BUCKET[129] = {
    0, 1, 2, 3, 4, 5, 6, 7, 8, 9, 10, 11, 12, 13, 14, 15, 16, 16, 16, 17, 17, 18, 18, 18, 19, 19, 19, 20, 20, 20, 20, 21, 21, 21, 21, 22, 22, 22, 22, 22, 23, 23, 23, 23, 23, 23, 24, 24, 24, 24, 24, 24,
    25, 25, 25, 25, 25, 25, 25, 26, 26, 26, 26, 26, 26, 26, 26, 27, 27, 27, 27, 27, 27, 27, 27, 27, 27, 28, 28, 28, 28, 28, 28, 28, 28, 28, 28, 29, 29, 29, 29, 29, 29, 29, 29, 29, 29, 29, 29,
    30, 30, 30, 30, 30, 30, 30, 30, 30, 30, 30, 30, 30, 30, 31, 31, 31, 31, 31, 31, 31, 31, 31, 31, 31, 31, 31, 31, 31, 31};

#define XB_TMO      128
#define XB_XCNT(j)  (256  + 64 * (j))
#define XB_XSUB(j)  (1280 + 64 * (j))
#define XB_XGEN(j)  (2304 + 64 * (j))
#define XB_TOP      3328
#define XB_TOPGEN   3392
#define XCD_BAR_WORDS 3456
#define XB_SPIN_CAP (1u << 18)
__device__ __forceinline__ unsigned xb_ld(unsigned* p)              { return __hip_atomic_load(p, __ATOMIC_RELAXED, __HIP_MEMORY_SCOPE_AGENT); }
__device__ __forceinline__ unsigned xb_add(unsigned* p, unsigned v) { return __hip_atomic_fetch_add(p, v, __ATOMIC_RELAXED, __HIP_MEMORY_SCOPE_AGENT); }
__device__ __forceinline__ unsigned xb_xcc_id() { return (unsigned)__builtin_amdgcn_s_getreg((3 << 11) | 20) & 0xFu; }
#define XB_SPIN(cond, bar) do { unsigned _sp = 0; while (cond) { __builtin_amdgcn_s_sleep(1); \
    if ((++_sp & 255u) == 0u) { if (xb_ld(&(bar)[XB_TMO])) break; if (_sp > XB_SPIN_CAP) { atomicAdd(&(bar)[XB_TMO], 1u); break; } } } } while (0)
struct XcdBarrier { unsigned* bar; unsigned x; volatile LAS unsigned* st; };
__device__ __forceinline__ XcdBarrier xcd_barrier_post(unsigned* bar, volatile LAS unsigned* st) {
    XcdBarrier b; b.bar = bar; b.x = xb_xcc_id(); b.st = st;
    if (threadIdx.x == 0) (void)xb_add(&bar[XB_XCNT(b.x)], 1u);
    return b;
}
__device__ __forceinline__ void xcd_barrier_complete(unsigned* bar, unsigned x, unsigned& nloc, unsigned& nx) {
    const unsigned G = gridDim.x * gridDim.y * gridDim.z;
    unsigned sum, cnt, mine, sp = 0u;
    for (;;) {
        sum = 0u; cnt = 0u; mine = 0u;
#pragma unroll
        for (unsigned j = 0; j < 16; ++j) { const unsigned c = xb_ld(&bar[XB_XCNT(j)]); sum += c; cnt += (c > 0u) ? 1u : 0u; mine = (j == x) ? c : mine; }
        if (sum == G) break;
        __builtin_amdgcn_s_sleep(1);
        if ((++sp & 255u) == 0u) { if (xb_ld(&bar[XB_TMO])) break; if (sp > XB_SPIN_CAP) { atomicAdd(&bar[XB_TMO], 1u); break; } }
    }
    nloc = mine > 0u ? mine : 1u; nx = cnt > 0u ? cnt : 1u;
}
__device__ __forceinline__ void xcd_barrier(const XcdBarrier& b) {
    asm volatile("s_waitcnt vmcnt(0)" ::: "memory");
    __syncthreads();
    if (threadIdx.x == 0) {
        unsigned* bar = b.bar;
        __builtin_amdgcn_s_waitcnt(0);
        unsigned nloc = b.st[0], nx = b.st[1];
        if (nloc == 0u) { xcd_barrier_complete(bar, b.x, nloc, nx); b.st[0] = nloc; b.st[1] = nx; }
        const unsigned old = xb_add(&bar[XB_XSUB(b.x)], 1u);
        const unsigned gen = old / nloc;
        if (old + 1u == (gen + 1u) * nloc) {
            __builtin_amdgcn_fence(__ATOMIC_RELEASE, "agent");
            asm volatile("s_waitcnt vmcnt(0)" ::: "memory");
            const unsigned og = xb_add(&bar[XB_TOP], 1u);
            const unsigned tg = og / nx;
            if (og + 1u == (tg + 1u) * nx) xb_add(&bar[XB_TOPGEN], 1u);
            else XB_SPIN(xb_ld(&bar[XB_TOPGEN]) == tg, bar);
            __builtin_amdgcn_fence(__ATOMIC_ACQUIRE, "agent");
            xb_add(&bar[XB_XGEN(b.x)], 1u);
            asm volatile("s_waitcnt vmcnt(0)" ::: "memory");
        } else {
            XB_SPIN(xb_ld(&bar[XB_XGEN(b.x)]) == gen, bar);
            __builtin_amdgcn_fence(__ATOMIC_ACQUIRE, "agent");
            asm volatile("s_waitcnt vmcnt(0)" ::: "memory");
        }
    }
    __syncthreads();
}

namespace pg8 {
constexpr int BM = 256, BK = 64, HALF = 128, HTB = HALF * BK * 2, STAGE_BYTES = 8 * HTB, NXCD = 8, WGM = 8;
__host__ __device__ __forceinline__ int lds_byte(int r, int c) { const int st = (r >> 4) * 2 + (c >> 5), rr = r & 15, cc = c & 31, ob = rr * 64 + cc * 2; return st * 1024 + (ob ^ (((ob >> 9) & 1) << 5)); }
__host__ __device__ __forceinline__ void stage_rc(int b, int& R, int& C) { const int st = b / 1024, sb = b % 1024, swz = sb ^ (((sb >> 9) & 1) << 5); R = (st >> 1) * 16 + swz / 64; C = (st & 1) * 32 + (swz % 64) / 2; }
__host__ __device__ __forceinline__ int perm32(int rho) { const int n = rho >> 4, i = rho & 15; return 8 * (i >> 2) + 4 * n + (i & 3); }

struct Unit { const char* a; const char* b; int pm, pn, aux; };
struct Gemm { int lda, ldb, nt; size_t gstride; };

struct StaticOrder {
    int nM, nN, nwg, G, c;
    __device__ void init(int M_, int N_, int G_, int c_) { nM = M_ / BM; nN = N_ / BM; nwg = nM * nN; G = G_; c = c_; }
    __device__ bool next(int i, int& pm, int& pn) const {
        const long L = (long)i * G + c; if (L >= nwg) return false;
        int wgid = (int)L; { const int q = nwg / NXCD, r = nwg % NXCD, xcd = wgid % NXCD, off = wgid / NXCD; wgid = (xcd < r ? xcd * (q + 1) : r * (q + 1) + (xcd - r) * q) + off; }
        const int nig = WGM * nN, gid = wgid / nig, fm = gid * WGM, gsz = (nM - fm) < WGM ? (nM - fm) : WGM;
        pm = fm + ((wgid % nig) % gsz); pn = (wgid % nig) / gsz; return true;
    }
};

template <class Epi, class Sched, int KGRP>
__device__ __forceinline__ void gemm_phase(LAS unsigned char* lds, const Gemm g, const Sched& S, const Epi& E) {
    int tid_ = threadIdx.x; asm volatile("" : "+v"(tid_));
    const int tid = tid_, wid = __builtin_amdgcn_readfirstlane(tid >> 6), lane = tid & 63, wr = wid >> 2, wc = wid & 3, fr = lane & 15, fq = lane >> 4;
    const int nt = g.nt;
    unsigned voffA[2], voffB[2];
#pragma unroll
    for (int i = 0; i < 2; ++i) { int R, C; stage_rc(tid * 16 + i * 8192, R, C); const int Rb = (R & ~31) + perm32(R & 31);
        voffA[i] = (unsigned)(R * g.lda + C) * 2u; voffB[i] = (unsigned)(Rb * g.ldb + C) * 2u; }
    const size_t kstep = (size_t)(BK * 2);
    const size_t hstepA = (size_t)HALF * g.lda * 2, hstepB = (size_t)HALF * g.ldb * 2;
    const unsigned ldsw = (unsigned)wid * 1024u;
    const int aoff = lds_byte(wr * 64 + fr, fq * 8), boff = lds_byte(wc * 32 + fr, fq * 8);
    auto koffA = [&](int t) -> size_t { if constexpr (KGRP > 0) return (size_t)(t / KGRP) * g.gstride + (size_t)(t % KGRP) * kstep; else return (size_t)t * kstep; };
#define PG8_SA(b, h) (((b) * 2 + (h)) * HTB)
#define PG8_SB(b, h) ((4 + (b) * 2 + (h)) * HTB)
#define PG8_STAGE(bufoff, gbase, voff) do { _Pragma("unroll") for (int _i = 0; _i < 2; ++_i) \
        __builtin_amdgcn_global_load_lds((const unsigned*)((const char*)(gbase) + (voff)[_i]), (LAS unsigned*)(lds + (bufoff) + ldsw + _i * 8192), 16, 0, 0); } while (0)
#define PG8_LDA(dst, b, h) do { _Pragma("unroll") for (int m = 0; m < 4; ++m) _Pragma("unroll") for (int k = 0; k < 2; ++k) dst[m][k] = *(const LAS bf16x8*)(lds + PG8_SA(b, h) + aoff + m * 2048 + k * 1024); } while (0)
#define PG8_LDB(dst, b, h) do { _Pragma("unroll") for (int n = 0; n < 2; ++n) _Pragma("unroll") for (int k = 0; k < 2; ++k) dst[n][k] = *(const LAS bf16x8*)(lds + PG8_SB(b, h) + boff + n * 2048 + k * 1024); } while (0)
#define PG8_MMA(ai, bj, At, Bt) do { __builtin_amdgcn_s_setprio(1); _Pragma("unroll") for (int m = 0; m < 4; ++m) _Pragma("unroll") for (int n = 0; n < 2; ++n) _Pragma("unroll") for (int k = 0; k < 2; ++k) \
        acc[ai][bj][m][n] = __builtin_amdgcn_mfma_f32_16x16x32_bf16(Bt[n][k], At[m][k], acc[ai][bj][m][n], 0, 0, 0); __builtin_amdgcn_s_setprio(0); } while (0)
#define PG8_WAIT_V(n) asm volatile("s_waitcnt vmcnt(" #n ")" ::: "memory")
#define PG8_WAIT_L(n) asm volatile("s_waitcnt lgkmcnt(" #n ")" ::: "memory")
#define PG8_BAR __builtin_amdgcn_s_barrier()
#define PG8_SCHED __builtin_amdgcn_sched_barrier(0)
    Unit cur, nxt; int ui = 0;
    if (!S.next(0, cur)) return;
    f32x4 acc[2][2][4][2];
#pragma unroll
    for (int a = 0; a < 2; ++a)
#pragma unroll
        for (int b = 0; b < 2; ++b)
#pragma unroll
            for (int m = 0; m < 4; ++m)
#pragma unroll
                for (int n = 0; n < 2; ++n) acc[a][b][m][n] = (f32x4){0.f, 0.f, 0.f, 0.f};
    bf16x8 At[4][2], B0[2][2], B1[2][2];
    const char* cA = cur.a; const char* cB = cur.b;
    PG8_STAGE(PG8_SB(0, 0), cB, voffB); PG8_STAGE(PG8_SB(0, 1), cB + hstepB, voffB); PG8_STAGE(PG8_SA(0, 0), cA, voffA); PG8_STAGE(PG8_SA(0, 1), cA + hstepA, voffA);
    if (wr == 1) PG8_BAR;
    PG8_WAIT_V(2); PG8_BAR;
    { const char* a1p = cA + koffA(1);
      PG8_STAGE(PG8_SB(1, 0), cB + kstep, voffB); PG8_STAGE(PG8_SA(1, 0), a1p, voffA); PG8_STAGE(PG8_SB(1, 1), cB + hstepB + kstep, voffB); }
    PG8_WAIT_V(6); PG8_BAR;
    for (;;) {
        const bool has_next = S.next(ui + 1, nxt);
        const char* nA = has_next ? nxt.a : cA; const char* nB = has_next ? nxt.b : cB;
        for (int t = 0; t < nt; t += 2) {
            const bool last = (t == nt - 2);
            const char* a1 = cA + koffA(t + 1);
            const char* a2 = last ? nA : cA + koffA(t + 2); const char* b2 = last ? nB : cB + (size_t)(t + 2) * kstep;
            const char* a3 = last ? nA + koffA(1) : cA + koffA(t + 3); const char* b3 = b2 + kstep;
            PG8_LDB(B0, 0, 0); PG8_LDB(B1, 0, 1); PG8_SCHED; PG8_LDA(At, 0, 0); PG8_STAGE(PG8_SA(1, 1), a1 + hstepA, voffA);
            PG8_WAIT_V(8); PG8_WAIT_L(0); PG8_BAR; PG8_MMA(0, 0, At, B0); PG8_MMA(0, 1, At, B1); PG8_BAR; PG8_SCHED;
            PG8_LDA(At, 0, 1); PG8_STAGE(PG8_SB(0, 0), b2, voffB); PG8_STAGE(PG8_SB(0, 1), b2 + hstepB, voffB); PG8_STAGE(PG8_SA(0, 0), a2, voffA);
            PG8_WAIT_V(8); PG8_WAIT_L(0); PG8_BAR; PG8_MMA(1, 0, At, B0); PG8_MMA(1, 1, At, B1); PG8_BAR; PG8_SCHED;
            PG8_LDB(B0, 1, 0); PG8_LDB(B1, 1, 1); PG8_SCHED; PG8_LDA(At, 1, 0); PG8_STAGE(PG8_SA(0, 1), a2 + hstepA, voffA);
            PG8_WAIT_V(8); PG8_WAIT_L(0); PG8_BAR; PG8_MMA(0, 0, At, B0); PG8_MMA(0, 1, At, B1); PG8_BAR; PG8_SCHED;
            PG8_LDA(At, 1, 1); PG8_STAGE(PG8_SB(1, 0), b3, voffB); PG8_STAGE(PG8_SB(1, 1), b3 + hstepB, voffB); PG8_STAGE(PG8_SA(1, 0), a3, voffA);
            PG8_WAIT_V(8); PG8_WAIT_L(0); PG8_BAR; PG8_MMA(1, 0, At, B0); PG8_MMA(1, 1, At, B1); PG8_BAR; PG8_SCHED;
        }
        if (wr == 0) PG8_BAR;
        const bool keep = E(acc, cur, wr, wc, fr, fq);
        if (!has_next) break;
        if (!keep) {
#pragma unroll
            for (int a = 0; a < 2; ++a)
#pragma unroll
                for (int b = 0; b < 2; ++b)
#pragma unroll
                    for (int m = 0; m < 4; ++m)
#pragma unroll
                        for (int n = 0; n < 2; ++n) acc[a][b][m][n] = (f32x4){0.f, 0.f, 0.f, 0.f};
        }
        cur = nxt; cA = nA; cB = nB; ++ui;
        if (wr == 1) PG8_BAR;
    }
    PG8_WAIT_V(0);
    PG8_BAR;
#undef PG8_SA
#undef PG8_SB
#undef PG8_STAGE
#undef PG8_LDA
#undef PG8_LDB
#undef PG8_MMA
#undef PG8_WAIT_V
#undef PG8_WAIT_L
#undef PG8_BAR
#undef PG8_SCHED
}
}
using pg8::Unit; using pg8::Gemm;
typedef f32x4 Acc[2][2][4][2];

struct SchedStd {
    pg8::StaticOrder so; const char* A; const char* B; size_t tA, tB;
    __device__ void init(const bf16_t* A_, int lda, const bf16_t* B_, int ldb, int M_, int N_, int G, int c) { so.init(M_, N_, G, c); A = (const char*)A_; B = (const char*)B_; tA = (size_t)256 * lda * 2; tB = (size_t)256 * ldb * 2; }
    __device__ bool next(int i, Unit& u) const { int pm, pn; if (!so.next(i, pm, pn)) return false; u.pm = pm; u.pn = pn; u.aux = 0; u.a = A + pm * tA; u.b = B + pn * tB; return true; }
};

struct EpiBf16 {
    bf16_t* O; int ldc;
    __device__ __forceinline__ bool operator()(Acc& acc, const Unit& u, int wr, int wc, int fr, int fq) const {
        const int row0 = u.pm * 256 + wr * 64 + fr, col0 = u.pn * 256 + wc * 32 + 8 * fq;
#pragma unroll
        for (int ai = 0; ai < 2; ++ai)
#pragma unroll
            for (int m = 0; m < 4; ++m) { bf16_t* rowp = O + (size_t)(row0 + ai * 128 + m * 16) * ldc + col0;
#pragma unroll
                for (int bj = 0; bj < 2; ++bj) { const f32x4 v0 = acc[ai][bj][m][0], v1 = acc[ai][bj][m][1];
                    u32x4 w; w.x = cvtpk(v0[0], v0[1]); w.y = cvtpk(v0[2], v0[3]); w.z = cvtpk(v1[0], v1[1]); w.w = cvtpk(v1[2], v1[3]);
                    *(u32x4*)(rowp + bj * 128) = w; } }
        return false;
    }
};
struct EpiSwiGLU {
    bf16_t* O; int ldc;
    __device__ __forceinline__ bool operator()(Acc& acc, const Unit& u, int wr, int wc, int fr, int fq) const {
        const int row0 = u.pm * 256 + wr * 64 + fr, col0 = u.pn * 128 + wc * 32 + 8 * fq;
#pragma unroll
        for (int ai = 0; ai < 2; ++ai)
#pragma unroll
            for (int m = 0; m < 4; ++m) { bf16_t* rowp = O + (size_t)(row0 + ai * 128 + m * 16) * ldc + col0;
                float h[8];
#pragma unroll
                for (int n = 0; n < 2; ++n)
#pragma unroll
                    for (int e = 0; e < 4; ++e) { const float gt = acc[ai][0][m][n][e], up = acc[ai][1][m][n][e]; h[n * 4 + e] = gt * sigmoidf_(gt) * up; }
                u32x4 w; w.x = cvtpk(h[0], h[1]); w.y = cvtpk(h[2], h[3]); w.z = cvtpk(h[4], h[5]); w.w = cvtpk(h[6], h[7]);
                *(u32x4*)rowp = w; }
        return false;
    }
};
struct EpiSlab {
    float* P;
    __device__ __forceinline__ bool operator()(Acc& acc, const Unit& u, int wr, int wc, int fr, int fq) const {
        float* base = P + (size_t)u.aux * 65536;
#pragma unroll
        for (int ai = 0; ai < 2; ++ai)
#pragma unroll
            for (int m = 0; m < 4; ++m) { float* rowp = base + (size_t)(ai * 128 + wr * 64 + m * 16 + fr) * 256 + wc * 32 + 8 * fq;
#pragma unroll
                for (int bj = 0; bj < 2; ++bj) { *(f32x4*)(rowp + bj * 128) = acc[ai][bj][m][0]; *(f32x4*)(rowp + bj * 128 + 4) = acc[ai][bj][m][1]; } }
        return false;
    }
};
struct EpiQKV {
    bf16_t* Q; bf16_t* KV;
    __device__ __forceinline__ bool operator()(Acc& acc, const Unit& u, int wr, int wc, int fr, int fq) const {
        EpiBf16 e{u.aux ? KV : Q, u.aux ? 2048 : 1536}; return e(acc, u, wr, wc, fr, fq);
    }
};
struct EpiMerge {
    const bf16_t* Z; bf16_t* O;
    __device__ __forceinline__ bool operator()(Acc& acc, const Unit& u, int wr, int wc, int fr, int fq) const {
        const int row0 = u.pm * 256 + wr * 64 + fr, col0 = u.pn * 256 + wc * 32 + 8 * fq;
#pragma unroll
        for (int ai = 0; ai < 2; ++ai)
#pragma unroll
            for (int m = 0; m < 4; ++m) { const size_t row = (size_t)(row0 + ai * 128 + m * 16);
#pragma unroll
                for (int bj = 0; bj < 2; ++bj) { const int col = col0 + bj * 128;
                    const u32x4 gbw = *(const u32x4*)(Z + row * DINP + ZO_GB + col);
                    float gb[8] = {sigmoidf_(bflo(gbw.x)), sigmoidf_(bfhi(gbw.x)), sigmoidf_(bflo(gbw.y)), sigmoidf_(bfhi(gbw.y)), sigmoidf_(bflo(gbw.z)), sigmoidf_(bfhi(gbw.z)), sigmoidf_(bflo(gbw.w)), sigmoidf_(bfhi(gbw.w))};
                    if (u.aux == 0) {
                        const u32x4 gaw = *(const u32x4*)(Z + row * DINP + ZO_GA + col);
                        float ga[8] = {sigmoidf_(bflo(gaw.x)), sigmoidf_(bfhi(gaw.x)), sigmoidf_(bflo(gaw.y)), sigmoidf_(bfhi(gaw.y)), sigmoidf_(bflo(gaw.z)), sigmoidf_(bfhi(gaw.z)), sigmoidf_(bflo(gaw.w)), sigmoidf_(bfhi(gaw.w))};
#pragma unroll
                        for (int n = 0; n < 2; ++n)
#pragma unroll
                            for (int e = 0; e < 4; ++e) acc[ai][bj][m][n][e] *= ga[n * 4 + e] / gb[n * 4 + e];
                    } else {
                        float h[8];
#pragma unroll
                        for (int n = 0; n < 2; ++n)
#pragma unroll
                            for (int e = 0; e < 4; ++e) h[n * 4 + e] = acc[ai][bj][m][n][e] * gb[n * 4 + e];
                        u32x4 w; w.x = cvtpk(h[0], h[1]); w.y = cvtpk(h[2], h[3]); w.z = cvtpk(h[4], h[5]); w.w = cvtpk(h[6], h[7]);
                        *(u32x4*)(O + row * 2048 + col) = w;
                    } } }
        return u.aux == 0;
    }
};

struct Args { const float* in[30]; float* out; unsigned char* ws; int ph_lo, ph_hi; };
enum { I_X = 0, I_POS, I_RELB, I_F1PRE, I_F1POST, I_F1G, I_F1U, I_F1D, I_MPRE, I_MPOST, I_WIN, I_QNG, I_WQUP, I_KVNG, I_WUK, I_WUV, I_PEK, I_W1K, I_W2K, I_PEV, I_W1V, I_W2V, I_WA, I_WB, I_WOUT,
       I_F2PRE, I_F2POST, I_F2G, I_F2U, I_F2D };
struct Frame {
    LAS unsigned char* lds; int tid, lane, wave, G, cu;
    const float* const* in; float* out; unsigned char* ws;
};

__device__ __forceinline__ void launder(Frame& F) { unsigned long long w_ = (unsigned long long)F.ws; unsigned lo_ = (unsigned)w_, hi_ = (unsigned)(w_ >> 32);
    asm volatile("" : "+v"(F.tid), "+v"(F.lane), "+v"(lo_), "+v"(hi_));
    lo_ = (unsigned)__builtin_amdgcn_readfirstlane((int)lo_); hi_ = (unsigned)__builtin_amdgcn_readfirstlane((int)hi_); F.ws = (unsigned char*)(((unsigned long long)hi_ << 32) | lo_); }
__device__ __forceinline__ void p0_transpose_item(const float* W, int K, int N, bf16_t* WT, int ldk, int koff, int mode, int row_off, LAS float* scr, int item, int lane) {
    const int nblk = (N + 31) / 32, kb = item / nblk, nb = item % nblk, k0 = 64 * kb, n0 = 32 * nb;
    const bool nok = (n0 + (lane & 31)) < N;
#pragma unroll 8
    for (int i = 0; i < 32; ++i) { const int kk = 2 * i + (lane >> 5); scr[kk * 33 + (lane & 31)] = nok ? W[(size_t)(k0 + kk) * N + n0 + (lane & 31)] : 0.f; }
    asm volatile("s_waitcnt lgkmcnt(0)" ::: "memory");
    const int c = lane & 7;
    const int rbase = mode ? ((n0 >> 7) * 256 + row_off + (n0 & 127)) : (row_off + n0);
#pragma unroll
    for (int j = 0; j < 4; ++j) { const int n = (lane >> 3) + 8 * j; const LAS float* s = scr + (8 * c) * 33 + n;
        u32x4 o; o.x = cvtpk(s[0 * 33], s[1 * 33]); o.y = cvtpk(s[2 * 33], s[3 * 33]); o.z = cvtpk(s[4 * 33], s[5 * 33]); o.w = cvtpk(s[6 * 33], s[7 * 33]);
        if (n0 + n < N) *(u32x4*)(WT + (size_t)(rbase + n) * ldk + koff + k0 + 8 * c) = o; }
    asm volatile("s_waitcnt lgkmcnt(0)" ::: "memory");
}
struct CvtJob { int in_idx, K, N, ldk, koff, mode, row_off; size_t dst_off; };
__device__ __forceinline__ CvtJob cvt_job(int j) {
    switch (j) {
    case 0:  return CvtJob{I_F1G, D, FF, D, 0, 1, 0, WO_GU1};
    case 1:  return CvtJob{I_F1U, D, FF, D, 0, 1, 128, WO_GU1};
    case 2:  return CvtJob{I_F1D, FF, D, FF, 0, 0, 0, WO_D1};
    case 3:  return CvtJob{I_F2G, D, FF, D, 0, 1, 0, WO_GU2};
    case 4:  return CvtJob{I_F2U, D, FF, D, 0, 1, 128, WO_GU2};
    case 5:  return CvtJob{I_F2D, FF, D, FF, 0, 0, 0, WO_D2};
    case 6:  return CvtJob{I_WIN, D, DIN, D, 0, 0, 0, WO_IN};
    case 7:  return CvtJob{I_WQUP, 512, 1536, 512, 0, 0, 0, WO_Q};
    case 8:  return CvtJob{I_WUK, 512, 1024, 512, 0, 0, 0, WO_UKV};
    case 9:  return CvtJob{I_WUV, 512, 1024, 512, 0, 0, 1024, WO_UKV};
    case 10: return CvtJob{I_W1K, 6144, 256, 6144, 0, 0, 0, WO_1K};
    case 11: return CvtJob{I_W1V, 4096, 256, 4096, 0, 0, 0, WO_1V};
    case 12: return CvtJob{I_WA, 1024, 2048, 2048, 0, 0, 0, WO_AB};
    case 13: return CvtJob{I_WB, 1024, 2048, 2048, 1024, 0, 0, WO_AB};
    default: return CvtJob{I_WOUT, 2048, 2048, 2048, 0, 0, 0, WO_OUT};
    }
}
constexpr int N_CVT_JOBS = 15;
__device__ __forceinline__ void p0_prologue(Frame& F) {
    LAS float* scr = (LAS float*)(F.lds + F.wave * 16384);
    const int gw = F.cu * 8 + F.wave, NGW = F.G * 8;
    bf16_t* wbase = (bf16_t*)(F.ws + WS_W);
    for (int l = 0; l < NL; ++l)
        for (int j = 0; j < N_CVT_JOBS; ++j) {
            const CvtJob J = cvt_job(j);
            const float* src = F.in[J.in_idx] + (size_t)l * J.K * J.N;
            bf16_t* dst = wbase + (size_t)l * WO_END + J.dst_off;
            const int nitems = (J.K / 64) * ((J.N + 31) / 32);
            for (int it = gw; it < nitems; it += NGW) p0_transpose_item(src, J.K, J.N, dst, J.ldk, J.koff, J.mode, J.row_off, scr, it, F.lane);
        }
    {
        const f32x4* xs = (const f32x4*)F.in[I_X]; f32x4* xd = (f32x4*)(F.ws + WS_X);
        for (size_t i = (size_t)F.cu * 512 + F.tid; i < (size_t)M * D / 4; i += (size_t)F.G * 512) xd[i] = xs[i];
        const int* pos = (const int*)F.in[I_POS]; f32x2* rope = (f32x2*)(F.ws + WS_ROPE);
        for (int i = F.cu * 512 + F.tid; i < M * 32; i += F.G * 512) {
            const float ang = (float)pos[i >> 5] * ROPE_INV[i & 31];
            const double rev = (double)ang * 0.15915494309189535; const float fr = (float)(rev - __builtin_rint(rev));
            rope[i] = (f32x2){__builtin_amdgcn_cosf(fr), __builtin_amdgcn_sinf(fr)};
        }
        float* tbl = (float*)(F.ws + WS_TBL);
        if (F.cu == 0) for (int i = F.tid; i < 8 * 132; i += 512) { const int h = i / 132, d = i % 132; tbl[i] = F.in[I_RELB][REL_BUCKET[d > 128 ? 128 : d] * 8 + h]; }
        if (F.cu >= 1 && F.cu <= 2 * NL) {
            const int l = (F.cu - 1) >> 1, kv = (F.cu - 1) & 1, Kk = kv ? 4096 : 6144;
            const float* pe = F.in[kv ? I_PEV : I_PEK] + (size_t)l * Kk; const float* w1 = F.in[kv ? I_W1V : I_W1K] + (size_t)l * Kk * 256;
            const int c = F.tid & 255, hf = F.tid >> 8; float s = 0.f;
            for (int k = hf * (Kk / 2); k < (hf + 1) * (Kk / 2); ++k) s += pe[k] * w1[(size_t)k * 256 + c];
            LAS float* red = (LAS float*)F.lds;
            __syncthreads();
            if (hf) red[c] = s;
            __syncthreads();
            if (!hf) ((float*)(F.ws + WS_TBL + 8192))[(l * 2 + kv) * 256 + c] = s + red[c];
            __syncthreads();
        }
    }
}

__device__ __forceinline__ void thin_first_norm(Frame& F, const float* g) {
    const int gw = F.cu * 8 + F.wave, NGW = F.G * 8;
    const float* X = (const float*)(F.ws + WS_X); bf16_t* U = (bf16_t*)(F.ws + WS_U);
    for (int m = gw; m < M; m += NGW) {
        const f32x4* xr = (const f32x4*)(X + (size_t)m * D) + F.lane; f32x4 v[8]; float s = 0.f;
#pragma unroll
        for (int j = 0; j < 8; ++j) { v[j] = xr[64 * j]; s += (v[j].x * v[j].x + v[j].y * v[j].y) + (v[j].z * v[j].z + v[j].w * v[j].w); }
        const float r = 1.0f / sqrtf(wave_sum(s) * (1.f / D) + EPS);
        u32x2* o = (u32x2*)(U + (size_t)m * D) + F.lane;
#pragma unroll
        for (int j = 0; j < 8; ++j) { const f32x4 gg = ((const f32x4*)g)[F.lane + 64 * j]; o[64 * j] = (u32x2){cvtpk(v[j].x * r * gg.x, v[j].y * r * gg.y), cvtpk(v[j].z * r * gg.z, v[j].w * r * gg.w)}; }
    }
}
__device__ __forceinline__ void thin_post_norm(Frame& F, float coef, const float* gpost, const float* gpre, float* outp) {
    const int gw = F.cu * 8 + F.wave, NGW = F.G * 8;
    float* X = (float*)(F.ws + WS_X); bf16_t* U = (bf16_t*)(F.ws + WS_U); const bf16_t* Y = (const bf16_t*)(F.ws + WS_Y);
    for (int m = gw; m < M; m += NGW) {
        f32x4* xr = (f32x4*)(X + (size_t)m * D) + F.lane; const u32x2* yr = (const u32x2*)(Y + (size_t)m * D) + F.lane;
        f32x4 y[8]; float s = 0.f;
#pragma unroll
        for (int j = 0; j < 8; ++j) { const u32x2 w = yr[64 * j]; y[j] = (f32x4){bflo(w.x), bfhi(w.x), bflo(w.y), bfhi(w.y)}; s += (y[j].x * y[j].x + y[j].y * y[j].y) + (y[j].z * y[j].z + y[j].w * y[j].w); }
        const float r = coef / sqrtf(wave_sum(s) * (1.f / D) + EPS);
        float s2 = 0.f;
#pragma unroll
        for (int j = 0; j < 8; ++j) { const f32x4 gg = ((const f32x4*)gpost)[F.lane + 64 * j]; f32x4 x = xr[64 * j];
            x.x += y[j].x * r * gg.x; x.y += y[j].y * r * gg.y; x.z += y[j].z * r * gg.z; x.w += y[j].w * r * gg.w; y[j] = x;
            s2 += (x.x * x.x + x.y * x.y) + (x.z * x.z + x.w * x.w);
            if (outp) ((f32x4*)(outp + (size_t)m * D))[F.lane + 64 * j] = x; else xr[64 * j] = x; }
        if (gpre) {
            const float r2 = 1.0f / sqrtf(wave_sum(s2) * (1.f / D) + EPS);
            u32x2* o = (u32x2*)(U + (size_t)m * D) + F.lane;
#pragma unroll
            for (int j = 0; j < 8; ++j) { const f32x4 gg = ((const f32x4*)gpre)[F.lane + 64 * j]; o[64 * j] = (u32x2){cvtpk(y[j].x * r2 * gg.x, y[j].y * r2 * gg.y), cvtpk(y[j].z * r2 * gg.z, y[j].w * r2 * gg.w)}; }
        }
    }
}
__device__ __forceinline__ void thin_mix(Frame& F, const float* gq, const float* gkv) {
    const int gw = F.cu * 8 + F.wave, NGW = F.G * 8;
    const bf16_t* Z = (const bf16_t*)(F.ws + WS_Z); bf16_t* C = (bf16_t*)(F.ws + WS_CQKV); bf16_t* KPE = (bf16_t*)(F.ws + WS_KPE); const f32x2* rope = (const f32x2*)(F.ws + WS_ROPE);
    for (int m = gw; m < M; m += NGW) {
        const bf16_t* zr = Z + (size_t)m * DINP;
#pragma unroll
        for (int part = 0; part < 2; ++part) {
            const u32x4 w = *((const u32x4*)(zr + part * 512) + F.lane);
            float v[8] = {bflo(w.x), bfhi(w.x), bflo(w.y), bfhi(w.y), bflo(w.z), bfhi(w.z), bflo(w.w), bfhi(w.w)}; float s = 0.f;
#pragma unroll
            for (int e = 0; e < 8; ++e) s += v[e] * v[e];
            const float r = 1.0f / sqrtf(wave_sum(s) * (1.f / 512.f) + EPS);
            const float* g = (part ? gkv : gq) + 8 * F.lane; const f32x4 g0 = *(const f32x4*)g, g1 = *(const f32x4*)(g + 4);
            u32x4 o; o.x = cvtpk(v[0] * r * g0.x, v[1] * r * g0.y); o.y = cvtpk(v[2] * r * g0.z, v[3] * r * g0.w); o.z = cvtpk(v[4] * r * g1.x, v[5] * r * g1.y); o.w = cvtpk(v[6] * r * g1.z, v[7] * r * g1.w);
            *((u32x4*)(C + (size_t)m * 1024 + part * 512) + F.lane) = o;
        }
        if (F.lane < 32) {
            const float x1 = bf1(zr[ZO_KR + F.lane]), x2 = bf1(zr[ZO_KR + 32 + F.lane]); const f32x2 cs = rope[(size_t)m * 32 + F.lane];
            const unsigned a = cvtpk(x1 * cs.x - x2 * cs.y, x1 * cs.y + x2 * cs.x);
            KPE[(size_t)m * 64 + F.lane] = (bf16_t)(a & 0xffffu); KPE[(size_t)m * 64 + 32 + F.lane] = (bf16_t)(a >> 16);
        }
    }
}
__device__ __forceinline__ void cmp_stage2_unit(Frame& F, int unit, int l) {
    const int kv = unit >> 6, u = unit & 63, g = u >> 5, r0 = (u & 31) * 16;
    const int NO = kv ? 128 : 192;
    const float* part = (const float*)(F.ws + WS_PART); const float* pb = (const float*)(F.ws + WS_TBL + 8192) + (l * 2 + kv) * 256;
    const float* w2 = F.in[kv ? I_W2V : I_W2K] + (size_t)l * 256 * NO;
    LAS float* hid = (LAS float*)F.lds;
    __syncthreads();
    {
        const int row = F.tid >> 5, c0 = (F.tid & 31) * 8, rp = r0 + row, rt = rp >> 8, rr = rp & 255;
        f32x4 s0 = *(const f32x4*)(pb + c0), s1 = *(const f32x4*)(pb + c0 + 4);
#pragma unroll
        for (int s = 0; s < 8; ++s) { const float* p = part + (size_t)((((kv * 2 + g) * 2 + rt) * 8) + s) * 65536 + (size_t)rr * 256 + c0; s0 += *(const f32x4*)p; s1 += *(const f32x4*)(p + 4); }
        float h[8] = {s0.x, s0.y, s0.z, s0.w, s1.x, s1.y, s1.z, s1.w};
#pragma unroll
        for (int e = 0; e < 8; ++e) hid[row * 256 + c0 + e] = h[e] * sigmoidf_(h[e]);
    }
    __syncthreads();
    bf16_t* dst = (bf16_t*)(F.ws + WS_KC + (kv ? 524288 : 0));
    for (int o = F.tid; o < 16 * NO; o += 512) {
        const int row = o / NO, n = o % NO; float a = 0.f;
#pragma unroll 8
        for (int c = 0; c < 256; ++c) a += hid[row * 256 + c] * w2[c * NO + n];
        const int rp = r0 + row, b = rp >> 7, nn = rp & 127;
        dst[(size_t)((b * 2 + g) * 128 + nn) * NO + n] = (bf16_t)(cvtpk(a, 0.f) & 0xffffu);
    }
}

template <bool ROPE>
__device__ __forceinline__ void load_q(Frame& F, const bf16_t* qp, float scale, LAS float* qs, const f32x2* rope_row) {
    if (F.lane < 24) { const u32x4 w = *((const u32x4*)qp + F.lane); LAS float* d = qs + 8 * F.lane;
        d[0] = bflo(w.x) * scale; d[1] = bfhi(w.x) * scale; d[2] = bflo(w.y) * scale; d[3] = bfhi(w.y) * scale; d[4] = bflo(w.z) * scale; d[5] = bfhi(w.z) * scale; d[6] = bflo(w.w) * scale; d[7] = bfhi(w.w) * scale; }
    if (ROPE) { if (F.lane < 32) { const float x1 = qs[128 + F.lane], x2 = qs[160 + F.lane]; const f32x2 cs = rope_row[F.lane]; qs[128 + F.lane] = x1 * cs.x - x2 * cs.y; qs[160 + F.lane] = x1 * cs.y + x2 * cs.x; } }
}
__device__ __forceinline__ float dot8(const u32x4 w, const LAS float* q) {
    const f32x4 a = *(const LAS f32x4*)q, b = *(const LAS f32x4*)(q + 4);
    return (bflo(w.x) * a.x + bfhi(w.x) * a.y) + (bflo(w.y) * a.z + bfhi(w.y) * a.w) + (bflo(w.z) * b.x + bfhi(w.z) * b.y) + (bflo(w.w) * b.z + bfhi(w.w) * b.w);
}
template <int MODE>
__device__ __forceinline__ void naive_row(Frame& F, int b, int t, int head, float gate, float& o0, float& o1, LAS float* sc, const LAS float* qs, unsigned selmask, int& nk_out) {
    const int g = head >> 2; const size_t mb = (size_t)b * SEQ;
    const bf16_t* Z = (const bf16_t*)(F.ws + WS_Z); const bf16_t* KV = (const bf16_t*)(F.ws + WS_KV); const bf16_t* KPE = (const bf16_t*)(F.ws + WS_KPE);
    const bf16_t* KC = (const bf16_t*)(F.ws + WS_KC); const bf16_t* VC = (const bf16_t*)(F.ws + WS_KC + 524288);
    const float* tbl = (const float*)(F.ws + WS_TBL) + head * 132; const int* pos = (const int*)F.in[I_POS] + mb;
    const int k0 = (MODE == 2) ? (t > 511 ? t - 511 : 0) : 0;
    const int k1 = (MODE == 3) ? (t < 31 ? -1 : (t - 31) / 16) : t;
    nk_out = k1 - k0 + 1;
    if (k1 < k0) return;
    const int qpos = (MODE != 0) ? pos[t] : 0;
    float mx = -INFINITY;
    for (int kb = k0; kb <= k1; kb += 64) {
        const int k = kb + F.lane; bool valid = k <= k1;
        if (MODE == 1) valid = valid && ((selmask >> (k >> 6)) & 1u);
        float s = -INFINITY;
        if (valid) {
            const bf16_t* p1; const bf16_t* p2;
            if (MODE == 0) { p1 = KV + (mb + k) * 2048 + head * 128; p2 = KPE + (mb + k) * 64; }
            else if (MODE == 1) { p1 = Z + (mb + k) * DINP + ZO_KS + g * 192; p2 = p1 + 128; }
            else if (MODE == 2) { p1 = Z + (mb + k) * DINP + ZO_KW + g * 192; p2 = p1 + 128; }
            else { p1 = KC + (size_t)((b * 2 + g) * 128 + k) * 192; p2 = p1 + 128; }
            float d = 0.f;
#pragma unroll
            for (int c = 0; c < 16; ++c) d += dot8(*((const u32x4*)p1 + c), qs + 8 * c);
#pragma unroll
            for (int c = 0; c < 8; ++c) d += dot8(*((const u32x4*)p2 + c), qs + 128 + 8 * c);
            if (MODE != 0) { const int kp = (MODE == 3) ? pos[16 * k + 31] : pos[k]; int dd = qpos - kp; dd = dd < 0 ? 0 : (dd > 128 ? 128 : dd); d += tbl[dd]; }
            s = d;
        }
        if (k <= k1) sc[k - k0] = s;
        mx = fmaxf(mx, s);
    }
    mx = wave_max(mx);
    float sum = 0.f;
    for (int kb = k0; kb <= k1; kb += 64) { const int k = kb + F.lane; if (k <= k1) { const float p = __expf(sc[k - k0] - mx); sc[k - k0] = p; sum += p; } }
    sum = wave_sum(sum);
    const float inv = 1.0f / sum;
    float a0 = 0.f, a1 = 0.f;
    for (int k = k0; k <= k1; ++k) {
        if (MODE == 1) { if (!((selmask >> (k >> 6)) & 1u)) { k |= 63; continue; } }
        const float p = sc[k - k0];
        const bf16_t* vp;
        if (MODE == 0) vp = KV + (mb + k) * 2048 + 1024 + head * 128;
        else if (MODE == 1) vp = Z + (mb + k) * DINP + ZO_VS + g * 128;
        else if (MODE == 2) vp = Z + (mb + k) * DINP + ZO_VW + g * 128;
        else vp = VC + (size_t)((b * 2 + g) * 128 + k) * 128;
        const unsigned w = *((const unsigned*)vp + F.lane);
        a0 += p * bflo(w); a1 += p * bfhi(w);
    }
    o0 += gate * inv * a0; o1 += gate * inv * a1;
    if (MODE == 3) { for (int kb = 0; kb <= k1; kb += 64) { const int k = kb + F.lane; if (k <= k1) sc[k] *= inv; } }
}
__device__ __forceinline__ void naive_cmp_phase(Frame& F) {
    const int gw = F.cu * 8 + F.wave, NGW = F.G * 8;
    LAS float* sc = (LAS float*)(F.lds + F.wave * 8192); LAS float* qs = (LAS float*)(F.lds + 65536 + F.wave * 1024); LAS float* ps = (LAS float*)(F.lds + 65536 + 8192 + F.wave * 512);
    const bf16_t* Z = (const bf16_t*)(F.ws + WS_Z); float* OC = (float*)(F.ws + WS_OC); unsigned* SEL = (unsigned*)(F.ws + WS_SEL);
    for (int r = gw; r < M * 2; r += NGW) {
        const int g = r & 1, m = r >> 1, b = m / SEQ, t = m % SEQ;
        ps[F.lane] = 0.f; ps[F.lane + 64] = 0.f;
        for (int j = 0; j < 4; ++j) {
            const int head = g * 4 + j; int nk = 0;
            load_q<false>(F, Z + (size_t)m * DINP + ZO_NQ + head * 192, 0.07216878364870322f, qs, nullptr);
            float o0 = 0.f, o1 = 0.f;
            const float g0 = sigmoidf_(bf1(Z[(size_t)m * DINP + ZO_NG + head * 3 + 0]));
            naive_row<3>(F, b, t, head, g0, o0, o1, sc, qs, 0u, nk);
            *(f32x2*)(OC + (size_t)m * 1024 + head * 128 + 2 * F.lane) = (f32x2){o0, o1};
            if (F.lane < nk) ps[F.lane] += sc[F.lane];
            if (F.lane + 64 < nk) ps[F.lane + 64] += sc[F.lane + 64];
        }
        const int mm = F.lane & 31; float imp = 0.f;
#pragma unroll
        for (int n = -1; n < 4; ++n) { const int nn = 4 * mm + n; if (nn >= 0 && nn < 128) imp += ps[nn]; }
        const int cur = t >> 6; const bool valid = mm <= cur, forced = valid && (mm == 0 || mm >= cur - 1);
        const float scv = forced ? 1e6f : (valid ? imp : -1.0f);
        int rank = 0;
#pragma unroll
        for (int o = 0; o < 32; ++o) { const float v = __shfl(scv, o); rank += (v > scv || (v == scv && o < mm)) ? 1 : 0; }
        const bool sel = (rank < 16) && (scv >= 0.f) && (F.lane < 32);
        const unsigned long long bal = __ballot(sel);
        if (F.lane == 0) SEL[(size_t)(b * 2 + g) * SEQ + t] = (unsigned)bal;
    }
}
__device__ __forceinline__ void naive_attn_phase(Frame& F) {
    const int gw = F.cu * 8 + F.wave, NGW = F.G * 8;
    LAS float* sc = (LAS float*)(F.lds + F.wave * 8192); LAS float* qs = (LAS float*)(F.lds + 65536 + F.wave * 1024);
    const bf16_t* Z = (const bf16_t*)(F.ws + WS_Z); const bf16_t* QM = (const bf16_t*)(F.ws + WS_QM); bf16_t* AB = (bf16_t*)(F.ws + WS_AB);
    const float* OC = (const float*)(F.ws + WS_OC); const unsigned* SEL = (const unsigned*)(F.ws + WS_SEL); const f32x2* rope = (const f32x2*)(F.ws + WS_ROPE);
    for (int r = gw; r < M * 8; r += NGW) {
        const int head = r & 7, m = r >> 3, b = m / SEQ, t = m % SEQ; int nk;
        load_q<true>(F, QM + (size_t)m * 1536 + head * 192, 0.07216878364870322f, qs, rope + (size_t)m * 32);
        float o0 = 0.f, o1 = 0.f;
        naive_row<0>(F, b, t, head, 1.0f, o0, o1, sc, qs, 0u, nk);
        *((unsigned*)(AB + (size_t)m * 2048 + head * 128) + F.lane) = cvtpk(o0, o1);
    }
    for (int r = gw; r < M * 8; r += NGW) {
        const int head = r & 7, m = r >> 3, b = m / SEQ, t = m % SEQ, g = head >> 2; int nk;
        const unsigned selmask = (unsigned)__builtin_amdgcn_readfirstlane((int)SEL[(size_t)(b * 2 + g) * SEQ + t]);
        load_q<false>(F, Z + (size_t)m * DINP + ZO_NQ + head * 192, 0.07216878364870322f, qs, nullptr);
        const float g1 = sigmoidf_(bf1(Z[(size_t)m * DINP + ZO_NG + head * 3 + 1])), g2 = sigmoidf_(bf1(Z[(size_t)m * DINP + ZO_NG + head * 3 + 2]));
        const f32x2 oc = *(const f32x2*)(OC + (size_t)m * 1024 + head * 128 + 2 * F.lane);
        float o0 = oc.x, o1 = oc.y;
        naive_row<1>(F, b, t, head, g1, o0, o1, sc, qs, selmask, nk);
        naive_row<2>(F, b, t, head, g2, o0, o1, sc, qs, 0u, nk);
        *((unsigned*)(AB + (size_t)m * 2048 + 1024 + head * 128) + F.lane) = cvtpk(o0, o1);
    }
}

struct SchedCmp {
    const char* Zb; const char* Wb; int c0, c, kv;
    __device__ bool next(int i, Unit& u) const {
        const int j = c - c0; if (i != 0 || j < 0 || j >= 32) return false;
        const int g = j >> 4, rt = (j >> 3) & 1, s = j & 7;
        u.a = Zb + ((size_t)(kv ? ZO_VC + 128 * g : ZO_KC + 192 * g) + (size_t)rt * 256 * 16 * DINP + (size_t)s * 4 * DINP) * 2;
        u.b = Wb + (size_t)s * (kv ? 8 : 12) * 64 * 2; u.pm = 0; u.pn = 0; u.aux = kv * 32 + j; return true;
    }
};
struct SchedQKV {
    const char* C; const char* WQ; const char* WUKV; int G, c;
    __device__ bool next(int i, Unit& u) const {
        int j = i * G + c; if (j >= 448) return false;
        if (j < 192) { u.aux = 0; u.pn = j / 32; u.pm = j % 32; u.a = C + (size_t)u.pm * 256 * 1024 * 2; u.b = WQ + (size_t)u.pn * 256 * 512 * 2; }
        else { j -= 192; u.aux = 1; u.pn = j / 32; u.pm = j % 32; u.a = C + ((size_t)u.pm * 256 * 1024 + 512) * 2; u.b = WUKV + (size_t)u.pn * 256 * 512 * 2; }
        return true;
    }
};
struct SchedMerge {
    const char* A; const char* W; int G, c;
    __device__ bool next(int i, Unit& u) const {
        const int ti = (i >> 1) * G + c, kh = i & 1; if (ti >= 256) return false;
        u.pm = ti % 32; u.pn = ti / 32; u.aux = kh;
        u.a = A + ((size_t)u.pm * 256 * 2048 + kh * 1024) * 2; u.b = W + ((size_t)u.pn * 256 * 2048 + kh * 1024) * 2; return true;
    }
};

constexpr int NPH = 2 + NL * 14;
__global__ void __launch_bounds__(512, 2) fwd(Args args) {
    extern __shared__ __attribute__((aligned(16))) unsigned char lds_raw[];
    Frame F;
    F.lds = (LAS unsigned char*)lds_raw; F.tid = threadIdx.x; F.lane = F.tid & 63; F.wave = __builtin_amdgcn_readfirstlane(F.tid >> 6); F.G = gridDim.x; F.cu = blockIdx.x;
    F.in = args.in; F.out = args.out; F.ws = args.ws;
    volatile LAS unsigned* MISC = (volatile LAS unsigned*)(F.lds + MISC_OFF);
    for (int u = F.tid; u < (LDS_BYTES - RING_BYTES) / 4; u += 512) ((LAS unsigned*)(F.lds + RING_BYTES))[u] = 0u;
    __syncthreads();
    unsigned* ctl = (unsigned*)(F.ws + WS_CTL);
    XcdBarrier bar; bar.bar = ctl + CW_BAR; bar.x = 0; bar.st = MISC + 8;
    if (!MK_PER_PHASE) bar = xcd_barrier_post(ctl + CW_BAR, MISC + 8);
    const int lo = args.ph_lo, hi = args.ph_hi; int pc = 0;
#define PH_IF launder(F); if (pc >= lo && pc < hi)
#define PH_END do { const bool both_ = (pc >= lo) && (pc + 1 < hi); ++pc; if (both_) xcd_barrier(bar); } while (0)
#define U ((bf16_t*)(F.ws + WS_U))
#define H ((bf16_t*)(F.ws + WS_H))
#define Y ((bf16_t*)(F.ws + WS_Y))
#define Z ((bf16_t*)(F.ws + WS_Z))
#define CQKV ((bf16_t*)(F.ws + WS_CQKV))
#define QM ((bf16_t*)(F.ws + WS_QM))
#define KV ((bf16_t*)(F.ws + WS_KV))
#define AB ((bf16_t*)(F.ws + WS_AB))
#define MG ((bf16_t*)(F.ws + WS_MG))
#define WL ((const bf16_t*)(F.ws + WS_W) + (size_t)l * WO_END)

    PH_IF { p0_prologue(F); } PH_END;
    PH_IF { thin_first_norm(F, F.in[I_F1PRE]); } PH_END;
    for (int l = 0; l < NL; ++l) {
        for (int f = 0; f < 2; ++f) {
            PH_IF {
                Gemm g{D, D, D / 64, 0}; SchedStd S; S.init(U, D, WL + (f ? WO_GU2 : WO_GU1), D, M, 2 * FF, F.G, F.cu); EpiSwiGLU E{H, FF};
                pg8::gemm_phase<EpiSwiGLU, SchedStd, 0>(F.lds, g, S, E);
            } PH_END;
            PH_IF {
                Gemm g{FF, FF, FF / 64, 0}; SchedStd S; S.init(H, FF, WL + (f ? WO_D2 : WO_D1), FF, M, D, F.G, F.cu); EpiBf16 E{Y, D};
                pg8::gemm_phase<EpiBf16, SchedStd, 0>(F.lds, g, S, E);
            } PH_END;
            PH_IF {
                if (f == 0) thin_post_norm(F, 0.5f, F.in[I_F1POST] + (size_t)l * D, F.in[I_MPRE] + (size_t)l * D, nullptr);
                else thin_post_norm(F, 0.5f, F.in[I_F2POST] + (size_t)l * D, (l + 1 < NL) ? F.in[I_F1PRE] + (size_t)(l + 1) * D : nullptr, (l + 1 < NL) ? nullptr : F.out);
            } PH_END;
            if (f == 0) {
                PH_IF {
                    Gemm g{D, D, D / 64, 0}; SchedStd S; S.init(U, D, WL + WO_IN, D, M, DINP, F.G, F.cu); EpiBf16 E{Z, DINP};
                    pg8::gemm_phase<EpiBf16, SchedStd, 0>(F.lds, g, S, E);
                } PH_END;
                PH_IF {
                    thin_mix(F, F.in[I_QNG] + (size_t)l * 512, F.in[I_KVNG] + (size_t)l * 512);
                    __syncthreads();
                    EpiSlab E{(float*)(F.ws + WS_PART)};
                    { Gemm g{16 * DINP, 6144, 12, (size_t)DINP * 2}; SchedCmp S{(const char*)Z, (const char*)(WL + WO_1K), 0, F.cu, 0}; pg8::gemm_phase<EpiSlab, SchedCmp, 3>(F.lds, g, S, E); }
                    { Gemm g{16 * DINP, 4096, 8, (size_t)DINP * 2}; SchedCmp S{(const char*)Z, (const char*)(WL + WO_1V), 32, F.cu, 1}; pg8::gemm_phase<EpiSlab, SchedCmp, 2>(F.lds, g, S, E); }
                } PH_END;
                PH_IF {
                    { Gemm g{1024, 512, 8, 0}; SchedQKV S{(const char*)CQKV, (const char*)(WL + WO_Q), (const char*)(WL + WO_UKV), F.G, F.cu}; EpiQKV E{QM, KV};
                      pg8::gemm_phase<EpiQKV, SchedQKV, 0>(F.lds, g, S, E); }
                    for (int u = F.G - 1 - F.cu; u < 128; u += F.G) cmp_stage2_unit(F, u, l);
                } PH_END;
                PH_IF { naive_cmp_phase(F); } PH_END;
                PH_IF { naive_attn_phase(F); } PH_END;
                PH_IF {
                    Gemm g{2048, 2048, 16, 0}; SchedMerge S{(const char*)AB, (const char*)(WL + WO_AB), F.G, F.cu}; EpiMerge E{Z, MG};
                    pg8::gemm_phase<EpiMerge, SchedMerge, 0>(F.lds, g, S, E);
                } PH_END;
                PH_IF {
                    Gemm g{2048, 2048, 32, 0}; SchedStd S; S.init(MG, 2048, WL + WO_OUT, 2048, M, D, F.G, F.cu); EpiBf16 E{Y, D};
                    pg8::gemm_phase<EpiBf16, SchedStd, 0>(F.lds, g, S, E);
                } PH_END;
                PH_IF { thin_post_norm(F, 1.0f, F.in[I_MPOST] + (size_t)l * D, F.in[I_F2PRE] + (size_t)l * D, nullptr); } PH_END;
            }
        }
    }
#undef PH_IF
#undef PH_END
#undef U
#undef H
#undef Y
#undef Z
#undef CQKV
#undef QM
#undef KV
#undef AB
#undef MG
#undef WL
}

extern "C" void kernel_launch(void* const* d_in, const int* in_sizes, int n_in, void* d_out, int out_size, void* d_ws, size_t ws_size, hipStream_t stream) {
    static int grid = 0;
    if (grid == 0) {
        if (n_in != 30 || in_sizes[0] != M * D || out_size != M * D || ws_size < WS_END) { fprintf(stderr, "kernel_launch: unexpected shapes / workspace (n_in %d, ws %zu < %zu)\n", n_in, ws_size, (size_t)WS_END); grid = -1; return; }
        int dev = 0, cus = 0, per_cu = 0;
        if (hipGetDevice(&dev) != hipSuccess || hipDeviceGetAttribute(&cus, hipDeviceAttributeMultiprocessorCount, dev) != hipSuccess) { grid = -1; return; }
        if (hipFuncSetAttribute((const void*)fwd, hipFuncAttributeMaxDynamicSharedMemorySize, LDS_BYTES) != hipSuccess) { fprintf(stderr, "kernel_launch: hipFuncSetAttribute failed\n"); grid = -1; return; }
        if (hipOccupancyMaxActiveBlocksPerMultiprocessor(&per_cu, (const void*)fwd, 512, LDS_BYTES) != hipSuccess || per_cu < 1) { fprintf(stderr, "kernel_launch: occupancy query says %d\n", per_cu); }
        (void)hipGetLastError();
        grid = cus;
    }
    if (grid < 0) return;
    (void)hipMemsetAsync((char*)d_ws + WS_CTL, 0, CTL_ZERO_BYTES, stream);
    Args a{};
    for (int i = 0; i < 30; ++i) a.in[i] = (const float*)d_in[i];
    a.out = (float*)d_out; a.ws = (unsigned char*)d_ws;
#if MK_PER_PHASE
    for (int p = 0; p < NPH; ++p) { a.ph_lo = p; a.ph_hi = p + 1; hipLaunchKernelGGL(fwd, dim3(grid), dim3(512), LDS_BYTES, stream, a); }
#else
    a.ph_lo = 0; a.ph_hi = NPH; hipLaunchKernelGGL(fwd, dim3(grid), dim3(512), LDS_BYTES, stream, a);
#endif
}
```

```cpp
#include <hip/hip_runtime.h>
#include <cstdio>
#include <cstdint>

#ifndef MK_PER_PHASE
#define MK_PER_PHASE 0
#endif

#define GAS __attribute__((address_space(1)))
#define LAS __attribute__((address_space(3)))
typedef unsigned short bf16_t;
typedef short bf16x8 __attribute__((ext_vector_type(8)));
typedef float f32x4 __attribute__((ext_vector_type(4)));
typedef float f32x2 __attribute__((ext_vector_type(2)));
typedef unsigned u32x4 __attribute__((ext_vector_type(4)));
typedef unsigned u32x2 __attribute__((ext_vector_type(2)));
typedef __bf16 bf16x2_t __attribute__((ext_vector_type(2)));

constexpr int NB = 4, SEQ = 2048, M = NB * SEQ, D = 2048, NL = 4, FF = 5632;
constexpr int DIN = 8664, DINP = 8704;
constexpr int ZO_CQ = 0, ZO_CKV = 512, ZO_KR = 1024, ZO_NQ = 1088, ZO_KC = 2624, ZO_VC = 3008, ZO_KS = 3264, ZO_VS = 3648, ZO_KW = 3904, ZO_VW = 4288, ZO_NG = 4544, ZO_GA = 4568, ZO_GB = 6616;
constexpr float EPS = 1e-6f;
constexpr int NCMP = 127;

constexpr size_t MiB = 1u << 20;
constexpr size_t alup(size_t x) { return (x + MiB - 1) / MiB * MiB; }
constexpr size_t WS_CTL = 0, CTL_ZERO_BYTES = 1 * MiB;
constexpr size_t WS_TBL = WS_CTL + CTL_ZERO_BYTES;
constexpr size_t WS_ROPE = WS_TBL + MiB;
constexpr size_t WS_X = WS_ROPE + alup((size_t)M * 32 * 8);
constexpr size_t WS_U = WS_X + alup((size_t)M * D * 4);
constexpr size_t WS_H = WS_U + alup((size_t)M * D * 2);
constexpr size_t WS_Y = WS_H + alup((size_t)M * FF * 2);
constexpr size_t WS_Z = WS_Y + alup((size_t)M * D * 2);
constexpr size_t WS_CQKV = WS_Z + alup((size_t)(M + 64) * DINP * 2);
constexpr size_t WS_KPE = WS_CQKV + alup((size_t)M * 1024 * 2);
constexpr size_t WS_QM = WS_KPE + alup((size_t)M * 64 * 2);
constexpr size_t WS_KV = WS_QM + alup((size_t)M * 1536 * 2);
constexpr size_t WS_AB = WS_KV + alup((size_t)M * 2048 * 2);
constexpr size_t WS_MG = WS_AB + alup((size_t)M * 2048 * 2);
constexpr size_t WS_OC = WS_MG + alup((size_t)M * 2048 * 2);
constexpr size_t WS_PART = WS_OC + alup((size_t)M * 1024 * 4);
constexpr size_t WS_KC = WS_PART + alup((size_t)64 * 256 * 256 * 4);
constexpr size_t WS_SEL = WS_KC + MiB;
constexpr size_t WS_W = WS_SEL + MiB;
constexpr size_t WO_GU1 = 0, WO_D1 = WO_GU1 + (size_t)2 * FF * D, WO_GU2 = WO_D1 + (size_t)D * FF, WO_D2 = WO_GU2 + (size_t)2 * FF * D,
                 WO_IN = WO_D2 + (size_t)D * FF, WO_Q = WO_IN + (size_t)DINP * D, WO_UKV = WO_Q + (size_t)1536 * 512, WO_1K = WO_UKV + (size_t)2048 * 512,
                 WO_1V = WO_1K + (size_t)256 * 6144, WO_AB = WO_1V + (size_t)256 * 4096, WO_OUT = WO_AB + (size_t)2048 * 2048, WO_END = WO_OUT + (size_t)2048 * 2048;
constexpr size_t WS_END = WS_W + alup(WO_END * 2 * NL);
constexpr int CW_BAR = 4096;

constexpr int RING_BYTES = 131072, MISC_OFF = RING_BYTES + 320, LDS_BYTES = 147456;

#define RLX_AGENT __ATOMIC_RELAXED, __HIP_MEMORY_SCOPE_AGENT
__device__ __forceinline__ unsigned cvtpk(float lo, float hi) { f32x2 v = {lo, hi}; bf16x2_t b = __builtin_convertvector(v, bf16x2_t); return __builtin_bit_cast(unsigned, b); }
__device__ __forceinline__ float bflo(unsigned u) { return __uint_as_float(u << 16); }
__device__ __forceinline__ float bfhi(unsigned u) { return __uint_as_float(u & 0xffff0000u); }
__device__ __forceinline__ float bf1(bf16_t h) { return __uint_as_float((unsigned)h << 16); }
__device__ __forceinline__ float wave_sum(float v) {
#pragma unroll
    for (int o = 1; o < 64; o <<= 1) v += __shfl_xor(v, o);
    return v;
}
__device__ __forceinline__ float wave_max(float v) {
#pragma unroll
    for (int o = 1; o < 64; o <<= 1) v = fmaxf(v, __shfl_xor(v, o));
    return v;
}
__device__ __forceinline__ float sigmoidf_(float x) { return 1.0f / (1.0f + __expf(-x)); }

__device__ const float ROPE_INV[32] = {
    1.000000000e+00f, 7.498942614e-01f, 5.623413324e-01f, 4.216965139e-01f, 3.162277639e-01f, 2.371373773e-01f, 1.778279394e-01f, 1.333521307e-01f,
    1.000000015e-01f, 7.498941571e-02f, 5.623413250e-02f, 4.216965288e-02f, 3.162277490e-02f, 2.371373773e-02f, 1.778279431e-02f, 1.333521493e-02f,
    9.999999776e-03f, 7.498941850e-03f, 5.623413250e-03f, 4.216964822e-03f, 3.162277630e-03f, 2.371373586e-03f, 1.778279431e-03f, 1.333521446e-03f,
    1.000000047e-03f, 7.498942432e-04f, 5.623413017e-04f, 4.216965172e-04f, 3.162277571e-04f, 2.371373703e-04f, 1.778279402e-04f, 1.333521504e-04f};
__device__ const unsigned char REL_BUCKET[129] = {
    0, 1, 2, 3, 4, 5, 6, 7, 8, 9, 10, 11, 12, 13, 14, 15, 16, 16, 16, 17, 17, 18, 18, 18, 19, 19, 19, 20, 20, 20, 20, 21, 21, 21, 21, 22, 22, 22, 22, 22, 23, 23, 23, 23, 23, 23, 24, 24, 24, 24, 24, 24,
    25, 25, 25, 25, 25, 25, 25, 26, 26, 26, 26, 26, 26, 26, 26, 27, 27, 27, 27, 27, 27, 27, 27, 27, 27, 28, 28, 28, 28, 28, 28, 28, 28, 28, 28, 29, 29, 29, 29, 29, 29, 29, 29, 29, 29, 29, 29,
    30, 30, 30, 30, 30, 30, 30, 30, 30, 30, 30, 30, 30, 30, 31, 31, 31, 31, 31, 31, 31, 31, 31, 31, 31, 31, 31, 31, 31, 31};

#define XB_TMO      128
#define XB_XCNT(j)  (256  + 64 * (j))
#define XB_XSUB(j)  (1280 + 64 * (j))
#define XB_XGEN(j)  (2304 + 64 * (j))
#define XB_TOP      3328
#define XB_TOPGEN   3392
#define XCD_BAR_WORDS 3456
#define XB_SPIN_CAP (1u << 18)
__device__ __forceinline__ unsigned xb_ld(unsigned* p)              { return __hip_atomic_load(p, __ATOMIC_RELAXED, __HIP_MEMORY_SCOPE_AGENT); }
__device__ __forceinline__ unsigned xb_add(unsigned* p, unsigned v) { return __hip_atomic_fetch_add(p, v, __ATOMIC_RELAXED, __HIP_MEMORY_SCOPE_AGENT); }
__device__ __forceinline__ unsigned xb_xcc_id() { return (unsigned)__builtin_amdgcn_s_getreg((3 << 11) | 20) & 0xFu; }
#define XB_SPIN(cond, bar) do { unsigned _sp = 0; while (cond) { __builtin_amdgcn_s_sleep(1); \
    if ((++_sp & 255u) == 0u) { if (xb_ld(&(bar)[XB_TMO])) break; if (_sp > XB_SPIN_CAP) { atomicAdd(&(bar)[XB_TMO], 1u); break; } } } } while (0)
struct XcdBarrier { unsigned* bar; unsigned x; volatile LAS unsigned* st; };
__device__ __forceinline__ XcdBarrier xcd_barrier_post(unsigned* bar, volatile LAS unsigned* st) {
    XcdBarrier b; b.bar = bar; b.x = xb_xcc_id(); b.st = st;
    if (threadIdx.x == 0) (void)xb_add(&bar[XB_XCNT(b.x)], 1u);
    return b;
}
__device__ __forceinline__ void xcd_barrier_complete(unsigned* bar, unsigned x, unsigned& nloc, unsigned& nx) {
    const unsigned G = gridDim.x * gridDim.y * gridDim.z;
    unsigned sum, cnt, mine, sp = 0u;
    for (;;) {
        sum = 0u; cnt = 0u; mine = 0u;
#pragma unroll
        for (unsigned j = 0; j < 16; ++j) { const unsigned c = xb_ld(&bar[XB_XCNT(j)]); sum += c; cnt += (c > 0u) ? 1u : 0u; mine = (j == x) ? c : mine; }
        if (sum == G) break;
        __builtin_amdgcn_s_sleep(1);
        if ((++sp & 255u) == 0u) { if (xb_ld(&bar[XB_TMO])) break; if (sp > XB_SPIN_CAP) { atomicAdd(&bar[XB_TMO], 1u); break; } }
    }
    nloc = mine > 0u ? mine : 1u; nx = cnt > 0u ? cnt : 1u;
}
__device__ __forceinline__ void xcd_barrier(const XcdBarrier& b) {
    asm volatile("s_waitcnt vmcnt(0)" ::: "memory");
    __syncthreads();
    if (threadIdx.x == 0) {
        unsigned* bar = b.bar;
        __builtin_amdgcn_s_waitcnt(0);
        unsigned nloc = b.st[0], nx = b.st[1];
        if (nloc == 0u) { xcd_barrier_complete(bar, b.x, nloc, nx); b.st[0] = nloc; b.st[1] = nx; }
        const unsigned old = xb_add(&bar[XB_XSUB(b.x)], 1u);
        const unsigned gen = old / nloc;
        if (old + 1u == (gen + 1u) * nloc) {
            __builtin_amdgcn_fence(__ATOMIC_RELEASE, "agent");
            asm volatile("s_waitcnt vmcnt(0)" ::: "memory");
            const unsigned og = xb_add(&bar[XB_TOP], 1u);
            const unsigned tg = og / nx;
            if (og + 1u == (tg + 1u) * nx) xb_add(&bar[XB_TOPGEN], 1u);
            else XB_SPIN(xb_ld(&bar[XB_TOPGEN]) == tg, bar);
            __builtin_amdgcn_fence(__ATOMIC_ACQUIRE, "agent");
            xb_add(&bar[XB_XGEN(b.x)], 1u);
            asm volatile("s_waitcnt vmcnt(0)" ::: "memory");
        } else {
            XB_SPIN(xb_ld(&bar[XB_XGEN(b.x)]) == gen, bar);
            __builtin_amdgcn_fence(__ATOMIC_ACQUIRE, "agent");
            asm volatile("s_waitcnt vmcnt(0)" ::: "memory");
        }
    }
    __syncthreads();
}

namespace pg8 {
constexpr int BM = 256, BK = 64, HALF = 128, HTB = HALF * BK * 2, STAGE_BYTES = 8 * HTB, NXCD = 8, WGM = 8;
__host__ __device__ __forceinline__ int lds_byte(int r, int c) { const int st = (r >> 4) * 2 + (c >> 5), rr = r & 15, cc = c & 31, ob = rr * 64 + cc * 2; return st * 1024 + (ob ^ (((ob >> 9) & 1) << 5)); }
__host__ __device__ __forceinline__ void stage_rc(int b, int& R, int& C) { const int st = b / 1024, sb = b % 1024, swz = sb ^ (((sb >> 9) & 1) << 5); R = (st >> 1) * 16 + swz / 64; C = (st & 1) * 32 + (swz % 64) / 2; }
__host__ __device__ __forceinline__ int perm32(int rho) { const int n = rho >> 4, i = rho & 15; return 8 * (i >> 2) + 4 * n + (i & 3); }

struct Unit { const char* a; const char* b; int pm, pn, aux; };
struct Gemm { int lda, ldb, nt; size_t gstride; };

struct StaticOrder {
    int nM, nN, nwg, G, c;
    __device__ void init(int M_, int N_, int G_, int c_) { nM = M_ / BM; nN = N_ / BM; nwg = nM * nN; G = G_; c = c_; }
    __device__ bool next(int i, int& pm, int& pn) const {
        const long L = (long)i * G + c; if (L >= nwg) return false;
        int wgid = (int)L; { const int q = nwg / NXCD, r = nwg % NXCD, xcd = wgid % NXCD, off = wgid / NXCD; wgid = (xcd < r ? xcd * (q + 1) : r * (q + 1) + (xcd - r) * q) + off; }
        const int nig = WGM * nN, gid = wgid / nig, fm = gid * WGM, gsz = (nM - fm) < WGM ? (nM - fm) : WGM;
        pm = fm + ((wgid % nig) % gsz); pn = (wgid % nig) / gsz; return true;
    }
};

template <class Epi, class Sched, int KGRP>
__device__ __forceinline__ void gemm_phase(LAS unsigned char* lds, const Gemm g, const Sched& S, const Epi& E) {
    int tid_ = threadIdx.x; asm volatile("" : "+v"(tid_));
    const int tid = tid_, wid = __builtin_amdgcn_readfirstlane(tid >> 6), lane = tid & 63, wr = wid >> 2, wc = wid & 3, fr = lane & 15, fq = lane >> 4;
    const int nt = g.nt;
    unsigned voffA[2], voffB[2];
#pragma unroll
    for (int i = 0; i < 2; ++i) { int R, C; stage_rc(tid * 16 + i * 8192, R, C); const int Rb = (R & ~31) + perm32(R & 31);
        voffA[i] = (unsigned)(R * g.lda + C) * 2u; voffB[i] = (unsigned)(Rb * g.ldb + C) * 2u; }
    const size_t kstep = (size_t)(BK * 2);
    const size_t hstepA = (size_t)HALF * g.lda * 2, hstepB = (size_t)HALF * g.ldb * 2;
    const unsigned ldsw = (unsigned)wid * 1024u;
    const int aoff = lds_byte(wr * 64 + fr, fq * 8), boff = lds_byte(wc * 32 + fr, fq * 8);
    auto koffA = [&](int t) -> size_t { if constexpr (KGRP > 0) return (size_t)(t / KGRP) * g.gstride + (size_t)(t % KGRP) * kstep; else return (size_t)t * kstep; };
#define PG8_SA(b, h) (((b) * 2 + (h)) * HTB)
#define PG8_SB(b, h) ((4 + (b) * 2 + (h)) * HTB)
#define PG8_STAGE(bufoff, gbase, voff) do { _Pragma("unroll") for (int _i = 0; _i < 2; ++_i) \
        __builtin_amdgcn_global_load_lds((const unsigned*)((const char*)(gbase) + (voff)[_i]), (LAS unsigned*)(lds + (bufoff) + ldsw + _i * 8192), 16, 0, 0); } while (0)
#define PG8_LDA(dst, b, h) do { _Pragma("unroll") for (int m = 0; m < 4; ++m) _Pragma("unroll") for (int k = 0; k < 2; ++k) dst[m][k] = *(const LAS bf16x8*)(lds + PG8_SA(b, h) + aoff + m * 2048 + k * 1024); } while (0)
#define PG8_LDB(dst, b, h) do { _Pragma("unroll") for (int n = 0; n < 2; ++n) _Pragma("unroll") for (int k = 0; k < 2; ++k) dst[n][k] = *(const LAS bf16x8*)(lds + PG8_SB(b, h) + boff + n * 2048 + k * 1024); } while (0)
#define PG8_MMA(ai, bj, At, Bt) do { __builtin_amdgcn_s_setprio(1); _Pragma("unroll") for (int m = 0; m < 4; ++m) _Pragma("unroll") for (int n = 0; n < 2; ++n) _Pragma("unroll") for (int k = 0; k < 2; ++k) \
        acc[ai][bj][m][n] = __builtin_amdgcn_mfma_f32_16x16x32_bf16(Bt[n][k], At[m][k], acc[ai][bj][m][n], 0, 0, 0); __builtin_amdgcn_s_setprio(0); } while (0)
#define PG8_WAIT_V(n) asm volatile("s_waitcnt vmcnt(" #n ")" ::: "memory")
#define PG8_WAIT_L(n) asm volatile("s_waitcnt lgkmcnt(" #n ")" ::: "memory")
#define PG8_BAR __builtin_amdgcn_s_barrier()
#define PG8_SCHED __builtin_amdgcn_sched_barrier(0)
    Unit cur, nxt; int ui = 0;
    if (!S.next(0, cur)) return;
    f32x4 acc[2][2][4][2];
#pragma unroll
    for (int a = 0; a < 2; ++a)
#pragma unroll
        for (int b = 0; b < 2; ++b)
#pragma unroll
            for (int m = 0; m < 4; ++m)
#pragma unroll
                for (int n = 0; n < 2; ++n) acc[a][b][m][n] = (f32x4){0.f, 0.f, 0.f, 0.f};
    bf16x8 At[4][2], B0[2][2], B1[2][2];
    const char* cA = cur.a; const char* cB = cur.b;
    PG8_STAGE(PG8_SB(0, 0), cB, voffB); PG8_STAGE(PG8_SB(0, 1), cB + hstepB, voffB); PG8_STAGE(PG8_SA(0, 0), cA, voffA); PG8_STAGE(PG8_SA(0, 1), cA + hstepA, voffA);
    if (wr == 1) PG8_BAR;
    PG8_WAIT_V(2); PG8_BAR;
    { const char* a1p = cA + koffA(1);
      PG8_STAGE(PG8_SB(1, 0), cB + kstep, voffB); PG8_STAGE(PG8_SA(1, 0), a1p, voffA); PG8_STAGE(PG8_SB(1, 1), cB + hstepB + kstep, voffB); }
    PG8_WAIT_V(6); PG8_BAR;
    for (;;) {
        const bool has_next = S.next(ui + 1, nxt);
        const char* nA = has_next ? nxt.a : cA; const char* nB = has_next ? nxt.b : cB;
        for (int t = 0; t < nt; t += 2) {
            const bool last = (t == nt - 2);
            const char* a1 = cA + koffA(t + 1);
            const char* a2 = last ? nA : cA + koffA(t + 2); const char* b2 = last ? nB : cB + (size_t)(t + 2) * kstep;
            const char* a3 = last ? nA + koffA(1) : cA + koffA(t + 3); const char* b3 = b2 + kstep;
            PG8_LDB(B0, 0, 0); PG8_LDB(B1, 0, 1); PG8_SCHED; PG8_LDA(At, 0, 0); PG8_STAGE(PG8_SA(1, 1), a1 + hstepA, voffA);
            PG8_WAIT_V(8); PG8_WAIT_L(0); PG8_BAR; PG8_MMA(0, 0, At, B0); PG8_MMA(0, 1, At, B1); PG8_BAR; PG8_SCHED;
            PG8_LDA(At, 0, 1); PG8_STAGE(PG8_SB(0, 0), b2, voffB); PG8_STAGE(PG8_SB(0, 1), b2 + hstepB, voffB); PG8_STAGE(PG8_SA(0, 0), a2, voffA);
            PG8_WAIT_V(8); PG8_WAIT_L(0); PG8_BAR; PG8_MMA(1, 0, At, B0); PG8_MMA(1, 1, At, B1); PG8_BAR; PG8_SCHED;
            PG8_LDB(B0, 1, 0); PG8_LDB(B1, 1, 1); PG8_SCHED; PG8_LDA(At, 1, 0); PG8_STAGE(PG8_SA(0, 1), a2 + hstepA, voffA);
            PG8_WAIT_V(8); PG8_WAIT_L(0); PG8_BAR; PG8_MMA(0, 0, At, B0); PG8_MMA(0, 1, At, B1); PG8_BAR; PG8_SCHED;
            PG8_LDA(At, 1, 1); PG8_STAGE(PG8_SB(1, 0), b3, voffB); PG8_STAGE(PG8_SB(1, 1), b3 + hstepB, voffB); PG8_STAGE(PG8_SA(1, 0), a3, voffA);
            PG8_WAIT_V(8); PG8_WAIT_L(0); PG8_BAR; PG8_MMA(1, 0, At, B0); PG8_MMA(1, 1, At, B1); PG8_BAR; PG8_SCHED;
        }
        if (wr == 0) PG8_BAR;
        const bool keep = E(acc, cur, wr, wc, fr, fq);
        if (!has_next) break;
        if (!keep) {
#pragma unroll
            for (int a = 0; a < 2; ++a)
#pragma unroll
                for (int b = 0; b < 2; ++b)
#pragma unroll
                    for (int m = 0; m < 4; ++m)
#pragma unroll
                        for (int n = 0; n < 2; ++n) acc[a][b][m][n] = (f32x4){0.f, 0.f, 0.f, 0.f};
        }
        cur = nxt; cA = nA; cB = nB; ++ui;
        if (wr == 1) PG8_BAR;
    }
    PG8_WAIT_V(0);
    PG8_BAR;
#undef PG8_SA
#undef PG8_SB
#undef PG8_STAGE
#undef PG8_LDA
#undef PG8_LDB
#undef PG8_MMA
#undef PG8_WAIT_V
#undef PG8_WAIT_L
#undef PG8_BAR
#undef PG8_SCHED
}
}
using pg8::Unit; using pg8::Gemm;
typedef f32x4 Acc[2][2][4][2];

struct SchedStd {
    pg8::StaticOrder so; const char* A; const char* B; size_t tA, tB;
    __device__ void init(const bf16_t* A_, int lda, const bf16_t* B_, int ldb, int M_, int N_, int G, int c) { so.init(M_, N_, G, c); A = (const char*)A_; B = (const char*)B_; tA = (size_t)256 * lda * 2; tB = (size_t)256 * ldb * 2; }
    __device__ bool next(int i, Unit& u) const { int pm, pn; if (!so.next(i, pm, pn)) return false; u.pm = pm; u.pn = pn; u.aux = 0; u.a = A + pm * tA; u.b = B + pn * tB; return true; }
};

struct EpiBf16 {
    bf16_t* O; int ldc;
    __device__ __forceinline__ bool operator()(Acc& acc, const Unit& u, int wr, int wc, int fr, int fq) const {
        const int row0 = u.pm * 256 + wr * 64 + fr, col0 = u.pn * 256 + wc * 32 + 8 * fq;
#pragma unroll
        for (int ai = 0; ai < 2; ++ai)
#pragma unroll
            for (int m = 0; m < 4; ++m) { bf16_t* rowp = O + (size_t)(row0 + ai * 128 + m * 16) * ldc + col0;
#pragma unroll
                for (int bj = 0; bj < 2; ++bj) { const f32x4 v0 = acc[ai][bj][m][0], v1 = acc[ai][bj][m][1];
                    u32x4 w; w.x = cvtpk(v0[0], v0[1]); w.y = cvtpk(v0[2], v0[3]); w.z = cvtpk(v1[0], v1[1]); w.w = cvtpk(v1[2], v1[3]);
                    *(u32x4*)(rowp + bj * 128) = w; } }
        return false;
    }
};
struct EpiSwiGLU {
    bf16_t* O; int ldc;
    __device__ __forceinline__ bool operator()(Acc& acc, const Unit& u, int wr, int wc, int fr, int fq) const {
        const int row0 = u.pm * 256 + wr * 64 + fr, col0 = u.pn * 128 + wc * 32 + 8 * fq;
#pragma unroll
        for (int ai = 0; ai < 2; ++ai)
#pragma unroll
            for (int m = 0; m < 4; ++m) { bf16_t* rowp = O + (size_t)(row0 + ai * 128 + m * 16) * ldc + col0;
                float h[8];
#pragma unroll
                for (int n = 0; n < 2; ++n)
#pragma unroll
                    for (int e = 0; e < 4; ++e) { const float gt = acc[ai][0][m][n][e], up = acc[ai][1][m][n][e]; h[n * 4 + e] = gt * sigmoidf_(gt) * up; }
                u32x4 w; w.x = cvtpk(h[0], h[1]); w.y = cvtpk(h[2], h[3]); w.z = cvtpk(h[4], h[5]); w.w = cvtpk(h[6], h[7]);
                *(u32x4*)rowp = w; }
        return false;
    }
};
struct EpiSlab {
    float* P;
    __device__ __forceinline__ bool operator()(Acc& acc, const Unit& u, int wr, int wc, int fr, int fq) const {
        float* base = P + (size_t)u.aux * 65536;
#pragma unroll
        for (int ai = 0; ai < 2; ++ai)
#pragma unroll
            for (int m = 0; m < 4; ++m) { float* rowp = base + (size_t)(ai * 128 + wr * 64 + m * 16 + fr) * 256 + wc * 32 + 8 * fq;
#pragma unroll
                for (int bj = 0; bj < 2; ++bj) { *(f32x4*)(rowp + bj * 128) = acc[ai][bj][m][0]; *(f32x4*)(rowp + bj * 128 + 4) = acc[ai][bj][m][1]; } }
        return false;
    }
};
struct EpiQKV {
    bf16_t* Q; bf16_t* KV;
    __device__ __forceinline__ bool operator()(Acc& acc, const Unit& u, int wr, int wc, int fr, int fq) const {
        EpiBf16 e{u.aux ? KV : Q, u.aux ? 2048 : 1536}; return e(acc, u, wr, wc, fr, fq);
    }
};
struct EpiMerge {
    const bf16_t* Z; bf16_t* O;
    __device__ __forceinline__ bool operator()(Acc& acc, const Unit& u, int wr, int wc, int fr, int fq) const {
        const int row0 = u.pm * 256 + wr * 64 + fr, col0 = u.pn * 256 + wc * 32 + 8 * fq;
#pragma unroll
        for (int ai = 0; ai < 2; ++ai)
#pragma unroll
            for (int m = 0; m < 4; ++m) { const size_t row = (size_t)(row0 + ai * 128 + m * 16);
#pragma unroll
                for (int bj = 0; bj < 2; ++bj) { const int col = col0 + bj * 128;
                    const u32x4 gbw = *(const u32x4*)(Z + row * DINP + ZO_GB + col);
                    float gb[8] = {sigmoidf_(bflo(gbw.x)), sigmoidf_(bfhi(gbw.x)), sigmoidf_(bflo(gbw.y)), sigmoidf_(bfhi(gbw.y)), sigmoidf_(bflo(gbw.z)), sigmoidf_(bfhi(gbw.z)), sigmoidf_(bflo(gbw.w)), sigmoidf_(bfhi(gbw.w))};
                    if (u.aux == 0) {
                        const u32x4 gaw = *(const u32x4*)(Z + row * DINP + ZO_GA + col);
                        float ga[8] = {sigmoidf_(bflo(gaw.x)), sigmoidf_(bfhi(gaw.x)), sigmoidf_(bflo(gaw.y)), sigmoidf_(bfhi(gaw.y)), sigmoidf_(bflo(gaw.z)), sigmoidf_(bfhi(gaw.z)), sigmoidf_(bflo(gaw.w)), sigmoidf_(bfhi(gaw.w))};
#pragma unroll
                        for (int n = 0; n < 2; ++n)
#pragma unroll
                            for (int e = 0; e < 4; ++e) acc[ai][bj][m][n][e] *= ga[n * 4 + e] / gb[n * 4 + e];
                    } else {
                        float h[8];
#pragma unroll
                        for (int n = 0; n < 2; ++n)
#pragma unroll
                            for (int e = 0; e < 4; ++e) h[n * 4 + e] = acc[ai][bj][m][n][e] * gb[n * 4 + e];
                        u32x4 w; w.x = cvtpk(h[0], h[1]); w.y = cvtpk(h[2], h[3]); w.z = cvtpk(h[4], h[5]); w.w = cvtpk(h[6], h[7]);
                        *(u32x4*)(O + row * 2048 + col) = w;
                    } } }
        return u.aux == 0;
    }
};

struct Args { const float* in[30]; float* out; unsigned char* ws; int ph_lo, ph_hi; };
enum { I_X = 0, I_POS, I_RELB, I_F1PRE, I_F1POST, I_F1G, I_F1U, I_F1D, I_MPRE, I_MPOST, I_WIN, I_QNG, I_WQUP, I_KVNG, I_WUK, I_WUV, I_PEK, I_W1K, I_W2K, I_PEV, I_W1V, I_W2V, I_WA, I_WB, I_WOUT,
       I_F2PRE, I_F2POST, I_F2G, I_F2U, I_F2D };
struct Frame {
    LAS unsigned char* lds; int tid, lane, wave, G, cu;
    const float* const* in; float* out; unsigned char* ws;
};

__device__ __forceinline__ void launder(Frame& F) { unsigned long long w_ = (unsigned long long)F.ws; unsigned lo_ = (unsigned)w_, hi_ = (unsigned)(w_ >> 32);
    asm volatile("" : "+v"(F.tid), "+v"(F.lane), "+v"(lo_), "+v"(hi_));
    lo_ = (unsigned)__builtin_amdgcn_readfirstlane((int)lo_); hi_ = (unsigned)__builtin_amdgcn_readfirstlane((int)hi_); F.ws = (unsigned char*)(((unsigned long long)hi_ << 32) | lo_); }
__device__ __forceinline__ void p0_transpose_item(const float* W, int K, int N, bf16_t* WT, int ldk, int koff, int mode, int row_off, LAS float* scr, int item, int lane) {
    const int nblk = (N + 31) / 32, kb = item / nblk, nb = item % nblk, k0 = 64 * kb, n0 = 32 * nb;
    const bool nok = (n0 + (lane & 31)) < N;
#pragma unroll 8
    for (int i = 0; i < 32; ++i) { const int kk = 2 * i + (lane >> 5); scr[kk * 33 + (lane & 31)] = nok ? W[(size_t)(k0 + kk) * N + n0 + (lane & 31)] : 0.f; }
    asm volatile("s_waitcnt lgkmcnt(0)" ::: "memory");
    const int c = lane & 7;
    const int rbase = mode ? ((n0 >> 7) * 256 + row_off + (n0 & 127)) : (row_off + n0);
#pragma unroll
    for (int j = 0; j < 4; ++j) { const int n = (lane >> 3) + 8 * j; const LAS float* s = scr + (8 * c) * 33 + n;
        u32x4 o; o.x = cvtpk(s[0 * 33], s[1 * 33]); o.y = cvtpk(s[2 * 33], s[3 * 33]); o.z = cvtpk(s[4 * 33], s[5 * 33]); o.w = cvtpk(s[6 * 33], s[7 * 33]);
        if (n0 + n < N) *(u32x4*)(WT + (size_t)(rbase + n) * ldk + koff + k0 + 8 * c) = o; }
    asm volatile("s_waitcnt lgkmcnt(0)" ::: "memory");
}
struct CvtJob { int in_idx, K, N, ldk, koff, mode, row_off; size_t dst_off; };
__device__ __forceinline__ CvtJob cvt_job(int j) {
    switch (j) {
    case 0:  return CvtJob{I_F1G, D, FF, D, 0, 1, 0, WO_GU1};
    case 1:  return CvtJob{I_F1U, D, FF, D, 0, 1, 128, WO_GU1};
    case 2:  return CvtJob{I_F1D, FF, D, FF, 0, 0, 0, WO_D1};
    case 3:  return CvtJob{I_F2G, D, FF, D, 0, 1, 0, WO_GU2};
    case 4:  return CvtJob{I_F2U, D, FF, D, 0, 1, 128, WO_GU2};
    case 5:  return CvtJob{I_F2D, FF, D, FF, 0, 0, 0, WO_D2};
    case 6:  return CvtJob{I_WIN, D, DIN, D, 0, 0, 0, WO_IN};
    case 7:  return CvtJob{I_WQUP, 512, 1536, 512, 0, 0, 0, WO_Q};
    case 8:  return CvtJob{I_WUK, 512, 1024, 512, 0, 0, 0, WO_UKV};
    case 9:  return CvtJob{I_WUV, 512, 1024, 512, 0, 0, 1024, WO_UKV};
    case 10: return CvtJob{I_W1K, 6144, 256, 6144, 0, 0, 0, WO_1K};
    case 11: return CvtJob{I_W1V, 4096, 256, 4096, 0, 0, 0, WO_1V};
    case 12: return CvtJob{I_WA, 1024, 2048, 2048, 0, 0, 0, WO_AB};
    case 13: return CvtJob{I_WB, 1024, 2048, 2048, 1024, 0, 0, WO_AB};
    default: return CvtJob{I_WOUT, 2048, 2048, 2048, 0, 0, 0, WO_OUT};
    }
}
constexpr int N_CVT_JOBS = 15;
__device__ __forceinline__ void p0_prologue(Frame& F) {
    LAS float* scr = (LAS float*)(F.lds + F.wave * 16384);
    const int gw = F.cu * 8 + F.wave, NGW = F.G * 8;
    bf16_t* wbase = (bf16_t*)(F.ws + WS_W);
    for (int l = 0; l < NL; ++l)
        for (int j = 0; j < N_CVT_JOBS; ++j) {
            const CvtJob J = cvt_job(j);
            const float* src = F.in[J.in_idx] + (size_t)l * J.K * J.N;
            bf16_t* dst = wbase + (size_t)l * WO_END + J.dst_off;
            const int nitems = (J.K / 64) * ((J.N + 31) / 32);
            for (int it = gw; it < nitems; it += NGW) p0_transpose_item(src, J.K, J.N, dst, J.ldk, J.koff, J.mode, J.row_off, scr, it, F.lane);
        }
    {
        const f32x4* xs = (const f32x4*)F.in[I_X]; f32x4* xd = (f32x4*)(F.ws + WS_X);
        for (size_t i = (size_t)F.cu * 512 + F.tid; i < (size_t)M * D / 4; i += (size_t)F.G * 512) xd[i] = xs[i];
        const int* pos = (const int*)F.in[I_POS]; f32x2* rope = (f32x2*)(F.ws + WS_ROPE);
        for (int i = F.cu * 512 + F.tid; i < M * 32; i += F.G * 512) {
            const float ang = (float)pos[i >> 5] * ROPE_INV[i & 31];
            const double rev = (double)ang * 0.15915494309189535; const float fr = (float)(rev - __builtin_rint(rev));
            rope[i] = (f32x2){__builtin_amdgcn_cosf(fr), __builtin_amdgcn_sinf(fr)};
        }
        float* tbl = (float*)(F.ws + WS_TBL);
        if (F.cu == 0) for (int i = F.tid; i < 8 * 132; i += 512) { const int h = i / 132, d = i % 132; const float tv = F.in[I_RELB][REL_BUCKET[d > 128 ? 128 : d] * 8 + h]; tbl[i] = tv; ((float*)(F.ws + WS_TBL + 16384))[i] = tv * 1.4426950408889634f; }
        if (F.cu >= 1 && F.cu <= 2 * NL) {
            const int l = (F.cu - 1) >> 1, kv = (F.cu - 1) & 1, Kk = kv ? 4096 : 6144;
            const float* pe = F.in[kv ? I_PEV : I_PEK] + (size_t)l * Kk; const float* w1 = F.in[kv ? I_W1V : I_W1K] + (size_t)l * Kk * 256;
            const int c = F.tid & 255, hf = F.tid >> 8; float s = 0.f;
            for (int k = hf * (Kk / 2); k < (hf + 1) * (Kk / 2); ++k) s += pe[k] * w1[(size_t)k * 256 + c];
            LAS float* red = (LAS float*)F.lds;
            __syncthreads();
            if (hf) red[c] = s;
            __syncthreads();
            if (!hf) ((float*)(F.ws + WS_TBL + 8192))[(l * 2 + kv) * 256 + c] = s + red[c];
            __syncthreads();
        }
    }
}

__device__ __forceinline__ void thin_first_norm(Frame& F, const float* g) {
    const int gw = F.cu * 8 + F.wave, NGW = F.G * 8;
    const float* X = (const float*)(F.ws + WS_X); bf16_t* U = (bf16_t*)(F.ws + WS_U);
    for (int m = gw; m < M; m += NGW) {
        const f32x4* xr = (const f32x4*)(X + (size_t)m * D) + F.lane; f32x4 v[8]; float s = 0.f;
#pragma unroll
        for (int j = 0; j < 8; ++j) { v[j] = xr[64 * j]; s += (v[j].x * v[j].x + v[j].y * v[j].y) + (v[j].z * v[j].z + v[j].w * v[j].w); }
        const float r = 1.0f / sqrtf(wave_sum(s) * (1.f / D) + EPS);
        u32x2* o = (u32x2*)(U + (size_t)m * D) + F.lane;
#pragma unroll
        for (int j = 0; j < 8; ++j) { const f32x4 gg = ((const f32x4*)g)[F.lane + 64 * j]; o[64 * j] = (u32x2){cvtpk(v[j].x * r * gg.x, v[j].y * r * gg.y), cvtpk(v[j].z * r * gg.z, v[j].w * r * gg.w)}; }
    }
}
__device__ __forceinline__ void thin_post_norm(Frame& F, float coef, const float* gpost, const float* gpre, float* outp) {
    const int gw = F.cu * 8 + F.wave, NGW = F.G * 8;
    float* X = (float*)(F.ws + WS_X); bf16_t* U = (bf16_t*)(F.ws + WS_U); const bf16_t* Y = (const bf16_t*)(F.ws + WS_Y);
    for (int m = gw; m < M; m += NGW) {
        f32x4* xr = (f32x4*)(X + (size_t)m * D) + F.lane; const u32x2* yr = (const u32x2*)(Y + (size_t)m * D) + F.lane;
        f32x4 y[8]; float s = 0.f;
#pragma unroll
        for (int j = 0; j < 8; ++j) { const u32x2 w = yr[64 * j]; y[j] = (f32x4){bflo(w.x), bfhi(w.x), bflo(w.y), bfhi(w.y)}; s += (y[j].x * y[j].x + y[j].y * y[j].y) + (y[j].z * y[j].z + y[j].w * y[j].w); }
        const float r = coef / sqrtf(wave_sum(s) * (1.f / D) + EPS);
        float s2 = 0.f;
#pragma unroll
        for (int j = 0; j < 8; ++j) { const f32x4 gg = ((const f32x4*)gpost)[F.lane + 64 * j]; f32x4 x = xr[64 * j];
            x.x += y[j].x * r * gg.x; x.y += y[j].y * r * gg.y; x.z += y[j].z * r * gg.z; x.w += y[j].w * r * gg.w; y[j] = x;
            s2 += (x.x * x.x + x.y * x.y) + (x.z * x.z + x.w * x.w);
            if (outp) ((f32x4*)(outp + (size_t)m * D))[F.lane + 64 * j] = x; else xr[64 * j] = x; }
        if (gpre) {
            const float r2 = 1.0f / sqrtf(wave_sum(s2) * (1.f / D) + EPS);
            u32x2* o = (u32x2*)(U + (size_t)m * D) + F.lane;
#pragma unroll
            for (int j = 0; j < 8; ++j) { const f32x4 gg = ((const f32x4*)gpre)[F.lane + 64 * j]; o[64 * j] = (u32x2){cvtpk(y[j].x * r2 * gg.x, y[j].y * r2 * gg.y), cvtpk(y[j].z * r2 * gg.z, y[j].w * r2 * gg.w)}; }
        }
    }
}
__device__ __forceinline__ void thin_mix(Frame& F, const float* gq, const float* gkv) {
    const int gw = F.cu * 8 + F.wave, NGW = F.G * 8;
    const bf16_t* Z = (const bf16_t*)(F.ws + WS_Z); bf16_t* C = (bf16_t*)(F.ws + WS_CQKV); bf16_t* KPE = (bf16_t*)(F.ws + WS_KPE); const f32x2* rope = (const f32x2*)(F.ws + WS_ROPE);
    for (int m = gw; m < M; m += NGW) {
        const bf16_t* zr = Z + (size_t)m * DINP;
#pragma unroll
        for (int part = 0; part < 2; ++part) {
            const u32x4 w = *((const u32x4*)(zr + part * 512) + F.lane);
            float v[8] = {bflo(w.x), bfhi(w.x), bflo(w.y), bfhi(w.y), bflo(w.z), bfhi(w.z), bflo(w.w), bfhi(w.w)}; float s = 0.f;
#pragma unroll
            for (int e = 0; e < 8; ++e) s += v[e] * v[e];
            const float r = 1.0f / sqrtf(wave_sum(s) * (1.f / 512.f) + EPS);
            const float* g = (part ? gkv : gq) + 8 * F.lane; const f32x4 g0 = *(const f32x4*)g, g1 = *(const f32x4*)(g + 4);
            u32x4 o; o.x = cvtpk(v[0] * r * g0.x, v[1] * r * g0.y); o.y = cvtpk(v[2] * r * g0.z, v[3] * r * g0.w); o.z = cvtpk(v[4] * r * g1.x, v[5] * r * g1.y); o.w = cvtpk(v[6] * r * g1.z, v[7] * r * g1.w);
            *((u32x4*)(C + (size_t)m * 1024 + part * 512) + F.lane) = o;
        }
        if (F.lane < 32) {
            const float x1 = bf1(zr[ZO_KR + F.lane]), x2 = bf1(zr[ZO_KR + 32 + F.lane]); const f32x2 cs = rope[(size_t)m * 32 + F.lane];
            const unsigned a = cvtpk(x1 * cs.x - x2 * cs.y, x1 * cs.y + x2 * cs.x);
            KPE[(size_t)m * 64 + F.lane] = (bf16_t)(a & 0xffffu); KPE[(size_t)m * 64 + 32 + F.lane] = (bf16_t)(a >> 16);
        }
    }
}
__device__ __forceinline__ void cmp_stage2_unit(Frame& F, int unit, int l) {
    const int kv = unit >> 6, u = unit & 63, g = u >> 5, r0 = (u & 31) * 16;
    const int NO = kv ? 128 : 192;
    const float* part = (const float*)(F.ws + WS_PART); const float* pb = (const float*)(F.ws + WS_TBL + 8192) + (l * 2 + kv) * 256;
    const float* w2 = F.in[kv ? I_W2V : I_W2K] + (size_t)l * 256 * NO;
    LAS float* hid = (LAS float*)F.lds;
    __syncthreads();
    {
        const int row = F.tid >> 5, c0 = (F.tid & 31) * 8, rp = r0 + row, rt = rp >> 8, rr = rp & 255;
        f32x4 s0 = *(const f32x4*)(pb + c0), s1 = *(const f32x4*)(pb + c0 + 4);
#pragma unroll
        for (int s = 0; s < 8; ++s) { const float* p = part + (size_t)((((kv * 2 + g) * 2 + rt) * 8) + s) * 65536 + (size_t)rr * 256 + c0; s0 += *(const f32x4*)p; s1 += *(const f32x4*)(p + 4); }
        float h[8] = {s0.x, s0.y, s0.z, s0.w, s1.x, s1.y, s1.z, s1.w};
#pragma unroll
        for (int e = 0; e < 8; ++e) hid[row * 256 + c0 + e] = h[e] * sigmoidf_(h[e]);
    }
    __syncthreads();
    bf16_t* dst = (bf16_t*)(F.ws + WS_KC + (kv ? 524288 : 0));
    for (int o = F.tid; o < 16 * NO; o += 512) {
        const int row = o / NO, n = o % NO; float a = 0.f;
#pragma unroll 8
        for (int c = 0; c < 256; ++c) a += hid[row * 256 + c] * w2[c * NO + n];
        const int rp = r0 + row, b = rp >> 7, nn = rp & 127;
        dst[(size_t)((b * 2 + g) * 128 + nn) * NO + n] = (bf16_t)(cvtpk(a, 0.f) & 0xffffu);
    }
}

template <bool ROPE>
__device__ __forceinline__ void load_q(Frame& F, const bf16_t* qp, float scale, LAS float* qs, const f32x2* rope_row) {
    if (F.lane < 24) { const u32x4 w = *((const u32x4*)qp + F.lane); LAS float* d = qs + 8 * F.lane;
        d[0] = bflo(w.x) * scale; d[1] = bfhi(w.x) * scale; d[2] = bflo(w.y) * scale; d[3] = bfhi(w.y) * scale; d[4] = bflo(w.z) * scale; d[5] = bfhi(w.z) * scale; d[6] = bflo(w.w) * scale; d[7] = bfhi(w.w) * scale; }
    if (ROPE) { if (F.lane < 32) { const float x1 = qs[128 + F.lane], x2 = qs[160 + F.lane]; const f32x2 cs = rope_row[F.lane]; qs[128 + F.lane] = x1 * cs.x - x2 * cs.y; qs[160 + F.lane] = x1 * cs.y + x2 * cs.x; } }
}
__device__ __forceinline__ float dot8(const u32x4 w, const LAS float* q) {
    const f32x4 a = *(const LAS f32x4*)q, b = *(const LAS f32x4*)(q + 4);
    return (bflo(w.x) * a.x + bfhi(w.x) * a.y) + (bflo(w.y) * a.z + bfhi(w.y) * a.w) + (bflo(w.z) * b.x + bfhi(w.z) * b.y) + (bflo(w.w) * b.z + bfhi(w.w) * b.w);
}
template <int MODE>
__device__ __forceinline__ void naive_row(Frame& F, int b, int t, int head, float gate, float& o0, float& o1, LAS float* sc, const LAS float* qs, unsigned selmask, int& nk_out) {
    const int g = head >> 2; const size_t mb = (size_t)b * SEQ;
    const bf16_t* Z = (const bf16_t*)(F.ws + WS_Z); const bf16_t* KV = (const bf16_t*)(F.ws + WS_KV); const bf16_t* KPE = (const bf16_t*)(F.ws + WS_KPE);
    const bf16_t* KC = (const bf16_t*)(F.ws + WS_KC); const bf16_t* VC = (const bf16_t*)(F.ws + WS_KC + 524288);
    const float* tbl = (const float*)(F.ws + WS_TBL) + head * 132; const int* pos = (const int*)F.in[I_POS] + mb;
    const int k0 = (MODE == 2) ? (t > 511 ? t - 511 : 0) : 0;
    const int k1 = (MODE == 3) ? (t < 31 ? -1 : (t - 31) / 16) : t;
    nk_out = k1 - k0 + 1;
    if (k1 < k0) return;
    const int qpos = (MODE != 0) ? pos[t] : 0;
    float mx = -INFINITY;
    for (int kb = k0; kb <= k1; kb += 64) {
        const int k = kb + F.lane; bool valid = k <= k1;
        if (MODE == 1) valid = valid && ((selmask >> (k >> 6)) & 1u);
        float s = -INFINITY;
        if (valid) {
            const bf16_t* p1; const bf16_t* p2;
            if (MODE == 0) { p1 = KV + (mb + k) * 2048 + head * 128; p2 = KPE + (mb + k) * 64; }
            else if (MODE == 1) { p1 = Z + (mb + k) * DINP + ZO_KS + g * 192; p2 = p1 + 128; }
            else if (MODE == 2) { p1 = Z + (mb + k) * DINP + ZO_KW + g * 192; p2 = p1 + 128; }
            else { p1 = KC + (size_t)((b * 2 + g) * 128 + k) * 192; p2 = p1 + 128; }
            float d = 0.f;
#pragma unroll
            for (int c = 0; c < 16; ++c) d += dot8(*((const u32x4*)p1 + c), qs + 8 * c);
#pragma unroll
            for (int c = 0; c < 8; ++c) d += dot8(*((const u32x4*)p2 + c), qs + 128 + 8 * c);
            if (MODE != 0) { const int kp = (MODE == 3) ? pos[16 * k + 31] : pos[k]; int dd = qpos - kp; dd = dd < 0 ? 0 : (dd > 128 ? 128 : dd); d += tbl[dd]; }
            s = d;
        }
        if (k <= k1) sc[k - k0] = s;
        mx = fmaxf(mx, s);
    }
    mx = wave_max(mx);
    float sum = 0.f;
    for (int kb = k0; kb <= k1; kb += 64) { const int k = kb + F.lane; if (k <= k1) { const float p = __expf(sc[k - k0] - mx); sc[k - k0] = p; sum += p; } }
    sum = wave_sum(sum);
    const float inv = 1.0f / sum;
    float a0 = 0.f, a1 = 0.f;
    for (int k = k0; k <= k1; ++k) {
        if (MODE == 1) { if (!((selmask >> (k >> 6)) & 1u)) { k |= 63; continue; } }
        const float p = sc[k - k0];
        const bf16_t* vp;
        if (MODE == 0) vp = KV + (mb + k) * 2048 + 1024 + head * 128;
        else if (MODE == 1) vp = Z + (mb + k) * DINP + ZO_VS + g * 128;
        else if (MODE == 2) vp = Z + (mb + k) * DINP + ZO_VW + g * 128;
        else vp = VC + (size_t)((b * 2 + g) * 128 + k) * 128;
        const unsigned w = *((const unsigned*)vp + F.lane);
        a0 += p * bflo(w); a1 += p * bfhi(w);
    }
    o0 += gate * inv * a0; o1 += gate * inv * a1;
    if (MODE == 3) { for (int kb = 0; kb <= k1; kb += 64) { const int k = kb + F.lane; if (k <= k1) sc[k] *= inv; } }
}
__device__ __forceinline__ void naive_cmp_phase(Frame& F) {
    const int gw = F.cu * 8 + F.wave, NGW = F.G * 8;
    LAS float* sc = (LAS float*)(F.lds + F.wave * 8192); LAS float* qs = (LAS float*)(F.lds + 65536 + F.wave * 1024); LAS float* ps = (LAS float*)(F.lds + 65536 + 8192 + F.wave * 512);
    const bf16_t* Z = (const bf16_t*)(F.ws + WS_Z); float* OC = (float*)(F.ws + WS_OC); unsigned* SEL = (unsigned*)(F.ws + WS_SEL);
    for (int r = gw; r < M * 2; r += NGW) {
        const int g = r & 1, m = r >> 1, b = m / SEQ, t = m % SEQ;
        ps[F.lane] = 0.f; ps[F.lane + 64] = 0.f;
        for (int j = 0; j < 4; ++j) {
            const int head = g * 4 + j; int nk = 0;
            load_q<false>(F, Z + (size_t)m * DINP + ZO_NQ + head * 192, 0.07216878364870322f, qs, nullptr);
            float o0 = 0.f, o1 = 0.f;
            const float g0 = sigmoidf_(bf1(Z[(size_t)m * DINP + ZO_NG + head * 3 + 0]));
            naive_row<3>(F, b, t, head, g0, o0, o1, sc, qs, 0u, nk);
            *(f32x2*)(OC + (size_t)m * 1024 + head * 128 + 2 * F.lane) = (f32x2){o0, o1};
            if (F.lane < nk) ps[F.lane] += sc[F.lane];
            if (F.lane + 64 < nk) ps[F.lane + 64] += sc[F.lane + 64];
        }
        const int mm = F.lane & 31; float imp = 0.f;
#pragma unroll
        for (int n = -1; n < 4; ++n) { const int nn = 4 * mm + n; if (nn >= 0 && nn < 128) imp += ps[nn]; }
        const int cur = t >> 6; const bool valid = mm <= cur, forced = valid && (mm == 0 || mm >= cur - 1);
        const float scv = forced ? 1e6f : (valid ? imp : -1.0f);
        int rank = 0;
#pragma unroll
        for (int o = 0; o < 32; ++o) { const float v = __shfl(scv, o); rank += (v > scv || (v == scv && o < mm)) ? 1 : 0; }
        const bool sel = (rank < 16) && (scv >= 0.f) && (F.lane < 32);
        const unsigned long long bal = __ballot(sel);
        if (F.lane == 0) SEL[(size_t)(b * 2 + g) * SEQ + t] = (unsigned)bal;
    }
}
__device__ __forceinline__ void naive_attn_phase(Frame& F) {
    const int gw = F.cu * 8 + F.wave, NGW = F.G * 8;
    LAS float* sc = (LAS float*)(F.lds + F.wave * 8192); LAS float* qs = (LAS float*)(F.lds + 65536 + F.wave * 1024);
    const bf16_t* Z = (const bf16_t*)(F.ws + WS_Z); const bf16_t* QM = (const bf16_t*)(F.ws + WS_QM); bf16_t* AB = (bf16_t*)(F.ws + WS_AB);
    const float* OC = (const float*)(F.ws + WS_OC); const unsigned* SEL = (const unsigned*)(F.ws + WS_SEL); const f32x2* rope = (const f32x2*)(F.ws + WS_ROPE);
    for (int r = gw; r < M * 8; r += NGW) {
        const int head = r & 7, m = r >> 3, b = m / SEQ, t = m % SEQ; int nk;
        load_q<true>(F, QM + (size_t)m * 1536 + head * 192, 0.07216878364870322f, qs, rope + (size_t)m * 32);
        float o0 = 0.f, o1 = 0.f;
        naive_row<0>(F, b, t, head, 1.0f, o0, o1, sc, qs, 0u, nk);
        *((unsigned*)(AB + (size_t)m * 2048 + head * 128) + F.lane) = cvtpk(o0, o1);
    }
    for (int r = gw; r < M * 8; r += NGW) {
        const int head = r & 7, m = r >> 3, b = m / SEQ, t = m % SEQ, g = head >> 2; int nk;
        const unsigned selmask = (unsigned)__builtin_amdgcn_readfirstlane((int)SEL[(size_t)(b * 2 + g) * SEQ + t]);
        load_q<false>(F, Z + (size_t)m * DINP + ZO_NQ + head * 192, 0.07216878364870322f, qs, nullptr);
        const float g1 = sigmoidf_(bf1(Z[(size_t)m * DINP + ZO_NG + head * 3 + 1])), g2 = sigmoidf_(bf1(Z[(size_t)m * DINP + ZO_NG + head * 3 + 2]));
        const f32x2 oc = *(const f32x2*)(OC + (size_t)m * 1024 + head * 128 + 2 * F.lane);
        float o0 = oc.x, o1 = oc.y;
        naive_row<1>(F, b, t, head, g1, o0, o1, sc, qs, selmask, nk);
        naive_row<2>(F, b, t, head, g2, o0, o1, sc, qs, 0u, nk);
        *((unsigned*)(AB + (size_t)m * 2048 + 1024 + head * 128) + F.lane) = cvtpk(o0, o1);
    }
}

namespace att {
typedef float f32x16 __attribute__((ext_vector_type(16)));
typedef short s16x4 __attribute__((ext_vector_type(4)));
typedef int i32x4 __attribute__((ext_vector_type(4)));
constexpr int KROW = 400, KBUF = 64 * KROW, VBUF = 64 * 256;
constexpr int L_K = 0, L_V = 2 * KBUF, L_KPOS = L_V + 2 * VBUF, L_KPMAX = L_KPOS + 512, L_TBL = L_KPMAX + 64, L_MISC = L_TBL + 8 * 132 * 4;
static_assert(L_MISC + 256 <= RING_BYTES, "attention LDS map");
constexpr float SL = 0.07216878364870322f * 1.4426950408889634f;
__device__ const unsigned char CLS_TYPE[40] = {1,1,1,1,1,1,1,1,1,0,1,1,1,1,0,1,1,1,1,0,1,1,1,1,0,1,1,1,0,1,1,0,1,1,0,1,1,0,1,1};
__device__ const unsigned char CLS_QB[40] = {31,30,29,28,27,26,25,24,23,7,22,21,20,19,6,18,17,16,15,5,14,13,12,11,4,10,9,8,3,7,6,2,5,4,1,3,2,0,1,0};
__device__ const unsigned short CLS_START[41] = {0,8,16,24,32,40,48,56,64,72,104,112,120,128,136,168,176,184,192,200,232,240,248,256,264,296,304,312,320,352,360,368,400,408,416,448,456,464,496,504,512};
__device__ __forceinline__ unsigned offb(unsigned row, unsigned ch) { return 256u * row + 16u * (ch ^ (((row & 3u) << 2) | ((row >> 2) & 3u))); }
struct Src { const bf16_t* k1; const bf16_t* k2; const bf16_t* v; int ldk1, ldk2, ldv; };
struct Stage { u32x4 k[3]; u32x4 v[2]; int kp; };
__device__ __forceinline__ void stage_load(Stage& st, const Src& s, int tile, int tid, const int* posb) {
    const unsigned vo1 = (unsigned)((tid >> 4) * s.ldk1 + (tid & 15) * 8) * 2u, vo2 = (unsigned)((tid >> 3) * s.ldk2 + (tid & 7) * 8) * 2u;
    const char* b1 = (const char*)s.k1 + (size_t)tile * 64 * s.ldk1 * 2; const char* b2 = (const char*)s.k2 + (size_t)tile * 64 * s.ldk2 * 2; const char* bv = (const char*)s.v + (size_t)tile * 64 * s.ldv * 2;
    st.k[0] = *(const u32x4*)(b1 + vo1); st.k[1] = *(const u32x4*)(b1 + (size_t)32 * s.ldk1 * 2 + vo1); st.k[2] = *(const u32x4*)(b2 + vo2);
    st.v[0] = *(const u32x4*)(bv + vo1); st.v[1] = *(const u32x4*)(bv + (size_t)32 * s.ldv * 2 + vo1);
    if (posb != nullptr && tid < 64) st.kp = posb[tile * 64 + tid];
}
__device__ __forceinline__ void stage_store(const Stage& st, LAS unsigned char* lds, int buf, int tid, bool haspos) {
    const int rowA = tid >> 4, chA = tid & 15;
    LAS unsigned char* ka = lds + L_K + buf * KBUF + rowA * KROW + chA * 16;
    *(LAS u32x4*)ka = st.k[0]; *(LAS u32x4*)(ka + 32 * KROW) = st.k[1];
    *(LAS u32x4*)(lds + L_K + buf * KBUF + (tid >> 3) * KROW + (16 + (tid & 7)) * 16) = st.k[2];
    LAS unsigned char* va = lds + L_V + buf * VBUF + offb(rowA, chA);
    *(LAS u32x4*)va = st.v[0]; *(LAS u32x4*)(va + 8192) = st.v[1];
    if (haspos && tid < 64) { ((LAS int*)(lds + L_KPOS))[buf * 64 + tid] = st.kp; int mx = st.kp;
#pragma unroll
        for (int o = 1; o < 64; o <<= 1) { const int t = __shfl_xor(mx, o); mx = t > mx ? t : mx; }
        if (tid == 0) ((LAS int*)(lds + L_KPMAX))[buf] = mx; }
}
__device__ __forceinline__ s16x4 vtr(const LAS unsigned char* p) { typedef short v4i16_t __attribute__((ext_vector_type(4))); return __builtin_bit_cast(s16x4, __builtin_amdgcn_ds_read_tr16_b64_v4i16((LAS v4i16_t*)p)); }

#define ATT_ZERO16 {0.f,0.f,0.f,0.f,0.f,0.f,0.f,0.f,0.f,0.f,0.f,0.f,0.f,0.f,0.f,0.f}
template <int MODE>
__device__ __forceinline__ void run_pass(Frame& F, const Src& src, unsigned tmask, const bf16x8 (&qf)[12], f32x16 (&oacc)[4], float& m_run, float& l_run,
                                         int tq, int tq_wmin, int tq_wmax, unsigned selq, int qpos, int qpos_wmin, int head, const int* posb) {
    if (tmask == 0u) return;
    const int tid = F.tid, lane = F.lane, r = lane & 31, hh = lane >> 5;
    LAS unsigned char* lds = F.lds;
    int tile = __builtin_ctz(tmask); unsigned rem = tmask & (tmask - 1u);
    Stage st; st.kp = 0;
    stage_load(st, src, tile, tid, posb); stage_store(st, lds, 0, tid, posb != nullptr); __syncthreads();
    int buf = 0;
    const LAS float* tblh = (const LAS float*)(lds + L_TBL) + head * 132;
    for (;;) {
        const int nxt = rem ? __builtin_ctz(rem) : -1;
        if (nxt >= 0) stage_load(st, src, nxt, tid, posb);
        const bool active = (MODE != 0) || (tile * 64 <= tq_wmax);
        if (active) {
            const LAS unsigned char* kb_ = lds + L_K + buf * KBUF + r * KROW + 16 * hh;
            const LAS unsigned char* vbuf = lds + L_V + buf * VBUF;
            bool far = true; if (MODE != 0) { const int kpmax = __builtin_amdgcn_readfirstlane(((const LAS int*)(lds + L_KPMAX))[buf]); far = (qpos_wmin - kpmax >= 128); }
            int lim = tq - tile * 64 - 4 * hh;
            if (MODE == 1) { if (!((selq >> tile) & 1u)) lim = -1; }
            const bool need = (MODE == 1) || (MODE == 2) || (tile * 64 + 63 > tq_wmin);
#pragma unroll
            for (int kb = 0; kb < 2; ++kb) {
                f32x16 sa = ATT_ZERO16;
#pragma unroll
                for (int s = 0; s < 12; ++s) { const bf16x8 a0 = *(const LAS bf16x8*)(kb_ + kb * 32 * KROW + 32 * s); sa = __builtin_amdgcn_mfma_f32_32x32x16_bf16(a0, qf[s], sa, 0, 0, 0); }
                float x[16];
                if (MODE == 0) {
#pragma unroll
                    for (int i = 0; i < 16; ++i) x[i] = sa[i] * SL;
                } else if (far) { const float cb = tblh[128];
#pragma unroll
                    for (int i = 0; i < 16; ++i) x[i] = sa[i] * SL + cb;
                } else {
                    const LAS int* kp = (const LAS int*)(lds + L_KPOS) + buf * 64 + 4 * hh + 32 * kb;
#pragma unroll
                    for (int g4 = 0; g4 < 4; ++g4) { const i32x4 kv = *(const LAS i32x4*)(kp + 8 * g4);
#pragma unroll
                        for (int e = 0; e < 4; ++e) { int d = qpos - kv[e]; d = d < 0 ? 0 : (d > 128 ? 128 : d); x[4 * g4 + e] = sa[4 * g4 + e] * SL + tblh[d]; } }
                }
                if (need) {
#pragma unroll
                    for (int i = 0; i < 16; ++i) { const int ci = 32 * kb + 8 * (i >> 2) + (i & 3); if (ci > lim) x[i] = -INFINITY; if (MODE == 2) { if (ci <= lim - 512) x[i] = -INFINITY; } }
                }
                float ml = x[0];
#pragma unroll
                for (int i = 1; i < 16; ++i) ml = fmaxf(ml, x[i]);
                ml = fmaxf(ml, __shfl_xor(ml, 32));
                const float mnew = fmaxf(m_run, ml), alpha = __builtin_amdgcn_exp2f(m_run - mnew);
                m_run = mnew;
                float ps = 0.f;
#pragma unroll
                for (int i = 0; i < 16; ++i) { x[i] = __builtin_amdgcn_exp2f(x[i] - mnew); ps += x[i]; }
                l_run = l_run * alpha + ps;
                if (!__all(alpha == 1.0f)) {
#pragma unroll
                    for (int c = 0; c < 4; ++c) oacc[c] = oacc[c] * alpha;
                }
                bf16x8 pf[2];
#pragma unroll
                for (int k2 = 0; k2 < 2; ++k2) { u32x4 w; w.x = cvtpk(x[8 * k2 + 0], x[8 * k2 + 1]); w.y = cvtpk(x[8 * k2 + 2], x[8 * k2 + 3]); w.z = cvtpk(x[8 * k2 + 4], x[8 * k2 + 5]); w.w = cvtpk(x[8 * k2 + 6], x[8 * k2 + 7]); pf[k2] = __builtin_bit_cast(bf16x8, w); }
                unsigned vb[4][2];
                { int lane_ = lane; asm volatile("" : "+v"(lane_)); const unsigned q4 = (lane_ & 15) >> 2, p = lane_ & 3, blk = (lane_ >> 4) & 1, h2 = lane_ >> 5;
#pragma unroll
                  for (int c = 0; c < 4; ++c)
#pragma unroll
                    for (int tp = 0; tp < 2; ++tp) vb[c][tp] = 256u * (8u * tp + 4u * h2 + q4) + 16u * ((((unsigned)c ^ q4) << 2) | ((2u * blk + (p >> 1)) ^ (2u * tp + h2))) + 8u * (p & 1u); }
#pragma unroll
                for (int c = 0; c < 4; ++c)
#pragma unroll
                    for (int k2 = 0; k2 < 2; ++k2) { const int ks = 2 * kb + k2; const s16x4 lo = vtr(vbuf + vb[c][0] + ks * 4096), hi = vtr(vbuf + vb[c][1] + ks * 4096);
                        const bf16x8 a = {lo[0], lo[1], lo[2], lo[3], hi[0], hi[1], hi[2], hi[3]};
                        oacc[c] = __builtin_amdgcn_mfma_f32_32x32x16_bf16(a, pf[k2], oacc[c], 0, 0, 0); }
            }
        }
        if (nxt >= 0) stage_store(st, lds, buf ^ 1, tid, posb != nullptr);
        __syncthreads();
        if (nxt < 0) break;
        tile = nxt; rem &= rem - 1u; buf ^= 1;
    }
}
template <bool ROPE>
__device__ __forceinline__ void load_qfrags(bf16x8 (&qf)[12], const bf16_t* qrow, int hh, const f32x2* rope_row) {
#pragma unroll
    for (int s = 0; s < 12; ++s) qf[s] = *(const bf16x8*)(qrow + 16 * s + 8 * hh);
    if (ROPE) {
#pragma unroll
        for (int pr = 0; pr < 2; ++pr) {
            const int i0 = 16 * pr + 8 * hh; bf16x8 a = qf[8 + pr], b = qf[10 + pr];
#pragma unroll
            for (int j = 0; j < 8; ++j) { const f32x2 cs = rope_row[i0 + j]; const float x1 = bf1((bf16_t)a[j]), x2 = bf1((bf16_t)b[j]);
                const unsigned w = cvtpk(x1 * cs.x - x2 * cs.y, x1 * cs.y + x2 * cs.x); a[j] = (short)(w & 0xffffu); b[j] = (short)(w >> 16); }
            qf[8 + pr] = a; qf[10 + pr] = b;
        }
    }
}
__device__ __forceinline__ void mla_unit(Frame& F, int b, int h, int qb) {
    const int lane = F.lane, r = lane & 31, hh = lane >> 5, w = F.wave;
    const int t0 = 256 * qb, tq = t0 + 32 * w + r; const size_t m = (size_t)b * SEQ + tq;
    const bf16_t* KV = (const bf16_t*)(F.ws + WS_KV);
    Src src{KV + (size_t)b * SEQ * 2048 + h * 128, (const bf16_t*)(F.ws + WS_KPE) + (size_t)b * SEQ * 64, KV + (size_t)b * SEQ * 2048 + 1024 + h * 128, 2048, 64, 2048};
    bf16x8 qf[12]; load_qfrags<true>(qf, (const bf16_t*)(F.ws + WS_QM) + m * 1536 + h * 192, hh, (const f32x2*)(F.ws + WS_ROPE) + m * 32);
    f32x16 oacc[4] = {ATT_ZERO16, ATT_ZERO16, ATT_ZERO16, ATT_ZERO16}; float m_run = -1e30f, l_run = 0.f;
    const unsigned tmask = (qb == 7) ? 0xffffffffu : ((1u << (4 * qb + 4)) - 1u);
    run_pass<0>(F, src, tmask, qf, oacc, m_run, l_run, tq, t0 + 32 * w, t0 + 32 * w + 31, 0u, 0, 0, h, nullptr);
    const float inv = 1.0f / (l_run + __shfl_xor(l_run, 32));
    bf16_t* o = (bf16_t*)(F.ws + WS_AB) + m * 2048 + h * 128 + 4 * hh;
#pragma unroll
    for (int c = 0; c < 4; ++c)
#pragma unroll
        for (int g4 = 0; g4 < 4; ++g4) *(u32x2*)(o + 32 * c + 8 * g4) = (u32x2){cvtpk(oacc[c][4 * g4] * inv, oacc[c][4 * g4 + 1] * inv), cvtpk(oacc[c][4 * g4 + 2] * inv, oacc[c][4 * g4 + 3] * inv)};
}
__device__ __forceinline__ void nsa_unit(Frame& F, int b, int g, int qb) {
    const int lane = F.lane, r = lane & 31, hh = lane >> 5, w = F.wave, head = 4 * g + (w >> 1);
    const int t0 = 64 * qb, tq = t0 + 32 * (w & 1) + r; const size_t m = (size_t)b * SEQ + tq;
    const bf16_t* Zb = (const bf16_t*)(F.ws + WS_Z) + (size_t)b * SEQ * DINP; const bf16_t* zr = (const bf16_t*)(F.ws + WS_Z) + m * DINP;
    const unsigned* SELb = (const unsigned*)(F.ws + WS_SEL) + (size_t)(b * 2 + g) * SEQ; const int* posb = (const int*)F.in[I_POS] + (size_t)b * SEQ;
    LAS unsigned* misc = (LAS unsigned*)(F.lds + L_MISC);
    if (w == 0) { unsigned v = SELb[t0 + lane];
#pragma unroll
        for (int o = 1; o < 64; o <<= 1) v |= (unsigned)__shfl_xor((int)v, o);
        if (lane == 0) misc[4] = v; }
    const unsigned selq = SELb[tq]; const int qpos = posb[tq]; int qmin = qpos;
#pragma unroll
    for (int o = 1; o < 64; o <<= 1) { const int t = __shfl_xor(qmin, o); qmin = t < qmin ? t : qmin; }
    qmin = __builtin_amdgcn_readfirstlane(qmin);
    bf16x8 qf[12]; load_qfrags<false>(qf, zr + ZO_NQ + head * 192, hh, nullptr);
    __syncthreads();
    const unsigned causal = (qb == 31) ? 0xffffffffu : ((2u << qb) - 1u);
    const unsigned umask = (unsigned)__builtin_amdgcn_readfirstlane((int)misc[4]) & causal;
    const int wlo = qb > 8 ? qb - 8 : 0; const unsigned wmask = causal & ~((1u << wlo) - 1u);
    f32x16 oacc[4] = {ATT_ZERO16, ATT_ZERO16, ATT_ZERO16, ATT_ZERO16}; float m_run = -1e30f, l_run = 0.f;
    {
        Src src{Zb + ZO_KS + g * 192, Zb + ZO_KS + g * 192 + 128, Zb + ZO_VS + g * 128, DINP, DINP, DINP};
        run_pass<1>(F, src, umask, qf, oacc, m_run, l_run, tq, t0 + 32 * (w & 1), t0 + 32 * (w & 1) + 31, selq, qpos, qmin, head, posb);
        asm volatile("" ::: "memory");
        const size_t m1 = (size_t)b * SEQ + t0 + 32 * (w & 1) + (F.lane & 31);
        const float g1 = sigmoidf_(bf1(((const bf16_t*)(F.ws + WS_Z))[m1 * DINP + ZO_NG + head * 3 + 1]));
        bf16_t* o = (bf16_t*)(F.ws + WS_AB) + m1 * 2048 + 1024 + head * 128 + 4 * (F.lane >> 5); const float* oc = (const float*)(F.ws + WS_OC) + m1 * 1024 + head * 128 + 4 * (F.lane >> 5);
        const float inv = g1 / (l_run + __shfl_xor(l_run, 32));
#pragma unroll
        for (int c = 0; c < 4; ++c)
#pragma unroll
            for (int g4 = 0; g4 < 4; ++g4) { const f32x4 cv = *(const f32x4*)(oc + 32 * c + 8 * g4);
                *(u32x2*)(o + 32 * c + 8 * g4) = (u32x2){cvtpk(oacc[c][4 * g4] * inv + cv.x, oacc[c][4 * g4 + 1] * inv + cv.y), cvtpk(oacc[c][4 * g4 + 2] * inv + cv.z, oacc[c][4 * g4 + 3] * inv + cv.w)}; }
    }
#pragma unroll
    for (int c = 0; c < 4; ++c) oacc[c] = (f32x16)ATT_ZERO16;
    m_run = -1e30f; l_run = 0.f;
    {
        Src src{Zb + ZO_KW + g * 192, Zb + ZO_KW + g * 192 + 128, Zb + ZO_VW + g * 128, DINP, DINP, DINP};
        run_pass<2>(F, src, wmask, qf, oacc, m_run, l_run, tq, t0 + 32 * (w & 1), t0 + 32 * (w & 1) + 31, 0u, qpos, qmin, head, posb);
        asm volatile("" ::: "memory");
        const size_t m1 = (size_t)b * SEQ + t0 + 32 * (w & 1) + (F.lane & 31);
        const float g2 = sigmoidf_(bf1(((const bf16_t*)(F.ws + WS_Z))[m1 * DINP + ZO_NG + head * 3 + 2]));
        bf16_t* o = (bf16_t*)(F.ws + WS_AB) + m1 * 2048 + 1024 + head * 128 + 4 * (F.lane >> 5);
        const float inv = g2 / (l_run + __shfl_xor(l_run, 32));
#pragma unroll
        for (int c = 0; c < 4; ++c)
#pragma unroll
            for (int g4 = 0; g4 < 4; ++g4) { const u32x2 pv = *(const u32x2*)(o + 32 * c + 8 * g4);
                *(u32x2*)(o + 32 * c + 8 * g4) = (u32x2){cvtpk(oacc[c][4 * g4] * inv + bflo(pv.x), oacc[c][4 * g4 + 1] * inv + bfhi(pv.x)), cvtpk(oacc[c][4 * g4 + 2] * inv + bflo(pv.y), oacc[c][4 * g4 + 3] * inv + bfhi(pv.y))}; }
    }
}
constexpr int CW_QUEUE = 8192;
__device__ __forceinline__ void attn_phase(Frame& F, int l) {
    LAS float* tblL = (LAS float*)(F.lds + L_TBL); const float* tg = (const float*)(F.ws + WS_TBL + 16384);
    for (int i = F.tid; i < 8 * 132; i += 512) tblL[i] = tg[i];
    LAS unsigned* misc = (LAS unsigned*)(F.lds + L_MISC);
    unsigned* qctr = (unsigned*)(F.ws + WS_CTL) + CW_QUEUE + 64 * l;
    __syncthreads();
    for (;;) {
        launder(F);
        if (F.tid == 0) misc[0] = __hip_atomic_fetch_add(qctr, 1u, __ATOMIC_RELAXED, __HIP_MEMORY_SCOPE_AGENT);
        __syncthreads();
        const int u = __builtin_amdgcn_readfirstlane((int)misc[0]);
        __syncthreads();
        if (u >= 256) break;
        mla_unit(F, (u & 31) >> 3, u & 7, 7 - (u >> 5));
    }
    for (;;) {
        launder(F);
        if (F.tid == 0) misc[0] = __hip_atomic_fetch_add(qctr + 16, 1u, __ATOMIC_RELAXED, __HIP_MEMORY_SCOPE_AGENT);
        __syncthreads();
        const int u = __builtin_amdgcn_readfirstlane((int)misc[0]);
        __syncthreads();
        if (u >= 256) break;
        nsa_unit(F, (u & 7) >> 1, u & 1, 31 - (u >> 3));
    }
}
}

struct SchedCmp {
    const char* Zb; const char* Wb; int c0, c, kv;
    __device__ bool next(int i, Unit& u) const {
        const int j = c - c0; if (i != 0 || j < 0 || j >= 32) return false;
        const int g = j >> 4, rt = (j >> 3) & 1, s = j & 7;
        u.a = Zb + ((size_t)(kv ? ZO_VC + 128 * g : ZO_KC + 192 * g) + (size_t)rt * 256 * 16 * DINP + (size_t)s * 4 * DINP) * 2;
        u.b = Wb + (size_t)s * (kv ? 8 : 12) * 64 * 2; u.pm = 0; u.pn = 0; u.aux = kv * 32 + j; return true;
    }
};
struct SchedQKV {
    const char* C; const char* WQ; const char* WUKV; int G, c;
    __device__ bool next(int i, Unit& u) const {
        int j = i * G + c; if (j >= 448) return false;
        if (j < 192) { u.aux = 0; u.pn = j / 32; u.pm = j % 32; u.a = C + (size_t)u.pm * 256 * 1024 * 2; u.b = WQ + (size_t)u.pn * 256 * 512 * 2; }
        else { j -= 192; u.aux = 1; u.pn = j / 32; u.pm = j % 32; u.a = C + ((size_t)u.pm * 256 * 1024 + 512) * 2; u.b = WUKV + (size_t)u.pn * 256 * 512 * 2; }
        return true;
    }
};
struct SchedMerge {
    const char* A; const char* W; int G, c;
    __device__ bool next(int i, Unit& u) const {
        const int ti = (i >> 1) * G + c, kh = i & 1; if (ti >= 256) return false;
        u.pm = ti % 32; u.pn = ti / 32; u.aux = kh;
        u.a = A + ((size_t)u.pm * 256 * 2048 + kh * 1024) * 2; u.b = W + ((size_t)u.pn * 256 * 2048 + kh * 1024) * 2; return true;
    }
};

constexpr int NPH = 2 + NL * 14;
__global__ void __launch_bounds__(512, 2) fwd(Args args) {
    extern __shared__ __attribute__((aligned(16))) unsigned char lds_raw[];
    Frame F;
    F.lds = (LAS unsigned char*)lds_raw; F.tid = threadIdx.x; F.lane = F.tid & 63; F.wave = __builtin_amdgcn_readfirstlane(F.tid >> 6); F.G = gridDim.x; F.cu = blockIdx.x;
    F.in = args.in; F.out = args.out; F.ws = args.ws;
    volatile LAS unsigned* MISC = (volatile LAS unsigned*)(F.lds + MISC_OFF);
    for (int u = F.tid; u < (LDS_BYTES - RING_BYTES) / 4; u += 512) ((LAS unsigned*)(F.lds + RING_BYTES))[u] = 0u;
    __syncthreads();
    unsigned* ctl = (unsigned*)(F.ws + WS_CTL);
    XcdBarrier bar; bar.bar = ctl + CW_BAR; bar.x = 0; bar.st = MISC + 8;
    if (!MK_PER_PHASE) bar = xcd_barrier_post(ctl + CW_BAR, MISC + 8);
    const int lo = args.ph_lo, hi = args.ph_hi; int pc = 0;
#define PH_IF launder(F); if (pc >= lo && pc < hi)
#define PH_END do { const bool both_ = (pc >= lo) && (pc + 1 < hi); ++pc; if (both_) xcd_barrier(bar); } while (0)
#define U ((bf16_t*)(F.ws + WS_U))
#define H ((bf16_t*)(F.ws + WS_H))
#define Y ((bf16_t*)(F.ws + WS_Y))
#define Z ((bf16_t*)(F.ws + WS_Z))
#define CQKV ((bf16_t*)(F.ws + WS_CQKV))
#define QM ((bf16_t*)(F.ws + WS_QM))
#define KV ((bf16_t*)(F.ws + WS_KV))
#define AB ((bf16_t*)(F.ws + WS_AB))
#define MG ((bf16_t*)(F.ws + WS_MG))
#define WL ((const bf16_t*)(F.ws + WS_W) + (size_t)l * WO_END)

    PH_IF { p0_prologue(F); } PH_END;
    PH_IF { thin_first_norm(F, F.in[I_F1PRE]); } PH_END;
    for (int l = 0; l < NL; ++l) {
        for (int f = 0; f < 2; ++f) {
            PH_IF {
                Gemm g{D, D, D / 64, 0}; SchedStd S; S.init(U, D, WL + (f ? WO_GU2 : WO_GU1), D, M, 2 * FF, F.G, F.cu); EpiSwiGLU E{H, FF};
                pg8::gemm_phase<EpiSwiGLU, SchedStd, 0>(F.lds, g, S, E);
            } PH_END;
            PH_IF {
                Gemm g{FF, FF, FF / 64, 0}; SchedStd S; S.init(H, FF, WL + (f ? WO_D2 : WO_D1), FF, M, D, F.G, F.cu); EpiBf16 E{Y, D};
                pg8::gemm_phase<EpiBf16, SchedStd, 0>(F.lds, g, S, E);
            } PH_END;
            PH_IF {
                if (f == 0) thin_post_norm(F, 0.5f, F.in[I_F1POST] + (size_t)l * D, F.in[I_MPRE] + (size_t)l * D, nullptr);
                else thin_post_norm(F, 0.5f, F.in[I_F2POST] + (size_t)l * D, (l + 1 < NL) ? F.in[I_F1PRE] + (size_t)(l + 1) * D : nullptr, (l + 1 < NL) ? nullptr : F.out);
            } PH_END;
            if (f == 0) {
                PH_IF {
                    Gemm g{D, D, D / 64, 0}; SchedStd S; S.init(U, D, WL + WO_IN, D, M, DINP, F.G, F.cu); EpiBf16 E{Z, DINP};
                    pg8::gemm_phase<EpiBf16, SchedStd, 0>(F.lds, g, S, E);
                } PH_END;
                PH_IF {
                    thin_mix(F, F.in[I_QNG] + (size_t)l * 512, F.in[I_KVNG] + (size_t)l * 512);
                    __syncthreads();
                    EpiSlab E{(float*)(F.ws + WS_PART)};
                    { Gemm g{16 * DINP, 6144, 12, (size_t)DINP * 2}; SchedCmp S{(const char*)Z, (const char*)(WL + WO_1K), 0, F.cu, 0}; pg8::gemm_phase<EpiSlab, SchedCmp, 3>(F.lds, g, S, E); }
                    { Gemm g{16 * DINP, 4096, 8, (size_t)DINP * 2}; SchedCmp S{(const char*)Z, (const char*)(WL + WO_1V), 32, F.cu, 1}; pg8::gemm_phase<EpiSlab, SchedCmp, 2>(F.lds, g, S, E); }
                } PH_END;
                PH_IF {
                    { Gemm g{1024, 512, 8, 0}; SchedQKV S{(const char*)CQKV, (const char*)(WL + WO_Q), (const char*)(WL + WO_UKV), F.G, F.cu}; EpiQKV E{QM, KV};
                      pg8::gemm_phase<EpiQKV, SchedQKV, 0>(F.lds, g, S, E); }
                    for (int u = F.G - 1 - F.cu; u < 128; u += F.G) cmp_stage2_unit(F, u, l);
                } PH_END;
                PH_IF { naive_cmp_phase(F); } PH_END;
                PH_IF { att::attn_phase(F, l); } PH_END;
                PH_IF {
                    Gemm g{2048, 2048, 16, 0}; SchedMerge S{(const char*)AB, (const char*)(WL + WO_AB), F.G, F.cu}; EpiMerge E{Z, MG};
                    pg8::gemm_phase<EpiMerge, SchedMerge, 0>(F.lds, g, S, E);
                } PH_END;
                PH_IF {
                    Gemm g{2048, 2048, 32, 0}; SchedStd S; S.init(MG, 2048, WL + WO_OUT, 2048, M, D, F.G, F.cu); EpiBf16 E{Y, D};
                    pg8::gemm_phase<EpiBf16, SchedStd, 0>(F.lds, g, S, E);
                } PH_END;
                PH_IF { thin_post_norm(F, 1.0f, F.in[I_MPOST] + (size_t)l * D, F.in[I_F2PRE] + (size_t)l * D, nullptr); } PH_END;
            }
        }
    }
#undef PH_IF
#undef PH_END
#undef U
#undef H
#undef Y
#undef Z
#undef CQKV
#undef QM
#undef KV
#undef AB
#undef MG
#undef WL
}

extern "C" void kernel_launch(void* const* d_in, const int* in_sizes, int n_in, void* d_out, int out_size, void* d_ws, size_t ws_size, hipStream_t stream) {
    static int grid = 0;
    if (grid == 0) {
        if (n_in != 30 || in_sizes[0] != M * D || out_size != M * D || ws_size < WS_END) { fprintf(stderr, "kernel_launch: unexpected shapes / workspace (n_in %d, ws %zu < %zu)\n", n_in, ws_size, (size_t)WS_END); grid = -1; return; }
        int dev = 0, cus = 0, per_cu = 0;
        if (hipGetDevice(&dev) != hipSuccess || hipDeviceGetAttribute(&cus, hipDeviceAttributeMultiprocessorCount, dev) != hipSuccess) { grid = -1; return; }
        if (hipFuncSetAttribute((const void*)fwd, hipFuncAttributeMaxDynamicSharedMemorySize, LDS_BYTES) != hipSuccess) { fprintf(stderr, "kernel_launch: hipFuncSetAttribute failed\n"); grid = -1; return; }
        if (hipOccupancyMaxActiveBlocksPerMultiprocessor(&per_cu, (const void*)fwd, 512, LDS_BYTES) != hipSuccess || per_cu < 1) { fprintf(stderr, "kernel_launch: occupancy query says %d\n", per_cu); }
        (void)hipGetLastError();
        grid = cus;
    }
    if (grid < 0) return;
    (void)hipMemsetAsync((char*)d_ws + WS_CTL, 0, CTL_ZERO_BYTES, stream);
    Args a{};
    for (int i = 0; i < 30; ++i) a.in[i] = (const float*)d_in[i];
    a.out = (float*)d_out; a.ws = (unsigned char*)d_ws;
#if MK_PER_PHASE
    for (int p = 0; p < NPH; ++p) { a.ph_lo = p; a.ph_hi = p + 1; hipLaunchKernelGGL(fwd, dim3(grid), dim3(512), LDS_BYTES, stream, a); }
#else
    a.ph_lo = 0; a.ph_hi = NPH; hipLaunchKernelGGL(fwd, dim3(grid), dim3(512), LDS_BYTES, stream, a);
#endif
}
```

```cpp
#include <hip/hip_runtime.h>
#include <cstdio>
#include <cstdint>

#ifndef MK_PER_PHASE
#define MK_PER_PHASE 0
#endif

#define GAS __attribute__((address_space(1)))
#define LAS __attribute__((address_space(3)))
typedef unsigned short bf16_t;
typedef short bf16x8 __attribute__((ext_vector_type(8)));
typedef float f32x4 __attribute__((ext_vector_type(4)));
typedef float f32x2 __attribute__((ext_vector_type(2)));
typedef unsigned u32x4 __attribute__((ext_vector_type(4)));
typedef unsigned u32x2 __attribute__((ext_vector_type(2)));
typedef __bf16 bf16x2_t __attribute__((ext_vector_type(2)));

constexpr int NB = 4, SEQ = 2048, M = NB * SEQ, D = 2048, NL = 4, FF = 5632;
constexpr int DIN = 8664, DINP = 8704;
constexpr int ZO_CQ = 0, ZO_CKV = 512, ZO_KR = 1024, ZO_NQ = 1088, ZO_KC = 2624, ZO_VC = 3008, ZO_KS = 3264, ZO_VS = 3648, ZO_KW = 3904, ZO_VW = 4288, ZO_NG = 4544, ZO_GA = 4568, ZO_GB = 6616;
constexpr float EPS = 1e-6f;
constexpr int NCMP = 127;

constexpr size_t MiB = 1u << 20;
constexpr size_t alup(size_t x) { return (x + MiB - 1) / MiB * MiB; }
constexpr size_t WS_CTL = 0, CTL_ZERO_BYTES = 1 * MiB;
constexpr size_t WS_TBL = WS_CTL + CTL_ZERO_BYTES;
constexpr size_t WS_ROPE = WS_TBL + MiB;
constexpr size_t WS_X = WS_ROPE + alup((size_t)M * 32 * 8);
constexpr size_t WS_U = WS_X + alup((size_t)M * D * 4);
constexpr size_t WS_H = WS_U + alup((size_t)M * D * 2);
constexpr size_t WS_Y = WS_H + alup((size_t)M * FF * 2);
constexpr size_t WS_Z = WS_Y + alup((size_t)M * D * 2);
constexpr size_t WS_CQKV = WS_Z + alup((size_t)(M + 64) * DINP * 2);
constexpr size_t WS_KPE = WS_CQKV + alup((size_t)M * 1024 * 2);
constexpr size_t WS_QM = WS_KPE + alup((size_t)M * 64 * 2);
constexpr size_t WS_KV = WS_QM + alup((size_t)M * 1536 * 2);
constexpr size_t WS_AB = WS_KV + alup((size_t)M * 2048 * 2);
constexpr size_t WS_MG = WS_AB + alup((size_t)M * 2048 * 2);
constexpr size_t WS_OC = WS_MG + alup((size_t)M * 2048 * 2);
constexpr size_t WS_PART = WS_OC + alup((size_t)M * 1024 * 4);
constexpr size_t WS_KC = WS_PART + alup((size_t)64 * 256 * 256 * 4);
constexpr size_t WS_SEL = WS_KC + MiB;
constexpr size_t WS_W = WS_SEL + MiB;
constexpr size_t WO_GU1 = 0, WO_D1 = WO_GU1 + (size_t)2 * FF * D, WO_GU2 = WO_D1 + (size_t)D * FF, WO_D2 = WO_GU2 + (size_t)2 * FF * D,
                 WO_IN = WO_D2 + (size_t)D * FF, WO_Q = WO_IN + (size_t)DINP * D, WO_UKV = WO_Q + (size_t)1536 * 512, WO_1K = WO_UKV + (size_t)2048 * 512,
                 WO_1V = WO_1K + (size_t)256 * 6144, WO_AB = WO_1V + (size_t)256 * 4096, WO_OUT = WO_AB + (size_t)2048 * 2048, WO_END = WO_OUT + (size_t)2048 * 2048;
constexpr size_t WS_END = WS_W + alup(WO_END * 2 * NL);
constexpr int CW_BAR = 4096;

constexpr int RING_BYTES = 131072, MISC_OFF = RING_BYTES + 320, LDS_BYTES = 147456;

#define RLX_AGENT __ATOMIC_RELAXED, __HIP_MEMORY_SCOPE_AGENT
__device__ __forceinline__ unsigned cvtpk(float lo, float hi) { f32x2 v = {lo, hi}; bf16x2_t b = __builtin_convertvector(v, bf16x2_t); return __builtin_bit_cast(unsigned, b); }
__device__ __forceinline__ float bflo(unsigned u) { return __uint_as_float(u << 16); }
__device__ __forceinline__ float bfhi(unsigned u) { return __uint_as_float(u & 0xffff0000u); }
__device__ __forceinline__ float bf1(bf16_t h) { return __uint_as_float((unsigned)h << 16); }
__device__ __forceinline__ float wave_sum(float v) {
#pragma unroll
    for (int o = 1; o < 64; o <<= 1) v += __shfl_xor(v, o);
    return v;
}
__device__ __forceinline__ float wave_max(float v) {
#pragma unroll
    for (int o = 1; o < 64; o <<= 1) v = fmaxf(v, __shfl_xor(v, o));
    return v;
}
__device__ __forceinline__ float sigmoidf_(float x) { return 1.0f / (1.0f + __expf(-x)); }

__device__ const float ROPE_INV[32] = {
    1.000000000e+00f, 7.498942614e-01f, 5.623413324e-01f, 4.216965139e-01f, 3.162277639e-01f, 2.371373773e-01f, 1.778279394e-01f, 1.333521307e-01f,
    1.000000015e-01f, 7.498941571e-02f, 5.623413250e-02f, 4.216965288e-02f, 3.162277490e-02f, 2.371373773e-02f, 1.778279431e-02f, 1.333521493e-02f,
    9.999999776e-03f, 7.498941850e-03f, 5.623413250e-03f, 4.216964822e-03f, 3.162277630e-03f, 2.371373586e-03f, 1.778279431e-03f, 1.333521446e-03f,
    1.000000047e-03f, 7.498942432e-04f, 5.623413017e-04f, 4.216965172e-04f, 3.162277571e-04f, 2.371373703e-04f, 1.778279402e-04f, 1.333521504e-04f};
__device__ const unsigned char REL_BUCKET[129] = {
    0, 1, 2, 3, 4, 5, 6, 7, 8, 9, 10, 11, 12, 13, 14, 15, 16, 16, 16, 17, 17, 18, 18, 18, 19, 19, 19, 20, 20, 20, 20, 21, 21, 21, 21, 22, 22, 22, 22, 22, 23, 23, 23, 23, 23, 23, 24, 24, 24, 24, 24, 24,
    25, 25, 25, 25, 25, 25, 25, 26, 26, 26, 26, 26, 26, 26, 26, 27, 27, 27, 27, 27, 27, 27, 27, 27, 27, 28, 28, 28, 28, 28, 28, 28, 28, 28, 28, 29, 29, 29, 29, 29, 29, 29, 29, 29, 29, 29, 29,
    30, 30, 30, 30, 30, 30, 30, 30, 30, 30, 30, 30, 30, 30, 31, 31, 31, 31, 31, 31, 31, 31, 31, 31, 31, 31, 31, 31, 31, 31};

#define XB_TMO      128
#define XB_XCNT(j)  (256  + 64 * (j))
#define XB_XSUB(j)  (1280 + 64 * (j))
#define XB_XGEN(j)  (2304 + 64 * (j))
#define XB_TOP      3328
#define XB_TOPGEN   3392
#define XCD_BAR_WORDS 3456
#define XB_SPIN_CAP (1u << 18)
__device__ __forceinline__ unsigned xb_ld(unsigned* p)              { return __hip_atomic_load(p, __ATOMIC_RELAXED, __HIP_MEMORY_SCOPE_AGENT); }
__device__ __forceinline__ unsigned xb_add(unsigned* p, unsigned v) { return __hip_atomic_fetch_add(p, v, __ATOMIC_RELAXED, __HIP_MEMORY_SCOPE_AGENT); }
__device__ __forceinline__ unsigned xb_xcc_id() { return (unsigned)__builtin_amdgcn_s_getreg((3 << 11) | 20) & 0xFu; }
#define XB_SPIN(cond, bar) do { unsigned _sp = 0; while (cond) { __builtin_amdgcn_s_sleep(1); \
    if ((++_sp & 255u) == 0u) { if (xb_ld(&(bar)[XB_TMO])) break; if (_sp > XB_SPIN_CAP) { atomicAdd(&(bar)[XB_TMO], 1u); break; } } } } while (0)
struct XcdBarrier { unsigned* bar; unsigned x; volatile LAS unsigned* st; };
__device__ __forceinline__ XcdBarrier xcd_barrier_post(unsigned* bar, volatile LAS unsigned* st) {
    XcdBarrier b; b.bar = bar; b.x = xb_xcc_id(); b.st = st;
    if (threadIdx.x == 0) (void)xb_add(&bar[XB_XCNT(b.x)], 1u);
    return b;
}
__device__ __forceinline__ void xcd_barrier_complete(unsigned* bar, unsigned x, unsigned& nloc, unsigned& nx) {
    const unsigned G = gridDim.x * gridDim.y * gridDim.z;
    unsigned sum, cnt, mine, sp = 0u;
    for (;;) {
        sum = 0u; cnt = 0u; mine = 0u;
#pragma unroll
        for (unsigned j = 0; j < 16; ++j) { const unsigned c = xb_ld(&bar[XB_XCNT(j)]); sum += c; cnt += (c > 0u) ? 1u : 0u; mine = (j == x) ? c : mine; }
        if (sum == G) break;
        __builtin_amdgcn_s_sleep(1);
        if ((++sp & 255u) == 0u) { if (xb_ld(&bar[XB_TMO])) break; if (sp > XB_SPIN_CAP) { atomicAdd(&bar[XB_TMO], 1u); break; } }
    }
    nloc = mine > 0u ? mine : 1u; nx = cnt > 0u ? cnt : 1u;
}
__device__ __forceinline__ void xcd_barrier(const XcdBarrier& b) {
    asm volatile("s_waitcnt vmcnt(0)" ::: "memory");
    __syncthreads();
    if (threadIdx.x == 0) {
        unsigned* bar = b.bar;
        __builtin_amdgcn_s_waitcnt(0);
        unsigned nloc = b.st[0], nx = b.st[1];
        if (nloc == 0u) { xcd_barrier_complete(bar, b.x, nloc, nx); b.st[0] = nloc; b.st[1] = nx; }
        const unsigned old = xb_add(&bar[XB_XSUB(b.x)], 1u);
        const unsigned gen = old / nloc;
        if (old + 1u == (gen + 1u) * nloc) {
            __builtin_amdgcn_fence(__ATOMIC_RELEASE, "agent");
            asm volatile("s_waitcnt vmcnt(0)" ::: "memory");
            const unsigned og = xb_add(&bar[XB_TOP], 1u);
            const unsigned tg = og / nx;
            if (og + 1u == (tg + 1u) * nx) xb_add(&bar[XB_TOPGEN], 1u);
            else XB_SPIN(xb_ld(&bar[XB_TOPGEN]) == tg, bar);
            __builtin_amdgcn_fence(__ATOMIC_ACQUIRE, "agent");
            xb_add(&bar[XB_XGEN(b.x)], 1u);
            asm volatile("s_waitcnt vmcnt(0)" ::: "memory");
        } else {
            XB_SPIN(xb_ld(&bar[XB_XGEN(b.x)]) == gen, bar);
            __builtin_amdgcn_fence(__ATOMIC_ACQUIRE, "agent");
            asm volatile("s_waitcnt vmcnt(0)" ::: "memory");
        }
    }
    __syncthreads();
}

namespace pg8 {
constexpr int BM = 256, BK = 64, HALF = 128, HTB = HALF * BK * 2, STAGE_BYTES = 8 * HTB, NXCD = 8, WGM = 8;
__host__ __device__ __forceinline__ int lds_byte(int r, int c) { const int st = (r >> 4) * 2 + (c >> 5), rr = r & 15, cc = c & 31, ob = rr * 64 + cc * 2; return st * 1024 + (ob ^ (((ob >> 9) & 1) << 5)); }
__host__ __device__ __forceinline__ void stage_rc(int b, int& R, int& C) { const int st = b / 1024, sb = b % 1024, swz = sb ^ (((sb >> 9) & 1) << 5); R = (st >> 1) * 16 + swz / 64; C = (st & 1) * 32 + (swz % 64) / 2; }
__host__ __device__ __forceinline__ int perm32(int rho) { const int n = rho >> 4, i = rho & 15; return 8 * (i >> 2) + 4 * n + (i & 3); }

struct Unit { const char* a; const char* b; int pm, pn, aux; };
struct Gemm { int lda, ldb, nt; size_t gstride; };

struct StaticOrder {
    int nM, nN, nwg, G, c;
    __device__ void init(int M_, int N_, int G_, int c_) { nM = M_ / BM; nN = N_ / BM; nwg = nM * nN; G = G_; c = c_; }
    __device__ bool next(int i, int& pm, int& pn) const {
        const long L = (long)i * G + c; if (L >= nwg) return false;
        int wgid = (int)L; { const int q = nwg / NXCD, r = nwg % NXCD, xcd = wgid % NXCD, off = wgid / NXCD; wgid = (xcd < r ? xcd * (q + 1) : r * (q + 1) + (xcd - r) * q) + off; }
        const int nig = WGM * nN, gid = wgid / nig, fm = gid * WGM, gsz = (nM - fm) < WGM ? (nM - fm) : WGM;
        pm = fm + ((wgid % nig) % gsz); pn = (wgid % nig) / gsz; return true;
    }
};

template <class Epi, class Sched, int KGRP>
__device__ __forceinline__ void gemm_phase(LAS unsigned char* lds, const Gemm g, const Sched& S, const Epi& E) {
    int tid_ = threadIdx.x; asm volatile("" : "+v"(tid_));
    const int tid = tid_, wid = __builtin_amdgcn_readfirstlane(tid >> 6), lane = tid & 63, wr = wid >> 2, wc = wid & 3, fr = lane & 15, fq = lane >> 4;
    const int nt = g.nt;
    unsigned voffA[2], voffB[2];
#pragma unroll
    for (int i = 0; i < 2; ++i) { int R, C; stage_rc(tid * 16 + i * 8192, R, C); const int Rb = (R & ~31) + perm32(R & 31);
        voffA[i] = (unsigned)(R * g.lda + C) * 2u; voffB[i] = (unsigned)(Rb * g.ldb + C) * 2u; }
    const size_t kstep = (size_t)(BK * 2);
    const size_t hstepA = (size_t)HALF * g.lda * 2, hstepB = (size_t)HALF * g.ldb * 2;
    const unsigned ldsw = (unsigned)wid * 1024u;
    const int aoff = lds_byte(wr * 64 + fr, fq * 8), boff = lds_byte(wc * 32 + fr, fq * 8);
    auto koffA = [&](int t) -> size_t { if constexpr (KGRP > 0) return (size_t)(t / KGRP) * g.gstride + (size_t)(t % KGRP) * kstep; else return (size_t)t * kstep; };
#define PG8_SA(b, h) (((b) * 2 + (h)) * HTB)
#define PG8_SB(b, h) ((4 + (b) * 2 + (h)) * HTB)
#define PG8_STAGE(bufoff, gbase, voff) do { _Pragma("unroll") for (int _i = 0; _i < 2; ++_i) \
        __builtin_amdgcn_global_load_lds((const unsigned*)((const char*)(gbase) + (voff)[_i]), (LAS unsigned*)(lds + (bufoff) + ldsw + _i * 8192), 16, 0, 0); } while (0)
#define PG8_LDA(dst, b, h) do { _Pragma("unroll") for (int m = 0; m < 4; ++m) _Pragma("unroll") for (int k = 0; k < 2; ++k) dst[m][k] = *(const LAS bf16x8*)(lds + PG8_SA(b, h) + aoff + m * 2048 + k * 1024); } while (0)
#define PG8_LDB(dst, b, h) do { _Pragma("unroll") for (int n = 0; n < 2; ++n) _Pragma("unroll") for (int k = 0; k < 2; ++k) dst[n][k] = *(const LAS bf16x8*)(lds + PG8_SB(b, h) + boff + n * 2048 + k * 1024); } while (0)
#define PG8_MMA(ai, bj, At, Bt) do { __builtin_amdgcn_s_setprio(1); _Pragma("unroll") for (int m = 0; m < 4; ++m) _Pragma("unroll") for (int n = 0; n < 2; ++n) _Pragma("unroll") for (int k = 0; k < 2; ++k) \
        acc[ai][bj][m][n] = __builtin_amdgcn_mfma_f32_16x16x32_bf16(Bt[n][k], At[m][k], acc[ai][bj][m][n], 0, 0, 0); __builtin_amdgcn_s_setprio(0); } while (0)
#define PG8_WAIT_V(n) asm volatile("s_waitcnt vmcnt(" #n ")" ::: "memory")
#define PG8_WAIT_L(n) asm volatile("s_waitcnt lgkmcnt(" #n ")" ::: "memory")
#define PG8_BAR __builtin_amdgcn_s_barrier()
#define PG8_SCHED __builtin_amdgcn_sched_barrier(0)
    Unit cur, nxt; int ui = 0;
    if (!S.next(0, cur)) return;
    f32x4 acc[2][2][4][2];
#pragma unroll
    for (int a = 0; a < 2; ++a)
#pragma unroll
        for (int b = 0; b < 2; ++b)
#pragma unroll
            for (int m = 0; m < 4; ++m)
#pragma unroll
                for (int n = 0; n < 2; ++n) acc[a][b][m][n] = (f32x4){0.f, 0.f, 0.f, 0.f};
    bf16x8 At[4][2], B0[2][2], B1[2][2];
    const char* cA = cur.a; const char* cB = cur.b;
    PG8_STAGE(PG8_SB(0, 0), cB, voffB); PG8_STAGE(PG8_SB(0, 1), cB + hstepB, voffB); PG8_STAGE(PG8_SA(0, 0), cA, voffA); PG8_STAGE(PG8_SA(0, 1), cA + hstepA, voffA);
    if (wr == 1) PG8_BAR;
    PG8_WAIT_V(2); PG8_BAR;
    { const char* a1p = cA + koffA(1);
      PG8_STAGE(PG8_SB(1, 0), cB + kstep, voffB); PG8_STAGE(PG8_SA(1, 0), a1p, voffA); PG8_STAGE(PG8_SB(1, 1), cB + hstepB + kstep, voffB); }
    PG8_WAIT_V(6); PG8_BAR;
    for (;;) {
        const bool has_next = S.next(ui + 1, nxt);
        const char* nA = has_next ? nxt.a : cA; const char* nB = has_next ? nxt.b : cB;
        for (int t = 0; t < nt; t += 2) {
            const bool last = (t == nt - 2);
            const char* a1 = cA + koffA(t + 1);
            const char* a2 = last ? nA : cA + koffA(t + 2); const char* b2 = last ? nB : cB + (size_t)(t + 2) * kstep;
            const char* a3 = last ? nA + koffA(1) : cA + koffA(t + 3); const char* b3 = b2 + kstep;
            PG8_LDB(B0, 0, 0); PG8_LDB(B1, 0, 1); PG8_SCHED; PG8_LDA(At, 0, 0); PG8_STAGE(PG8_SA(1, 1), a1 + hstepA, voffA);
            PG8_WAIT_V(8); PG8_WAIT_L(0); PG8_BAR; PG8_MMA(0, 0, At, B0); PG8_MMA(0, 1, At, B1); PG8_BAR; PG8_SCHED;
            PG8_LDA(At, 0, 1); PG8_STAGE(PG8_SB(0, 0), b2, voffB); PG8_STAGE(PG8_SB(0, 1), b2 + hstepB, voffB); PG8_STAGE(PG8_SA(0, 0), a2, voffA);
            PG8_WAIT_V(8); PG8_WAIT_L(0); PG8_BAR; PG8_MMA(1, 0, At, B0); PG8_MMA(1, 1, At, B1); PG8_BAR; PG8_SCHED;
            PG8_LDB(B0, 1, 0); PG8_LDB(B1, 1, 1); PG8_SCHED; PG8_LDA(At, 1, 0); PG8_STAGE(PG8_SA(0, 1), a2 + hstepA, voffA);
            PG8_WAIT_V(8); PG8_WAIT_L(0); PG8_BAR; PG8_MMA(0, 0, At, B0); PG8_MMA(0, 1, At, B1); PG8_BAR; PG8_SCHED;
            PG8_LDA(At, 1, 1); PG8_STAGE(PG8_SB(1, 0), b3, voffB); PG8_STAGE(PG8_SB(1, 1), b3 + hstepB, voffB); PG8_STAGE(PG8_SA(1, 0), a3, voffA);
            PG8_WAIT_V(8); PG8_WAIT_L(0); PG8_BAR; PG8_MMA(1, 0, At, B0); PG8_MMA(1, 1, At, B1); PG8_BAR; PG8_SCHED;
        }
        if (wr == 0) PG8_BAR;
        const bool keep = E(acc, cur, wr, wc, fr, fq);
        if (!has_next) break;
        if (!keep) {
#pragma unroll
            for (int a = 0; a < 2; ++a)
#pragma unroll
                for (int b = 0; b < 2; ++b)
#pragma unroll
                    for (int m = 0; m < 4; ++m)
#pragma unroll
                        for (int n = 0; n < 2; ++n) acc[a][b][m][n] = (f32x4){0.f, 0.f, 0.f, 0.f};
        }
        cur = nxt; cA = nA; cB = nB; ++ui;
        if (wr == 1) PG8_BAR;
    }
    PG8_WAIT_V(0);
    PG8_BAR;
#undef PG8_SA
#undef PG8_SB
#undef PG8_STAGE
#undef PG8_LDA
#undef PG8_LDB
#undef PG8_MMA
#undef PG8_WAIT_V
#undef PG8_WAIT_L
#undef PG8_BAR
#undef PG8_SCHED
}
}
using pg8::Unit; using pg8::Gemm;
typedef f32x4 Acc[2][2][4][2];

struct SchedStd {
    pg8::StaticOrder so; const char* A; const char* B; size_t tA, tB;
    __device__ void init(const bf16_t* A_, int lda, const bf16_t* B_, int ldb, int M_, int N_, int G, int c) { so.init(M_, N_, G, c); A = (const char*)A_; B = (const char*)B_; tA = (size_t)256 * lda * 2; tB = (size_t)256 * ldb * 2; }
    __device__ bool next(int i, Unit& u) const { int pm, pn; if (!so.next(i, pm, pn)) return false; u.pm = pm; u.pn = pn; u.aux = 0; u.a = A + pm * tA; u.b = B + pn * tB; return true; }
};

struct EpiBf16 {
    bf16_t* O; int ldc;
    __device__ __forceinline__ bool operator()(Acc& acc, const Unit& u, int wr, int wc, int fr, int fq) const {
        const int row0 = u.pm * 256 + wr * 64 + fr, col0 = u.pn * 256 + wc * 32 + 8 * fq;
#pragma unroll
        for (int ai = 0; ai < 2; ++ai)
#pragma unroll
            for (int m = 0; m < 4; ++m) { bf16_t* rowp = O + (size_t)(row0 + ai * 128 + m * 16) * ldc + col0;
#pragma unroll
                for (int bj = 0; bj < 2; ++bj) { const f32x4 v0 = acc[ai][bj][m][0], v1 = acc[ai][bj][m][1];
                    u32x4 w; w.x = cvtpk(v0[0], v0[1]); w.y = cvtpk(v0[2], v0[3]); w.z = cvtpk(v1[0], v1[1]); w.w = cvtpk(v1[2], v1[3]);
                    *(u32x4*)(rowp + bj * 128) = w; } }
        return false;
    }
};
struct EpiSwiGLU {
    bf16_t* O; int ldc;
    __device__ __forceinline__ bool operator()(Acc& acc, const Unit& u, int wr, int wc, int fr, int fq) const {
        const int row0 = u.pm * 256 + wr * 64 + fr, col0 = u.pn * 128 + wc * 32 + 8 * fq;
#pragma unroll
        for (int ai = 0; ai < 2; ++ai)
#pragma unroll
            for (int m = 0; m < 4; ++m) { bf16_t* rowp = O + (size_t)(row0 + ai * 128 + m * 16) * ldc + col0;
                float h[8];
#pragma unroll
                for (int n = 0; n < 2; ++n)
#pragma unroll
                    for (int e = 0; e < 4; ++e) { const float gt = acc[ai][0][m][n][e], up = acc[ai][1][m][n][e]; h[n * 4 + e] = gt * sigmoidf_(gt) * up; }
                u32x4 w; w.x = cvtpk(h[0], h[1]); w.y = cvtpk(h[2], h[3]); w.z = cvtpk(h[4], h[5]); w.w = cvtpk(h[6], h[7]);
                *(u32x4*)rowp = w; }
        return false;
    }
};
struct EpiSlab {
    float* P;
    __device__ __forceinline__ bool operator()(Acc& acc, const Unit& u, int wr, int wc, int fr, int fq) const {
        float* base = P + (size_t)u.aux * 65536;
#pragma unroll
        for (int ai = 0; ai < 2; ++ai)
#pragma unroll
            for (int m = 0; m < 4; ++m) { float* rowp = base + (size_t)(ai * 128 + wr * 64 + m * 16 + fr) * 256 + wc * 32 + 8 * fq;
#pragma unroll
                for (int bj = 0; bj < 2; ++bj) { *(f32x4*)(rowp + bj * 128) = acc[ai][bj][m][0]; *(f32x4*)(rowp + bj * 128 + 4) = acc[ai][bj][m][1]; } }
        return false;
    }
};
struct EpiQKV {
    bf16_t* Q; bf16_t* KV;
    __device__ __forceinline__ bool operator()(Acc& acc, const Unit& u, int wr, int wc, int fr, int fq) const {
        EpiBf16 e{u.aux ? KV : Q, u.aux ? 2048 : 1536}; return e(acc, u, wr, wc, fr, fq);
    }
};
struct EpiMerge {
    const bf16_t* Z; bf16_t* O;
    __device__ __forceinline__ bool operator()(Acc& acc, const Unit& u, int wr, int wc, int fr, int fq) const {
        const int row0 = u.pm * 256 + wr * 64 + fr, col0 = u.pn * 256 + wc * 32 + 8 * fq;
#pragma unroll
        for (int ai = 0; ai < 2; ++ai)
#pragma unroll
            for (int m = 0; m < 4; ++m) { const size_t row = (size_t)(row0 + ai * 128 + m * 16);
#pragma unroll
                for (int bj = 0; bj < 2; ++bj) { const int col = col0 + bj * 128;
                    const u32x4 gbw = *(const u32x4*)(Z + row * DINP + ZO_GB + col);
                    float gb[8] = {sigmoidf_(bflo(gbw.x)), sigmoidf_(bfhi(gbw.x)), sigmoidf_(bflo(gbw.y)), sigmoidf_(bfhi(gbw.y)), sigmoidf_(bflo(gbw.z)), sigmoidf_(bfhi(gbw.z)), sigmoidf_(bflo(gbw.w)), sigmoidf_(bfhi(gbw.w))};
                    if (u.aux == 0) {
                        const u32x4 gaw = *(const u32x4*)(Z + row * DINP + ZO_GA + col);
                        float ga[8] = {sigmoidf_(bflo(gaw.x)), sigmoidf_(bfhi(gaw.x)), sigmoidf_(bflo(gaw.y)), sigmoidf_(bfhi(gaw.y)), sigmoidf_(bflo(gaw.z)), sigmoidf_(bfhi(gaw.z)), sigmoidf_(bflo(gaw.w)), sigmoidf_(bfhi(gaw.w))};
#pragma unroll
                        for (int n = 0; n < 2; ++n)
#pragma unroll
                            for (int e = 0; e < 4; ++e) acc[ai][bj][m][n][e] *= ga[n * 4 + e] / gb[n * 4 + e];
                    } else {
                        float h[8];
#pragma unroll
                        for (int n = 0; n < 2; ++n)
#pragma unroll
                            for (int e = 0; e < 4; ++e) h[n * 4 + e] = acc[ai][bj][m][n][e] * gb[n * 4 + e];
                        u32x4 w; w.x = cvtpk(h[0], h[1]); w.y = cvtpk(h[2], h[3]); w.z = cvtpk(h[4], h[5]); w.w = cvtpk(h[6], h[7]);
                        *(u32x4*)(O + row * 2048 + col) = w;
                    } } }
        return u.aux == 0;
    }
};

struct Args { const float* in[30]; float* out; unsigned char* ws; int ph_lo, ph_hi; };
enum { I_X = 0, I_POS, I_RELB, I_F1PRE, I_F1POST, I_F1G, I_F1U, I_F1D, I_MPRE, I_MPOST, I_WIN, I_QNG, I_WQUP, I_KVNG, I_WUK, I_WUV, I_PEK, I_W1K, I_W2K, I_PEV, I_W1V, I_W2V, I_WA, I_WB, I_WOUT,
       I_F2PRE, I_F2POST, I_F2G, I_F2U, I_F2D };
struct Frame {
    LAS unsigned char* lds; int tid, lane, wave, G, cu;
    const float* const* in; float* out; unsigned char* ws;
};

__device__ __forceinline__ void launder(Frame& F) { unsigned long long w_ = (unsigned long long)F.ws; unsigned lo_ = (unsigned)w_, hi_ = (unsigned)(w_ >> 32);
    int cu_ = F.cu; asm volatile("" : "+v"(F.tid), "+v"(F.lane), "+v"(lo_), "+v"(hi_), "+v"(cu_));
    lo_ = (unsigned)__builtin_amdgcn_readfirstlane((int)lo_); hi_ = (unsigned)__builtin_amdgcn_readfirstlane((int)hi_); F.ws = (unsigned char*)(((unsigned long long)hi_ << 32) | lo_); F.cu = __builtin_amdgcn_readfirstlane(cu_); }
__device__ __forceinline__ void p0_transpose_item(const float* W, int K, int N, bf16_t* WT, int ldk, int koff, int mode, int row_off, LAS float* scr, int item, int lane) {
    const int nblk = (N + 31) / 32, kb = item / nblk, nb = item % nblk, k0 = 64 * kb, n0 = 32 * nb;
    const bool nok = (n0 + (lane & 31)) < N;
#pragma unroll 8
    for (int i = 0; i < 32; ++i) { const int kk = 2 * i + (lane >> 5); scr[kk * 33 + (lane & 31)] = nok ? W[(size_t)(k0 + kk) * N + n0 + (lane & 31)] : 0.f; }
    asm volatile("s_waitcnt lgkmcnt(0)" ::: "memory");
    const int c = lane & 7;
    const int rbase = mode ? ((n0 >> 7) * 256 + row_off + (n0 & 127)) : (row_off + n0);
#pragma unroll
    for (int j = 0; j < 4; ++j) { const int n = (lane >> 3) + 8 * j; const LAS float* s = scr + (8 * c) * 33 + n;
        u32x4 o; o.x = cvtpk(s[0 * 33], s[1 * 33]); o.y = cvtpk(s[2 * 33], s[3 * 33]); o.z = cvtpk(s[4 * 33], s[5 * 33]); o.w = cvtpk(s[6 * 33], s[7 * 33]);
        if (n0 + n < N) *(u32x4*)(WT + (size_t)(rbase + n) * ldk + koff + k0 + 8 * c) = o; }
    asm volatile("s_waitcnt lgkmcnt(0)" ::: "memory");
}
struct CvtJob { int in_idx, K, N, ldk, koff, mode, row_off; size_t dst_off; };
__device__ __forceinline__ CvtJob cvt_job(int j) {
    switch (j) {
    case 0:  return CvtJob{I_F1G, D, FF, D, 0, 1, 0, WO_GU1};
    case 1:  return CvtJob{I_F1U, D, FF, D, 0, 1, 128, WO_GU1};
    case 2:  return CvtJob{I_F1D, FF, D, FF, 0, 0, 0, WO_D1};
    case 3:  return CvtJob{I_F2G, D, FF, D, 0, 1, 0, WO_GU2};
    case 4:  return CvtJob{I_F2U, D, FF, D, 0, 1, 128, WO_GU2};
    case 5:  return CvtJob{I_F2D, FF, D, FF, 0, 0, 0, WO_D2};
    case 6:  return CvtJob{I_WIN, D, DIN, D, 0, 0, 0, WO_IN};
    case 7:  return CvtJob{I_WQUP, 512, 1536, 512, 0, 0, 0, WO_Q};
    case 8:  return CvtJob{I_WUK, 512, 1024, 512, 0, 0, 0, WO_UKV};
    case 9:  return CvtJob{I_WUV, 512, 1024, 512, 0, 0, 1024, WO_UKV};
    case 10: return CvtJob{I_W1K, 6144, 256, 6144, 0, 0, 0, WO_1K};
    case 11: return CvtJob{I_W1V, 4096, 256, 4096, 0, 0, 0, WO_1V};
    case 12: return CvtJob{I_WA, 1024, 2048, 2048, 0, 0, 0, WO_AB};
    case 13: return CvtJob{I_WB, 1024, 2048, 2048, 1024, 0, 0, WO_AB};
    default: return CvtJob{I_WOUT, 2048, 2048, 2048, 0, 0, 0, WO_OUT};
    }
}
constexpr int N_CVT_JOBS = 15;
__device__ __forceinline__ void p0_prologue(Frame& F) {
    LAS float* scr = (LAS float*)(F.lds + F.wave * 16384);
    const int gw = F.cu * 8 + F.wave, NGW = F.G * 8;
    bf16_t* wbase = (bf16_t*)(F.ws + WS_W);
    for (int l = 0; l < NL; ++l)
        for (int j = 0; j < N_CVT_JOBS; ++j) {
            const CvtJob J = cvt_job(j);
            const float* src = F.in[J.in_idx] + (size_t)l * J.K * J.N;
            bf16_t* dst = wbase + (size_t)l * WO_END + J.dst_off;
            const int nitems = (J.K / 64) * ((J.N + 31) / 32);
            for (int it = gw; it < nitems; it += NGW) p0_transpose_item(src, J.K, J.N, dst, J.ldk, J.koff, J.mode, J.row_off, scr, it, F.lane);
        }
    {
        const f32x4* xs = (const f32x4*)F.in[I_X]; f32x4* xd = (f32x4*)(F.ws + WS_X);
        for (size_t i = (size_t)F.cu * 512 + F.tid; i < (size_t)M * D / 4; i += (size_t)F.G * 512) xd[i] = xs[i];
        const int* pos = (const int*)F.in[I_POS]; f32x2* rope = (f32x2*)(F.ws + WS_ROPE);
        for (int i = F.cu * 512 + F.tid; i < M * 32; i += F.G * 512) {
            const float ang = (float)pos[i >> 5] * ROPE_INV[i & 31];
            const double rev = (double)ang * 0.15915494309189535; const float fr = (float)(rev - __builtin_rint(rev));
            rope[i] = (f32x2){__builtin_amdgcn_cosf(fr), __builtin_amdgcn_sinf(fr)};
        }
        float* tbl = (float*)(F.ws + WS_TBL);
        if (F.cu == 0) for (int i = F.tid; i < 8 * 132; i += 512) { const int h = i / 132, d = i % 132; const float tv = F.in[I_RELB][REL_BUCKET[d > 128 ? 128 : d] * 8 + h]; tbl[i] = tv; ((float*)(F.ws + WS_TBL + 16384))[i] = tv * 1.4426950408889634f; }
        if (F.cu >= 1 && F.cu <= 2 * NL) {
            const int l = (F.cu - 1) >> 1, kv = (F.cu - 1) & 1, Kk = kv ? 4096 : 6144;
            const float* pe = F.in[kv ? I_PEV : I_PEK] + (size_t)l * Kk; const float* w1 = F.in[kv ? I_W1V : I_W1K] + (size_t)l * Kk * 256;
            const int c = F.tid & 255, hf = F.tid >> 8; float s = 0.f;
            for (int k = hf * (Kk / 2); k < (hf + 1) * (Kk / 2); ++k) s += pe[k] * w1[(size_t)k * 256 + c];
            LAS float* red = (LAS float*)F.lds;
            __syncthreads();
            if (hf) red[c] = s;
            __syncthreads();
            if (!hf) ((float*)(F.ws + WS_TBL + 8192))[(l * 2 + kv) * 256 + c] = s + red[c];
            __syncthreads();
        }
    }
}

__device__ __forceinline__ void thin_first_norm(Frame& F, const float* g) {
    const int gw = F.cu * 8 + F.wave, NGW = F.G * 8;
    const float* X = (const float*)(F.ws + WS_X); bf16_t* U = (bf16_t*)(F.ws + WS_U);
    for (int m = gw; m < M; m += NGW) {
        const f32x4* xr = (const f32x4*)(X + (size_t)m * D) + F.lane; f32x4 v[8]; float s = 0.f;
#pragma unroll
        for (int j = 0; j < 8; ++j) { v[j] = xr[64 * j]; s += (v[j].x * v[j].x + v[j].y * v[j].y) + (v[j].z * v[j].z + v[j].w * v[j].w); }
        const float r = 1.0f / sqrtf(wave_sum(s) * (1.f / D) + EPS);
        u32x2* o = (u32x2*)(U + (size_t)m * D) + F.lane;
#pragma unroll
        for (int j = 0; j < 8; ++j) { const f32x4 gg = ((const f32x4*)g)[F.lane + 64 * j]; o[64 * j] = (u32x2){cvtpk(v[j].x * r * gg.x, v[j].y * r * gg.y), cvtpk(v[j].z * r * gg.z, v[j].w * r * gg.w)}; }
    }
}
__device__ __forceinline__ void thin_post_norm(Frame& F, float coef, const float* gpost, const float* gpre, float* outp) {
    const int gw = F.cu * 8 + F.wave, NGW = F.G * 8;
    float* X = (float*)(F.ws + WS_X); bf16_t* U = (bf16_t*)(F.ws + WS_U); const bf16_t* Y = (const bf16_t*)(F.ws + WS_Y);
    for (int m = gw; m < M; m += NGW) {
        f32x4* xr = (f32x4*)(X + (size_t)m * D) + F.lane; const u32x2* yr = (const u32x2*)(Y + (size_t)m * D) + F.lane;
        f32x4 y[8]; float s = 0.f;
#pragma unroll
        for (int j = 0; j < 8; ++j) { const u32x2 w = yr[64 * j]; y[j] = (f32x4){bflo(w.x), bfhi(w.x), bflo(w.y), bfhi(w.y)}; s += (y[j].x * y[j].x + y[j].y * y[j].y) + (y[j].z * y[j].z + y[j].w * y[j].w); }
        const float r = coef / sqrtf(wave_sum(s) * (1.f / D) + EPS);
        float s2 = 0.f;
#pragma unroll
        for (int j = 0; j < 8; ++j) { const f32x4 gg = ((const f32x4*)gpost)[F.lane + 64 * j]; f32x4 x = xr[64 * j];
            x.x += y[j].x * r * gg.x; x.y += y[j].y * r * gg.y; x.z += y[j].z * r * gg.z; x.w += y[j].w * r * gg.w; y[j] = x;
            s2 += (x.x * x.x + x.y * x.y) + (x.z * x.z + x.w * x.w);
            if (outp) ((f32x4*)(outp + (size_t)m * D))[F.lane + 64 * j] = x; else xr[64 * j] = x; }
        if (gpre) {
            const float r2 = 1.0f / sqrtf(wave_sum(s2) * (1.f / D) + EPS);
            u32x2* o = (u32x2*)(U + (size_t)m * D) + F.lane;
#pragma unroll
            for (int j = 0; j < 8; ++j) { const f32x4 gg = ((const f32x4*)gpre)[F.lane + 64 * j]; o[64 * j] = (u32x2){cvtpk(y[j].x * r2 * gg.x, y[j].y * r2 * gg.y), cvtpk(y[j].z * r2 * gg.z, y[j].w * r2 * gg.w)}; }
        }
    }
}
__device__ __forceinline__ void thin_mix(Frame& F, const float* gq, const float* gkv) {
    const int gw = F.cu * 8 + F.wave, NGW = F.G * 8;
    const bf16_t* Z = (const bf16_t*)(F.ws + WS_Z); bf16_t* C = (bf16_t*)(F.ws + WS_CQKV); bf16_t* KPE = (bf16_t*)(F.ws + WS_KPE); const f32x2* rope = (const f32x2*)(F.ws + WS_ROPE);
    for (int m = gw; m < M; m += NGW) {
        const bf16_t* zr = Z + (size_t)m * DINP;
#pragma unroll
        for (int part = 0; part < 2; ++part) {
            const u32x4 w = *((const u32x4*)(zr + part * 512) + F.lane);
            float v[8] = {bflo(w.x), bfhi(w.x), bflo(w.y), bfhi(w.y), bflo(w.z), bfhi(w.z), bflo(w.w), bfhi(w.w)}; float s = 0.f;
#pragma unroll
            for (int e = 0; e < 8; ++e) s += v[e] * v[e];
            const float r = 1.0f / sqrtf(wave_sum(s) * (1.f / 512.f) + EPS);
            const float* g = (part ? gkv : gq) + 8 * F.lane; const f32x4 g0 = *(const f32x4*)g, g1 = *(const f32x4*)(g + 4);
            u32x4 o; o.x = cvtpk(v[0] * r * g0.x, v[1] * r * g0.y); o.y = cvtpk(v[2] * r * g0.z, v[3] * r * g0.w); o.z = cvtpk(v[4] * r * g1.x, v[5] * r * g1.y); o.w = cvtpk(v[6] * r * g1.z, v[7] * r * g1.w);
            *((u32x4*)(C + (size_t)m * 1024 + part * 512) + F.lane) = o;
        }
        if (F.lane < 32) {
            const float x1 = bf1(zr[ZO_KR + F.lane]), x2 = bf1(zr[ZO_KR + 32 + F.lane]); const f32x2 cs = rope[(size_t)m * 32 + F.lane];
            const unsigned a = cvtpk(x1 * cs.x - x2 * cs.y, x1 * cs.y + x2 * cs.x);
            KPE[(size_t)m * 64 + F.lane] = (bf16_t)(a & 0xffffu); KPE[(size_t)m * 64 + 32 + F.lane] = (bf16_t)(a >> 16);
        }
    }
}
__device__ __forceinline__ void cmp_stage2_unit(Frame& F, int unit, int l) {
    const int kv = unit >> 6, u = unit & 63, g = u >> 5, r0 = (u & 31) * 16;
    const int NO = kv ? 128 : 192;
    const float* part = (const float*)(F.ws + WS_PART); const float* pb = (const float*)(F.ws + WS_TBL + 8192) + (l * 2 + kv) * 256;
    const float* w2 = F.in[kv ? I_W2V : I_W2K] + (size_t)l * 256 * NO;
    LAS float* hid = (LAS float*)F.lds;
    __syncthreads();
    {
        const int row = F.tid >> 5, c0 = (F.tid & 31) * 8, rp = r0 + row, rt = rp >> 8, rr = rp & 255;
        f32x4 s0 = *(const f32x4*)(pb + c0), s1 = *(const f32x4*)(pb + c0 + 4);
#pragma unroll
        for (int s = 0; s < 8; ++s) { const float* p = part + (size_t)((((kv * 2 + g) * 2 + rt) * 8) + s) * 65536 + (size_t)rr * 256 + c0; s0 += *(const f32x4*)p; s1 += *(const f32x4*)(p + 4); }
        float h[8] = {s0.x, s0.y, s0.z, s0.w, s1.x, s1.y, s1.z, s1.w};
#pragma unroll
        for (int e = 0; e < 8; ++e) hid[row * 256 + c0 + e] = h[e] * sigmoidf_(h[e]);
    }
    __syncthreads();
    bf16_t* dst = (bf16_t*)(F.ws + WS_KC + (kv ? 524288 : 0));
    for (int o = F.tid; o < 16 * NO; o += 512) {
        const int row = o / NO, n = o % NO; float a = 0.f;
#pragma unroll 8
        for (int c = 0; c < 256; ++c) a += hid[row * 256 + c] * w2[c * NO + n];
        const int rp = r0 + row, b = rp >> 7, nn = rp & 127;
        dst[(size_t)((b * 2 + g) * 128 + nn) * NO + n] = (bf16_t)(cvtpk(a, 0.f) & 0xffffu);
    }
}

template <bool ROPE>
__device__ __forceinline__ void load_q(Frame& F, const bf16_t* qp, float scale, LAS float* qs, const f32x2* rope_row) {
    if (F.lane < 24) { const u32x4 w = *((const u32x4*)qp + F.lane); LAS float* d = qs + 8 * F.lane;
        d[0] = bflo(w.x) * scale; d[1] = bfhi(w.x) * scale; d[2] = bflo(w.y) * scale; d[3] = bfhi(w.y) * scale; d[4] = bflo(w.z) * scale; d[5] = bfhi(w.z) * scale; d[6] = bflo(w.w) * scale; d[7] = bfhi(w.w) * scale; }
    if (ROPE) { if (F.lane < 32) { const float x1 = qs[128 + F.lane], x2 = qs[160 + F.lane]; const f32x2 cs = rope_row[F.lane]; qs[128 + F.lane] = x1 * cs.x - x2 * cs.y; qs[160 + F.lane] = x1 * cs.y + x2 * cs.x; } }
}
__device__ __forceinline__ float dot8(const u32x4 w, const LAS float* q) {
    const f32x4 a = *(const LAS f32x4*)q, b = *(const LAS f32x4*)(q + 4);
    return (bflo(w.x) * a.x + bfhi(w.x) * a.y) + (bflo(w.y) * a.z + bfhi(w.y) * a.w) + (bflo(w.z) * b.x + bfhi(w.z) * b.y) + (bflo(w.w) * b.z + bfhi(w.w) * b.w);
}
template <int MODE>
__device__ __forceinline__ void naive_row(Frame& F, int b, int t, int head, float gate, float& o0, float& o1, LAS float* sc, const LAS float* qs, unsigned selmask, int& nk_out) {
    const int g = head >> 2; const size_t mb = (size_t)b * SEQ;
    const bf16_t* Z = (const bf16_t*)(F.ws + WS_Z); const bf16_t* KV = (const bf16_t*)(F.ws + WS_KV); const bf16_t* KPE = (const bf16_t*)(F.ws + WS_KPE);
    const bf16_t* KC = (const bf16_t*)(F.ws + WS_KC); const bf16_t* VC = (const bf16_t*)(F.ws + WS_KC + 524288);
    const float* tbl = (const float*)(F.ws + WS_TBL) + head * 132; const int* pos = (const int*)F.in[I_POS] + mb;
    const int k0 = (MODE == 2) ? (t > 511 ? t - 511 : 0) : 0;
    const int k1 = (MODE == 3) ? (t < 31 ? -1 : (t - 31) / 16) : t;
    nk_out = k1 - k0 + 1;
    if (k1 < k0) return;
    const int qpos = (MODE != 0) ? pos[t] : 0;
    float mx = -INFINITY;
    for (int kb = k0; kb <= k1; kb += 64) {
        const int k = kb + F.lane; bool valid = k <= k1;
        if (MODE == 1) valid = valid && ((selmask >> (k >> 6)) & 1u);
        float s = -INFINITY;
        if (valid) {
            const bf16_t* p1; const bf16_t* p2;
            if (MODE == 0) { p1 = KV + (mb + k) * 2048 + head * 128; p2 = KPE + (mb + k) * 64; }
            else if (MODE == 1) { p1 = Z + (mb + k) * DINP + ZO_KS + g * 192; p2 = p1 + 128; }
            else if (MODE == 2) { p1 = Z + (mb + k) * DINP + ZO_KW + g * 192; p2 = p1 + 128; }
            else { p1 = KC + (size_t)((b * 2 + g) * 128 + k) * 192; p2 = p1 + 128; }
            float d = 0.f;
#pragma unroll
            for (int c = 0; c < 16; ++c) d += dot8(*((const u32x4*)p1 + c), qs + 8 * c);
#pragma unroll
            for (int c = 0; c < 8; ++c) d += dot8(*((const u32x4*)p2 + c), qs + 128 + 8 * c);
            if (MODE != 0) { const int kp = (MODE == 3) ? pos[16 * k + 31] : pos[k]; int dd = qpos - kp; dd = dd < 0 ? 0 : (dd > 128 ? 128 : dd); d += tbl[dd]; }
            s = d;
        }
        if (k <= k1) sc[k - k0] = s;
        mx = fmaxf(mx, s);
    }
    mx = wave_max(mx);
    float sum = 0.f;
    for (int kb = k0; kb <= k1; kb += 64) { const int k = kb + F.lane; if (k <= k1) { const float p = __expf(sc[k - k0] - mx); sc[k - k0] = p; sum += p; } }
    sum = wave_sum(sum);
    const float inv = 1.0f / sum;
    float a0 = 0.f, a1 = 0.f;
    for (int k = k0; k <= k1; ++k) {
        if (MODE == 1) { if (!((selmask >> (k >> 6)) & 1u)) { k |= 63; continue; } }
        const float p = sc[k - k0];
        const bf16_t* vp;
        if (MODE == 0) vp = KV + (mb + k) * 2048 + 1024 + head * 128;
        else if (MODE == 1) vp = Z + (mb + k) * DINP + ZO_VS + g * 128;
        else if (MODE == 2) vp = Z + (mb + k) * DINP + ZO_VW + g * 128;
        else vp = VC + (size_t)((b * 2 + g) * 128 + k) * 128;
        const unsigned w = *((const unsigned*)vp + F.lane);
        a0 += p * bflo(w); a1 += p * bfhi(w);
    }
    o0 += gate * inv * a0; o1 += gate * inv * a1;
    if (MODE == 3) { for (int kb = 0; kb <= k1; kb += 64) { const int k = kb + F.lane; if (k <= k1) sc[k] *= inv; } }
}
__device__ __forceinline__ void naive_cmp_phase(Frame& F) {
    const int gw = F.cu * 8 + F.wave, NGW = F.G * 8;
    LAS float* sc = (LAS float*)(F.lds + F.wave * 8192); LAS float* qs = (LAS float*)(F.lds + 65536 + F.wave * 1024); LAS float* ps = (LAS float*)(F.lds + 65536 + 8192 + F.wave * 512);
    const bf16_t* Z = (const bf16_t*)(F.ws + WS_Z); float* OC = (float*)(F.ws + WS_OC); unsigned* SEL = (unsigned*)(F.ws + WS_SEL);
    for (int r = gw; r < M * 2; r += NGW) {
        const int g = r & 1, m = r >> 1, b = m / SEQ, t = m % SEQ;
        ps[F.lane] = 0.f; ps[F.lane + 64] = 0.f;
        for (int j = 0; j < 4; ++j) {
            const int head = g * 4 + j; int nk = 0;
            load_q<false>(F, Z + (size_t)m * DINP + ZO_NQ + head * 192, 0.07216878364870322f, qs, nullptr);
            float o0 = 0.f, o1 = 0.f;
            const float g0 = sigmoidf_(bf1(Z[(size_t)m * DINP + ZO_NG + head * 3 + 0]));
            naive_row<3>(F, b, t, head, g0, o0, o1, sc, qs, 0u, nk);
            *(f32x2*)(OC + (size_t)m * 1024 + head * 128 + 2 * F.lane) = (f32x2){o0, o1};
            if (F.lane < nk) ps[F.lane] += sc[F.lane];
            if (F.lane + 64 < nk) ps[F.lane + 64] += sc[F.lane + 64];
        }
        const int mm = F.lane & 31; float imp = 0.f;
#pragma unroll
        for (int n = -1; n < 4; ++n) { const int nn = 4 * mm + n; if (nn >= 0 && nn < 128) imp += ps[nn]; }
        const int cur = t >> 6; const bool valid = mm <= cur, forced = valid && (mm == 0 || mm >= cur - 1);
        const float scv = forced ? 1e6f : (valid ? imp : -1.0f);
        int rank = 0;
#pragma unroll
        for (int o = 0; o < 32; ++o) { const float v = __shfl(scv, o); rank += (v > scv || (v == scv && o < mm)) ? 1 : 0; }
        const bool sel = (rank < 16) && (scv >= 0.f) && (F.lane < 32);
        const unsigned long long bal = __ballot(sel);
        if (F.lane == 0) SEL[(size_t)(b * 2 + g) * SEQ + t] = (unsigned)bal;
    }
}
__device__ __forceinline__ void naive_attn_phase(Frame& F) {
    const int gw = F.cu * 8 + F.wave, NGW = F.G * 8;
    LAS float* sc = (LAS float*)(F.lds + F.wave * 8192); LAS float* qs = (LAS float*)(F.lds + 65536 + F.wave * 1024);
    const bf16_t* Z = (const bf16_t*)(F.ws + WS_Z); const bf16_t* QM = (const bf16_t*)(F.ws + WS_QM); bf16_t* AB = (bf16_t*)(F.ws + WS_AB);
    const float* OC = (const float*)(F.ws + WS_OC); const unsigned* SEL = (const unsigned*)(F.ws + WS_SEL); const f32x2* rope = (const f32x2*)(F.ws + WS_ROPE);
    for (int r = gw; r < M * 8; r += NGW) {
        const int head = r & 7, m = r >> 3, b = m / SEQ, t = m % SEQ; int nk;
        load_q<true>(F, QM + (size_t)m * 1536 + head * 192, 0.07216878364870322f, qs, rope + (size_t)m * 32);
        float o0 = 0.f, o1 = 0.f;
        naive_row<0>(F, b, t, head, 1.0f, o0, o1, sc, qs, 0u, nk);
        *((unsigned*)(AB + (size_t)m * 2048 + head * 128) + F.lane) = cvtpk(o0, o1);
    }
    for (int r = gw; r < M * 8; r += NGW) {
        const int head = r & 7, m = r >> 3, b = m / SEQ, t = m % SEQ, g = head >> 2; int nk;
        const unsigned selmask = (unsigned)__builtin_amdgcn_readfirstlane((int)SEL[(size_t)(b * 2 + g) * SEQ + t]);
        load_q<false>(F, Z + (size_t)m * DINP + ZO_NQ + head * 192, 0.07216878364870322f, qs, nullptr);
        const float g1 = sigmoidf_(bf1(Z[(size_t)m * DINP + ZO_NG + head * 3 + 1])), g2 = sigmoidf_(bf1(Z[(size_t)m * DINP + ZO_NG + head * 3 + 2]));
        const f32x2 oc = *(const f32x2*)(OC + (size_t)m * 1024 + head * 128 + 2 * F.lane);
        float o0 = oc.x, o1 = oc.y;
        naive_row<1>(F, b, t, head, g1, o0, o1, sc, qs, selmask, nk);
        naive_row<2>(F, b, t, head, g2, o0, o1, sc, qs, 0u, nk);
        *((unsigned*)(AB + (size_t)m * 2048 + 1024 + head * 128) + F.lane) = cvtpk(o0, o1);
    }
}

namespace att {
typedef float f32x16 __attribute__((ext_vector_type(16)));
typedef short s16x4 __attribute__((ext_vector_type(4)));
typedef int i32x4 __attribute__((ext_vector_type(4)));
constexpr int KROW = 400, KBUF = 64 * KROW, VBUF = 64 * 256;
constexpr int L_K = 0, L_V = 2 * KBUF, L_KPOS = L_V + 2 * VBUF, L_KPMAX = L_KPOS + 512, L_TBL = L_KPMAX + 64, L_MISC = L_TBL + 8 * 132 * 4;
static_assert(L_MISC + 256 <= RING_BYTES, "attention LDS map");
constexpr float SL = 0.07216878364870322f * 1.4426950408889634f;
__device__ const unsigned char CLS_TYPE[40] = {1,1,1,1,1,1,1,1,1,0,1,1,1,1,0,1,1,1,1,0,1,1,1,1,0,1,1,1,0,1,1,0,1,1,0,1,1,0,1,1};
__device__ const unsigned char CLS_QB[40] = {31,30,29,28,27,26,25,24,23,7,22,21,20,19,6,18,17,16,15,5,14,13,12,11,4,10,9,8,3,7,6,2,5,4,1,3,2,0,1,0};
__device__ const unsigned short CLS_START[41] = {0,8,16,24,32,40,48,56,64,72,104,112,120,128,136,168,176,184,192,200,232,240,248,256,264,296,304,312,320,352,360,368,400,408,416,448,456,464,496,504,512};
__device__ __forceinline__ unsigned offb(unsigned row, unsigned ch) { return 256u * row + 16u * (ch ^ (((row & 3u) << 2) | ((row >> 2) & 3u))); }
struct Src { const bf16_t* k1; const bf16_t* k2; const bf16_t* v; int ldk1, ldk2, ldv; };
struct Stage { u32x4 k[3]; u32x4 v[2]; int kp; };
template <bool SAMELD = true>
__device__ __forceinline__ void stage_load(Stage& st, const Src& s, int tile, int tid, const int* posb) {
    const unsigned vo1 = (unsigned)((tid >> 4) * s.ldk1 + (tid & 15) * 8) * 2u, vo2 = (unsigned)((tid >> 3) * s.ldk2 + (tid & 7) * 8) * 2u;
    const char* b1 = (const char*)s.k1 + (size_t)tile * 64 * s.ldk1 * 2; const char* b2 = (const char*)s.k2 + (size_t)tile * 64 * s.ldk2 * 2; const char* bv = (const char*)s.v + (size_t)tile * 64 * s.ldv * 2;
    st.k[0] = *(const u32x4*)(b1 + vo1); st.k[1] = *(const u32x4*)(b1 + (size_t)32 * s.ldk1 * 2 + vo1); st.k[2] = *(const u32x4*)(b2 + vo2);
    const unsigned vov = SAMELD ? vo1 : (unsigned)((tid >> 4) * s.ldv + (tid & 15) * 8) * 2u;
    st.v[0] = *(const u32x4*)(bv + vov); st.v[1] = *(const u32x4*)(bv + (size_t)32 * s.ldv * 2 + vov);
    if (posb != nullptr && tid < 64) st.kp = posb[tile * 64 + tid];
}
__device__ __forceinline__ void stage_store(const Stage& st, LAS unsigned char* lds, int buf, int tid, bool haspos) {
    const int rowA = tid >> 4, chA = tid & 15;
    LAS unsigned char* ka = lds + L_K + buf * KBUF + rowA * KROW + chA * 16;
    *(LAS u32x4*)ka = st.k[0]; *(LAS u32x4*)(ka + 32 * KROW) = st.k[1];
    *(LAS u32x4*)(lds + L_K + buf * KBUF + (tid >> 3) * KROW + (16 + (tid & 7)) * 16) = st.k[2];
    LAS unsigned char* va = lds + L_V + buf * VBUF + offb(rowA, chA);
    *(LAS u32x4*)va = st.v[0]; *(LAS u32x4*)(va + 8192) = st.v[1];
    if (haspos && tid < 64) { ((LAS int*)(lds + L_KPOS))[buf * 64 + tid] = st.kp; int mx = st.kp;
#pragma unroll
        for (int o = 1; o < 64; o <<= 1) { const int t = __shfl_xor(mx, o); mx = t > mx ? t : mx; }
        if (tid == 0) ((LAS int*)(lds + L_KPMAX))[buf] = mx; }
}
__device__ __forceinline__ s16x4 vtr(const LAS unsigned char* p) { typedef short v4i16_t __attribute__((ext_vector_type(4))); return __builtin_bit_cast(s16x4, __builtin_amdgcn_ds_read_tr16_b64_v4i16((LAS v4i16_t*)p)); }

__device__ __forceinline__ unsigned vtr_off(int lane_, int c, int tp) {
    const unsigned q4 = (lane_ & 15) >> 2, p = lane_ & 3, blk = (lane_ >> 4) & 1, h2 = lane_ >> 5;
    return 256u * (8u * tp + 4u * h2 + q4) + 16u * ((((unsigned)c ^ q4) << 2) | ((2u * blk + (p >> 1)) ^ (2u * tp + h2))) + 8u * (p & 1u);
}
#define ATT_ZERO16 {0.f,0.f,0.f,0.f,0.f,0.f,0.f,0.f,0.f,0.f,0.f,0.f,0.f,0.f,0.f,0.f}
template <int MODE>
__device__ __forceinline__ void run_pass(Frame& F, const Src& src, unsigned tmask, const bf16x8 (&qf)[12], f32x16 (&oacc)[4], float& m_run, float& l_run,
                                         int tq, int tq_wmin, int tq_wmax, unsigned selq, int qpos, int qpos_wmin, int head, const int* posb) {
    if (tmask == 0u) return;
    const int tid = F.tid, lane = F.lane, r = lane & 31, hh = lane >> 5;
    LAS unsigned char* lds = F.lds;
    int tile = __builtin_ctz(tmask); unsigned rem = tmask & (tmask - 1u);
    Stage st; st.kp = 0;
    stage_load(st, src, tile, tid, posb); stage_store(st, lds, 0, tid, posb != nullptr); __syncthreads();
    int buf = 0;
    const LAS float* tblh = (const LAS float*)(lds + L_TBL) + head * 132;
    for (;;) {
        const int nxt = rem ? __builtin_ctz(rem) : -1;
        if (nxt >= 0) stage_load(st, src, nxt, tid, posb);
        const bool active = (MODE != 0) || (tile * 64 <= tq_wmax);
        if (active) {
            const LAS unsigned char* kb_ = lds + L_K + buf * KBUF + r * KROW + 16 * hh;
            const LAS unsigned char* vbuf = lds + L_V + buf * VBUF;
            bool far = true; if (MODE != 0) { const int kpmax = __builtin_amdgcn_readfirstlane(((const LAS int*)(lds + L_KPMAX))[buf]); far = (qpos_wmin - kpmax >= 128); }
            int lim = tq - tile * 64 - 4 * hh;
            if (MODE == 1) { if (!((selq >> tile) & 1u)) lim = -1; }
            const bool need = (MODE == 1) || (MODE == 2) || (tile * 64 + 63 > tq_wmin);
#pragma unroll
            for (int kb = 0; kb < 2; ++kb) {
                f32x16 sa = ATT_ZERO16;
#pragma unroll
                for (int s = 0; s < 12; ++s) { const bf16x8 a0 = *(const LAS bf16x8*)(kb_ + kb * 32 * KROW + 32 * s); sa = __builtin_amdgcn_mfma_f32_32x32x16_bf16(a0, qf[s], sa, 0, 0, 0); }
                float x[16];
                if (MODE == 0) {
#pragma unroll
                    for (int i = 0; i < 16; ++i) x[i] = sa[i] * SL;
                } else if (far) { const float cb = tblh[128];
#pragma unroll
                    for (int i = 0; i < 16; ++i) x[i] = sa[i] * SL + cb;
                } else {
                    const LAS int* kp = (const LAS int*)(lds + L_KPOS) + buf * 64 + 4 * hh + 32 * kb;
#pragma unroll
                    for (int g4 = 0; g4 < 4; ++g4) { const i32x4 kv = *(const LAS i32x4*)(kp + 8 * g4);
#pragma unroll
                        for (int e = 0; e < 4; ++e) { int d = qpos - kv[e]; d = d < 0 ? 0 : (d > 128 ? 128 : d); x[4 * g4 + e] = sa[4 * g4 + e] * SL + tblh[d]; } }
                }
                if (need) {
#pragma unroll
                    for (int i = 0; i < 16; ++i) { const int ci = 32 * kb + 8 * (i >> 2) + (i & 3); if (ci > lim) x[i] = -INFINITY; if (MODE == 2) { if (ci <= lim - 512) x[i] = -INFINITY; } }
                }
                float ml = x[0];
#pragma unroll
                for (int i = 1; i < 16; ++i) ml = fmaxf(ml, x[i]);
                ml = fmaxf(ml, __shfl_xor(ml, 32));
                const float mnew = fmaxf(m_run, ml), alpha = __builtin_amdgcn_exp2f(m_run - mnew);
                m_run = mnew;
                float ps = 0.f;
#pragma unroll
                for (int i = 0; i < 16; ++i) { x[i] = __builtin_amdgcn_exp2f(x[i] - mnew); ps += x[i]; }
                l_run = l_run * alpha + ps;
                if (!__all(alpha == 1.0f)) {
#pragma unroll
                    for (int c = 0; c < 4; ++c) oacc[c] = oacc[c] * alpha;
                }
                bf16x8 pf[2];
#pragma unroll
                for (int k2 = 0; k2 < 2; ++k2) { u32x4 w; w.x = cvtpk(x[8 * k2 + 0], x[8 * k2 + 1]); w.y = cvtpk(x[8 * k2 + 2], x[8 * k2 + 3]); w.z = cvtpk(x[8 * k2 + 4], x[8 * k2 + 5]); w.w = cvtpk(x[8 * k2 + 6], x[8 * k2 + 7]); pf[k2] = __builtin_bit_cast(bf16x8, w); }
#pragma unroll
                for (int c = 0; c < 4; ++c) { int lane_ = lane; asm volatile("" : "+v"(lane_)); const unsigned v0 = vtr_off(lane_, c, 0), v1 = vtr_off(lane_, c, 1);
#pragma unroll
                    for (int k2 = 0; k2 < 2; ++k2) { const int ks = 2 * kb + k2; const s16x4 lo = vtr(vbuf + v0 + ks * 4096), hi = vtr(vbuf + v1 + ks * 4096);
                        const bf16x8 a = {lo[0], lo[1], lo[2], lo[3], hi[0], hi[1], hi[2], hi[3]};
                        oacc[c] = __builtin_amdgcn_mfma_f32_32x32x16_bf16(a, pf[k2], oacc[c], 0, 0, 0); } }
            }
        }
        if (nxt >= 0) stage_store(st, lds, buf ^ 1, tid, posb != nullptr);
        __syncthreads();
        if (nxt < 0) break;
        tile = nxt; rem &= rem - 1u; buf ^= 1;
    }
}
template <bool ROPE>
__device__ __forceinline__ void load_qfrags(bf16x8 (&qf)[12], const bf16_t* qrow, int hh, const f32x2* rope_row) {
#pragma unroll
    for (int s = 0; s < 12; ++s) qf[s] = *(const bf16x8*)(qrow + 16 * s + 8 * hh);
    if (ROPE) {
#pragma unroll
        for (int pr = 0; pr < 2; ++pr) {
            const int i0 = 16 * pr + 8 * hh; bf16x8 a = qf[8 + pr], b = qf[10 + pr];
#pragma unroll
            for (int j = 0; j < 8; ++j) { const f32x2 cs = rope_row[i0 + j]; const float x1 = bf1((bf16_t)a[j]), x2 = bf1((bf16_t)b[j]);
                const unsigned w = cvtpk(x1 * cs.x - x2 * cs.y, x1 * cs.y + x2 * cs.x); a[j] = (short)(w & 0xffffu); b[j] = (short)(w >> 16); }
            qf[8 + pr] = a; qf[10 + pr] = b;
        }
    }
}
__device__ __forceinline__ void mla_unit(Frame& F, int b, int h, int qb) {
    const int lane = F.lane, r = lane & 31, hh = lane >> 5, w = F.wave;
    const int t0 = 256 * qb, tq = t0 + 32 * w + r; const size_t m = (size_t)b * SEQ + tq;
    const bf16_t* KV = (const bf16_t*)(F.ws + WS_KV);
    Src src{KV + (size_t)b * SEQ * 2048 + h * 128, (const bf16_t*)(F.ws + WS_KPE) + (size_t)b * SEQ * 64, KV + (size_t)b * SEQ * 2048 + 1024 + h * 128, 2048, 64, 2048};
    bf16x8 qf[12]; load_qfrags<true>(qf, (const bf16_t*)(F.ws + WS_QM) + m * 1536 + h * 192, hh, (const f32x2*)(F.ws + WS_ROPE) + m * 32);
    f32x16 oacc[4] = {ATT_ZERO16, ATT_ZERO16, ATT_ZERO16, ATT_ZERO16}; float m_run = -1e30f, l_run = 0.f;
    const unsigned tmask = (qb == 7) ? 0xffffffffu : ((1u << (4 * qb + 4)) - 1u);
    run_pass<0>(F, src, tmask, qf, oacc, m_run, l_run, tq, t0 + 32 * w, t0 + 32 * w + 31, 0u, 0, 0, h, nullptr);
    const float inv = 1.0f / (l_run + __shfl_xor(l_run, 32));
    bf16_t* o = (bf16_t*)(F.ws + WS_AB) + m * 2048 + h * 128 + 4 * hh;
#pragma unroll
    for (int c = 0; c < 4; ++c)
#pragma unroll
        for (int g4 = 0; g4 < 4; ++g4) *(u32x2*)(o + 32 * c + 8 * g4) = (u32x2){cvtpk(oacc[c][4 * g4] * inv, oacc[c][4 * g4 + 1] * inv), cvtpk(oacc[c][4 * g4 + 2] * inv, oacc[c][4 * g4 + 3] * inv)};
}
__device__ __forceinline__ void nsa_unit(Frame& F, int b, int g, int qb) {
    const int lane = F.lane, r = lane & 31, hh = lane >> 5, w = F.wave, head = 4 * g + (w >> 1);
    const int t0 = 64 * qb, tq = t0 + 32 * (w & 1) + r; const size_t m = (size_t)b * SEQ + tq;
    const bf16_t* Zb = (const bf16_t*)(F.ws + WS_Z) + (size_t)b * SEQ * DINP; const bf16_t* zr = (const bf16_t*)(F.ws + WS_Z) + m * DINP;
    const unsigned* SELb = (const unsigned*)(F.ws + WS_SEL) + (size_t)(b * 2 + g) * SEQ; const int* posb = (const int*)F.in[I_POS] + (size_t)b * SEQ;
    LAS unsigned* misc = (LAS unsigned*)(F.lds + L_MISC);
    if (w == 0) { unsigned v = SELb[t0 + lane];
#pragma unroll
        for (int o = 1; o < 64; o <<= 1) v |= (unsigned)__shfl_xor((int)v, o);
        if (lane == 0) misc[4] = v; }
    const unsigned selq = SELb[tq]; const int qpos = posb[tq]; int qmin = qpos;
#pragma unroll
    for (int o = 1; o < 64; o <<= 1) { const int t = __shfl_xor(qmin, o); qmin = t < qmin ? t : qmin; }
    qmin = __builtin_amdgcn_readfirstlane(qmin);
    bf16x8 qf[12]; load_qfrags<false>(qf, zr + ZO_NQ + head * 192, hh, nullptr);
    __syncthreads();
    const unsigned causal = (qb == 31) ? 0xffffffffu : ((2u << qb) - 1u);
    const unsigned umask = (unsigned)__builtin_amdgcn_readfirstlane((int)misc[4]) & causal;
    const int wlo = qb > 8 ? qb - 8 : 0; const unsigned wmask = causal & ~((1u << wlo) - 1u);
    f32x16 oacc[4] = {ATT_ZERO16, ATT_ZERO16, ATT_ZERO16, ATT_ZERO16}; float m_run = -1e30f, l_run = 0.f;
    {
        Src src{Zb + ZO_KS + g * 192, Zb + ZO_KS + g * 192 + 128, Zb + ZO_VS + g * 128, DINP, DINP, DINP};
        run_pass<1>(F, src, umask, qf, oacc, m_run, l_run, tq, t0 + 32 * (w & 1), t0 + 32 * (w & 1) + 31, selq, qpos, qmin, head, posb);
        asm volatile("" ::: "memory");
        const size_t m1 = (size_t)b * SEQ + t0 + 32 * (w & 1) + (F.lane & 31);
        const float g1 = sigmoidf_(bf1(((const bf16_t*)(F.ws + WS_Z))[m1 * DINP + ZO_NG + head * 3 + 1]));
        bf16_t* o = (bf16_t*)(F.ws + WS_AB) + m1 * 2048 + 1024 + head * 128 + 4 * (F.lane >> 5); const float* oc = (const float*)(F.ws + WS_OC) + m1 * 1024 + head * 128 + 4 * (F.lane >> 5);
        const float inv = g1 / (l_run + __shfl_xor(l_run, 32));
#pragma unroll
        for (int c = 0; c < 4; ++c)
#pragma unroll
            for (int g4 = 0; g4 < 4; ++g4) { const f32x4 cv = *(const f32x4*)(oc + 32 * c + 8 * g4);
                *(u32x2*)(o + 32 * c + 8 * g4) = (u32x2){cvtpk(oacc[c][4 * g4] * inv + cv.x, oacc[c][4 * g4 + 1] * inv + cv.y), cvtpk(oacc[c][4 * g4 + 2] * inv + cv.z, oacc[c][4 * g4 + 3] * inv + cv.w)}; }
    }
#pragma unroll
    for (int c = 0; c < 4; ++c) oacc[c] = (f32x16)ATT_ZERO16;
    m_run = -1e30f; l_run = 0.f;
    {
        Src src{Zb + ZO_KW + g * 192, Zb + ZO_KW + g * 192 + 128, Zb + ZO_VW + g * 128, DINP, DINP, DINP};
        run_pass<2>(F, src, wmask, qf, oacc, m_run, l_run, tq, t0 + 32 * (w & 1), t0 + 32 * (w & 1) + 31, 0u, qpos, qmin, head, posb);
        asm volatile("" ::: "memory");
        const size_t m1 = (size_t)b * SEQ + t0 + 32 * (w & 1) + (F.lane & 31);
        const float g2 = sigmoidf_(bf1(((const bf16_t*)(F.ws + WS_Z))[m1 * DINP + ZO_NG + head * 3 + 2]));
        bf16_t* o = (bf16_t*)(F.ws + WS_AB) + m1 * 2048 + 1024 + head * 128 + 4 * (F.lane >> 5);
        const float inv = g2 / (l_run + __shfl_xor(l_run, 32));
#pragma unroll
        for (int c = 0; c < 4; ++c)
#pragma unroll
            for (int g4 = 0; g4 < 4; ++g4) { const u32x2 pv = *(const u32x2*)(o + 32 * c + 8 * g4);
                *(u32x2*)(o + 32 * c + 8 * g4) = (u32x2){cvtpk(oacc[c][4 * g4] * inv + bflo(pv.x), oacc[c][4 * g4 + 1] * inv + bfhi(pv.x)), cvtpk(oacc[c][4 * g4 + 2] * inv + bflo(pv.y), oacc[c][4 * g4 + 3] * inv + bfhi(pv.y))}; }
    }
}
__device__ __forceinline__ void cmp_unit(Frame& F, int b, int g, int qb) {
    const int tid = F.tid, lane = F.lane, r = lane & 31, hh = lane >> 5, w = F.wave;
    const int t0 = 256 * qb, tq = t0 + 32 * w + r; const size_t m = (size_t)b * SEQ + tq;
    LAS unsigned char* lds = F.lds;
    const int* posb = (const int*)F.in[I_POS] + (size_t)b * SEQ;
    {
        Src src{(const bf16_t*)(F.ws + WS_KC) + (size_t)(b * 2 + g) * 128 * 192, (const bf16_t*)(F.ws + WS_KC) + (size_t)(b * 2 + g) * 128 * 192 + 128, (const bf16_t*)(F.ws + WS_KC + 524288) + (size_t)(b * 2 + g) * 128 * 128, 192, 192, 128};
        Stage st; st.kp = 0;
        stage_load<false>(st, src, 0, tid, nullptr); stage_store(st, lds, 0, tid, false);
        stage_load<false>(st, src, 1, tid, nullptr); stage_store(st, lds, 1, tid, false);
        if (tid < 128) { int kt = 16 * tid + 31; kt = kt > SEQ - 1 ? SEQ - 1 : kt; ((LAS int*)(lds + L_KPOS))[tid] = posb[kt]; }
    }
    __syncthreads();
    const int qpos = posb[tq];
    const int nmax = tq >= 31 ? (tq - 31) >> 4 : -1;
    float imp[16];
#pragma unroll
    for (int i = 0; i < 16; ++i) imp[i] = 0.f;
    const LAS unsigned char* kb_ = lds + L_K + r * KROW + 16 * hh;
    const LAS unsigned char* vbuf = lds + L_V;
    const bf16_t* zr = (const bf16_t*)(F.ws + WS_Z) + m * DINP;
#pragma unroll 1
    for (int j = 0; j < 4; ++j) {
        const int head = 4 * g + j;
        const LAS float* tblh = (const LAS float*)(lds + L_TBL) + head * 132;
        bf16x8 qf[12]; load_qfrags<false>(qf, zr + ZO_NQ + head * 192, hh, nullptr);
        float m_run = -1e30f, l_run = 0.f;
#define CMP_SCORES(kb) \
                f32x16 sa = ATT_ZERO16; \
                _Pragma("unroll") for (int s = 0; s < 12; ++s) { const bf16x8 a0 = *(const LAS bf16x8*)(kb_ + (kb) * 32 * KROW + 32 * s); sa = __builtin_amdgcn_mfma_f32_32x32x16_bf16(a0, qf[s], sa, 0, 0, 0); } \
                float x[16]; \
                { const LAS int* kp = (const LAS int*)(lds + L_KPOS) + 4 * hh + 32 * (kb); int nm_ = nmax; asm volatile("" : "+v"(nm_)); const int lim = nm_ - 32 * (kb) - 4 * hh; \
                _Pragma("unroll") for (int g4 = 0; g4 < 4; ++g4) { const i32x4 kv = *(const LAS i32x4*)(kp + 8 * g4); \
                    _Pragma("unroll") for (int e = 0; e < 4; ++e) { int d = qpos - kv[e]; d = d < 0 ? 0 : (d > 128 ? 128 : d); const float v = sa[4 * g4 + e] * SL + tblh[d]; x[4 * g4 + e] = (8 * g4 + e > lim) ? -INFINITY : v; } } }
#pragma unroll
        for (int kb = 0; kb < 4; ++kb) {
            CMP_SCORES(kb)
            float ml = x[0];
#pragma unroll
            for (int i = 1; i < 16; ++i) ml = fmaxf(ml, x[i]);
            ml = fmaxf(ml, __shfl_xor(ml, 32));
            const float mnew = fmaxf(m_run, ml), alpha = __builtin_amdgcn_exp2f(m_run - mnew); m_run = mnew;
            float ps = 0.f;
#pragma unroll
            for (int i = 0; i < 16; ++i) ps += __builtin_amdgcn_exp2f(x[i] - mnew);
            l_run = l_run * alpha + ps;
            asm volatile("" ::: "memory");
        }
        const float lt = l_run + __shfl_xor(l_run, 32), inv = lt > 0.f ? 1.0f / lt : 0.f;
        f32x16 oacc[4] = {ATT_ZERO16, ATT_ZERO16, ATT_ZERO16, ATT_ZERO16};
        float carry = 0.f;
#pragma unroll
        for (int kb = 0; kb < 4; ++kb) {
            CMP_SCORES(kb)
#pragma unroll
            for (int i = 0; i < 16; ++i) x[i] = __builtin_amdgcn_exp2f(x[i] - m_run) * inv;
#pragma unroll
            for (int g4 = 0; g4 < 4; ++g4) { const float e3 = x[4 * g4 + 3], sw = __shfl_xor(e3, 32);
                imp[4 * kb + g4] += ((x[4 * g4] + x[4 * g4 + 1]) + (x[4 * g4 + 2] + e3)) + (hh ? sw : carry); carry = sw; }
            bf16x8 pf[2];
#pragma unroll
            for (int k2 = 0; k2 < 2; ++k2) { u32x4 wv; wv.x = cvtpk(x[8 * k2 + 0], x[8 * k2 + 1]); wv.y = cvtpk(x[8 * k2 + 2], x[8 * k2 + 3]); wv.z = cvtpk(x[8 * k2 + 4], x[8 * k2 + 5]); wv.w = cvtpk(x[8 * k2 + 6], x[8 * k2 + 7]); pf[k2] = __builtin_bit_cast(bf16x8, wv); }
#pragma unroll
            for (int c = 0; c < 4; ++c) { int lane_ = lane; asm volatile("" : "+v"(lane_)); const unsigned v0 = vtr_off(lane_, c, 0), v1 = vtr_off(lane_, c, 1);
#pragma unroll
                for (int k2 = 0; k2 < 2; ++k2) { const int ks = 2 * kb + k2; const s16x4 lo = vtr(vbuf + v0 + ks * 4096), hi = vtr(vbuf + v1 + ks * 4096);
                    const bf16x8 a = {lo[0], lo[1], lo[2], lo[3], hi[0], hi[1], hi[2], hi[3]};
                    oacc[c] = __builtin_amdgcn_mfma_f32_32x32x16_bf16(a, pf[k2], oacc[c], 0, 0, 0); } }
            asm volatile("" ::: "memory");
        }
#undef CMP_SCORES
        {
            const float g0 = sigmoidf_(bf1(zr[ZO_NG + head * 3 + 0]));
            float* oc = (float*)(F.ws + WS_OC) + m * 1024 + head * 128 + 4 * hh;
#pragma unroll
            for (int c = 0; c < 4; ++c)
#pragma unroll
                for (int g4 = 0; g4 < 4; ++g4) *(f32x4*)(oc + 32 * c + 8 * g4) = (f32x4){oacc[c][4 * g4] * g0, oacc[c][4 * g4 + 1] * g0, oacc[c][4 * g4 + 2] * g0, oacc[c][4 * g4 + 3] * g0};
        }
    }
    {
        LAS float* impl = (LAS float*)(lds + 90112);
#pragma unroll
        for (int i = 0; i < 4; ++i) *(LAS f32x4*)(impl + (w * 64 + lane) * 16 + 4 * i) = (f32x4){imp[4 * i], imp[4 * i + 1], imp[4 * i + 2], imp[4 * i + 3]};
        asm volatile("s_waitcnt lgkmcnt(0)" ::: "memory");
        int lane2 = F.tid & 63; asm volatile("" : "+v"(lane2));
        const int hh2 = lane2 >> 5;
        const int cur = (t0 + 32 * w + (lane2 & 31)) >> 6; float own[16], oth[16];
#pragma unroll
        for (int i = 0; i < 4; ++i) { const f32x4 a = *(const LAS f32x4*)(impl + (w * 64 + lane2) * 16 + 4 * i), c = *(const LAS f32x4*)(impl + (w * 64 + (lane2 ^ 32)) * 16 + 4 * i);
            own[4 * i] = a.x; own[4 * i + 1] = a.y; own[4 * i + 2] = a.z; own[4 * i + 3] = a.w; oth[4 * i] = c.x; oth[4 * i + 1] = c.y; oth[4 * i + 2] = c.z; oth[4 * i + 3] = c.w; }
#pragma unroll
        for (int i = 0; i < 16; ++i) { const int mo = 2 * i + hh2, mp = 2 * i + 1 - hh2; const bool vo = mo <= cur, fo = vo && (mo == 0 || mo >= cur - 1), vp = mp <= cur, fp = vp && (mp == 0 || mp >= cur - 1);
            own[i] = fo ? 1e6f : (vo ? own[i] : -1.0f); oth[i] = fp ? 1e6f : (vp ? oth[i] : -1.0f); }
        unsigned bits = 0u;
#pragma unroll
        for (int i = 0; i < 16; ++i) { const float v = own[i]; int rank = 0;
#pragma unroll
            for (int k = 0; k < 16; ++k) {
                if (k < i) rank += (own[k] >= v) ? 1 : 0; else if (k > i) rank += (own[k] > v) ? 1 : 0;
                if (k < i) rank += (oth[k] >= v) ? 1 : 0; else if (k > i) rank += (oth[k] > v) ? 1 : 0; else rank += hh2 ? ((oth[k] >= v) ? 1 : 0) : ((oth[k] > v) ? 1 : 0);
                asm volatile("" : "+v"(rank)); }
            if (rank < 16 && v >= 0.f) bits |= 1u << (2 * i + hh2); }
        bits |= (unsigned)__shfl_xor((int)bits, 32);
        if (hh2 == 0) ((unsigned*)(F.ws + WS_SEL))[(size_t)(b * 2 + g) * SEQ + t0 + 32 * w + (lane2 & 31)] = bits;
    }
    __syncthreads();
}
__device__ __forceinline__ void cmp_phase(Frame& F) {
    LAS float* tblL = (LAS float*)(F.lds + L_TBL); const float* tg = (const float*)(F.ws + WS_TBL + 16384);
    for (int i = F.tid; i < 8 * 132; i += 512) tblL[i] = tg[i];
    __syncthreads();
    for (int u = F.cu; u < 64; u += F.G) cmp_unit(F, u >> 4, (u >> 3) & 1, u & 7);
}
constexpr int CW_QUEUE = 8192;
__device__ __forceinline__ void attn_phase(Frame& F, int l) {
    LAS float* tblL = (LAS float*)(F.lds + L_TBL); const float* tg = (const float*)(F.ws + WS_TBL + 16384);
    for (int i = F.tid; i < 8 * 132; i += 512) tblL[i] = tg[i];
    LAS unsigned* misc = (LAS unsigned*)(F.lds + L_MISC);
    unsigned* qctr = (unsigned*)(F.ws + WS_CTL) + CW_QUEUE + 64 * l;
    __syncthreads();
    for (;;) {
        launder(F);
        if (F.tid == 0) misc[0] = __hip_atomic_fetch_add(qctr, 1u, __ATOMIC_RELAXED, __HIP_MEMORY_SCOPE_AGENT);
        __syncthreads();
        const int u = __builtin_amdgcn_readfirstlane((int)misc[0]);
        __syncthreads();
        if (u >= 256) break;
        mla_unit(F, (u & 31) >> 3, u & 7, 7 - (u >> 5));
    }
    for (;;) {
        launder(F);
        if (F.tid == 0) misc[0] = __hip_atomic_fetch_add(qctr + 16, 1u, __ATOMIC_RELAXED, __HIP_MEMORY_SCOPE_AGENT);
        __syncthreads();
        const int u = __builtin_amdgcn_readfirstlane((int)misc[0]);
        __syncthreads();
        if (u >= 256) break;
        nsa_unit(F, (u & 7) >> 1, u & 1, 31 - (u >> 3));
    }
}
}

struct SchedCmp {
    const char* Zb; const char* Wb; int c0, c, kv;
    __device__ bool next(int i, Unit& u) const {
        const int j = c - c0; if (i != 0 || j < 0 || j >= 32) return false;
        const int g = j >> 4, rt = (j >> 3) & 1, s = j & 7;
        u.a = Zb + ((size_t)(kv ? ZO_VC + 128 * g : ZO_KC + 192 * g) + (size_t)rt * 256 * 16 * DINP + (size_t)s * 4 * DINP) * 2;
        u.b = Wb + (size_t)s * (kv ? 8 : 12) * 64 * 2; u.pm = 0; u.pn = 0; u.aux = kv * 32 + j; return true;
    }
};
struct SchedQKV {
    const char* C; const char* WQ; const char* WUKV; int G, c;
    __device__ bool next(int i, Unit& u) const {
        int j = i * G + c; if (j >= 448) return false;
        if (j < 192) { u.aux = 0; u.pn = j / 32; u.pm = j % 32; u.a = C + (size_t)u.pm * 256 * 1024 * 2; u.b = WQ + (size_t)u.pn * 256 * 512 * 2; }
        else { j -= 192; u.aux = 1; u.pn = j / 32; u.pm = j % 32; u.a = C + ((size_t)u.pm * 256 * 1024 + 512) * 2; u.b = WUKV + (size_t)u.pn * 256 * 512 * 2; }
        return true;
    }
};
struct SchedMerge {
    const char* A; const char* W; int G, c;
    __device__ bool next(int i, Unit& u) const {
        const int ti = (i >> 1) * G + c, kh = i & 1; if (ti >= 256) return false;
        u.pm = ti % 32; u.pn = ti / 32; u.aux = kh;
        u.a = A + ((size_t)u.pm * 256 * 2048 + kh * 1024) * 2; u.b = W + ((size_t)u.pn * 256 * 2048 + kh * 1024) * 2; return true;
    }
};

constexpr int NPH = 2 + NL * 14;
__global__ void __launch_bounds__(512, 2) fwd(Args args) {
    extern __shared__ __attribute__((aligned(16))) unsigned char lds_raw[];
    Frame F;
    F.lds = (LAS unsigned char*)lds_raw; F.tid = threadIdx.x; F.lane = F.tid & 63; F.wave = __builtin_amdgcn_readfirstlane(F.tid >> 6); F.G = gridDim.x; F.cu = blockIdx.x;
    F.in = args.in; F.out = args.out; F.ws = args.ws;
    volatile LAS unsigned* MISC = (volatile LAS unsigned*)(F.lds + MISC_OFF);
    for (int u = F.tid; u < (LDS_BYTES - RING_BYTES) / 4; u += 512) ((LAS unsigned*)(F.lds + RING_BYTES))[u] = 0u;
    __syncthreads();
    unsigned* ctl = (unsigned*)(F.ws + WS_CTL);
    XcdBarrier bar; bar.bar = ctl + CW_BAR; bar.x = 0; bar.st = MISC + 8;
    if (!MK_PER_PHASE) bar = xcd_barrier_post(ctl + CW_BAR, MISC + 8);
    const int lo = args.ph_lo, hi = args.ph_hi; int pc = 0;
#define PH_IF launder(F); if (pc >= lo && pc < hi)
#define PH_END do { const bool both_ = (pc >= lo) && (pc + 1 < hi); ++pc; if (both_) xcd_barrier(bar); } while (0)
#define U ((bf16_t*)(F.ws + WS_U))
#define H ((bf16_t*)(F.ws + WS_H))
#define Y ((bf16_t*)(F.ws + WS_Y))
#define Z ((bf16_t*)(F.ws + WS_Z))
#define CQKV ((bf16_t*)(F.ws + WS_CQKV))
#define QM ((bf16_t*)(F.ws + WS_QM))
#define KV ((bf16_t*)(F.ws + WS_KV))
#define AB ((bf16_t*)(F.ws + WS_AB))
#define MG ((bf16_t*)(F.ws + WS_MG))
#define WL ((const bf16_t*)(F.ws + WS_W) + (size_t)l * WO_END)

    PH_IF { p0_prologue(F); } PH_END;
    PH_IF { thin_first_norm(F, F.in[I_F1PRE]); } PH_END;
    for (int l = 0; l < NL; ++l) {
        for (int f = 0; f < 2; ++f) {
            PH_IF {
                Gemm g{D, D, D / 64, 0}; SchedStd S; S.init(U, D, WL + (f ? WO_GU2 : WO_GU1), D, M, 2 * FF, F.G, F.cu); EpiSwiGLU E{H, FF};
                pg8::gemm_phase<EpiSwiGLU, SchedStd, 0>(F.lds, g, S, E);
            } PH_END;
            PH_IF {
                Gemm g{FF, FF, FF / 64, 0}; SchedStd S; S.init(H, FF, WL + (f ? WO_D2 : WO_D1), FF, M, D, F.G, F.cu); EpiBf16 E{Y, D};
                pg8::gemm_phase<EpiBf16, SchedStd, 0>(F.lds, g, S, E);
            } PH_END;
            PH_IF {
                if (f == 0) thin_post_norm(F, 0.5f, F.in[I_F1POST] + (size_t)l * D, F.in[I_MPRE] + (size_t)l * D, nullptr);
                else thin_post_norm(F, 0.5f, F.in[I_F2POST] + (size_t)l * D, (l + 1 < NL) ? F.in[I_F1PRE] + (size_t)(l + 1) * D : nullptr, (l + 1 < NL) ? nullptr : F.out);
            } PH_END;
            if (f == 0) {
                PH_IF {
                    Gemm g{D, D, D / 64, 0}; SchedStd S; S.init(U, D, WL + WO_IN, D, M, DINP, F.G, F.cu); EpiBf16 E{Z, DINP};
                    pg8::gemm_phase<EpiBf16, SchedStd, 0>(F.lds, g, S, E);
                } PH_END;
                PH_IF {
                    thin_mix(F, F.in[I_QNG] + (size_t)l * 512, F.in[I_KVNG] + (size_t)l * 512);
                    __syncthreads();
                    EpiSlab E{(float*)(F.ws + WS_PART)};
                    { Gemm g{16 * DINP, 6144, 12, (size_t)DINP * 2}; SchedCmp S{(const char*)Z, (const char*)(WL + WO_1K), 0, F.cu, 0}; pg8::gemm_phase<EpiSlab, SchedCmp, 3>(F.lds, g, S, E); }
                    { Gemm g{16 * DINP, 4096, 8, (size_t)DINP * 2}; SchedCmp S{(const char*)Z, (const char*)(WL + WO_1V), 32, F.cu, 1}; pg8::gemm_phase<EpiSlab, SchedCmp, 2>(F.lds, g, S, E); }
                } PH_END;
                PH_IF {
                    { Gemm g{1024, 512, 8, 0}; SchedQKV S{(const char*)CQKV, (const char*)(WL + WO_Q), (const char*)(WL + WO_UKV), F.G, F.cu}; EpiQKV E{QM, KV};
                      pg8::gemm_phase<EpiQKV, SchedQKV, 0>(F.lds, g, S, E); }
                    for (int u = F.G - 1 - F.cu; u < 128; u += F.G) cmp_stage2_unit(F, u, l);
                } PH_END;
                PH_IF { att::cmp_phase(F); } PH_END;
                PH_IF { att::attn_phase(F, l); } PH_END;
                PH_IF {
                    Gemm g{2048, 2048, 16, 0}; SchedMerge S{(const char*)AB, (const char*)(WL + WO_AB), F.G, F.cu}; EpiMerge E{Z, MG};
                    pg8::gemm_phase<EpiMerge, SchedMerge, 0>(F.lds, g, S, E);
                } PH_END;
                PH_IF {
                    Gemm g{2048, 2048, 32, 0}; SchedStd S; S.init(MG, 2048, WL + WO_OUT, 2048, M, D, F.G, F.cu); EpiBf16 E{Y, D};
                    pg8::gemm_phase<EpiBf16, SchedStd, 0>(F.lds, g, S, E);
                } PH_END;
                PH_IF { thin_post_norm(F, 1.0f, F.in[I_MPOST] + (size_t)l * D, F.in[I_F2PRE] + (size_t)l * D, nullptr); } PH_END;
            }
        }
    }
#undef PH_IF
#undef PH_END
#undef U
#undef H
#undef Y
#undef Z
#undef CQKV
#undef QM
#undef KV
#undef AB
#undef MG
#undef WL
}

extern "C" void kernel_launch(void* const* d_in, const int* in_sizes, int n_in, void* d_out, int out_size, void* d_ws, size_t ws_size, hipStream_t stream) {
    static int grid = 0;
    if (grid == 0) {
        if (n_in != 30 || in_sizes[0] != M * D || out_size != M * D || ws_size < WS_END) { fprintf(stderr, "kernel_launch: unexpected shapes / workspace (n_in %d, ws %zu < %zu)\n", n_in, ws_size, (size_t)WS_END); grid = -1; return; }
        int dev = 0, cus = 0, per_cu = 0;
        if (hipGetDevice(&dev) != hipSuccess || hipDeviceGetAttribute(&cus, hipDeviceAttributeMultiprocessorCount, dev) != hipSuccess) { grid = -1; return; }
        if (hipFuncSetAttribute((const void*)fwd, hipFuncAttributeMaxDynamicSharedMemorySize, LDS_BYTES) != hipSuccess) { fprintf(stderr, "kernel_launch: hipFuncSetAttribute failed\n"); grid = -1; return; }
        if (hipOccupancyMaxActiveBlocksPerMultiprocessor(&per_cu, (const void*)fwd, 512, LDS_BYTES) != hipSuccess || per_cu < 1) { fprintf(stderr, "kernel_launch: occupancy query says %d\n", per_cu); }
        (void)hipGetLastError();
        grid = cus;
    }
    if (grid < 0) return;
    (void)hipMemsetAsync((char*)d_ws + WS_CTL, 0, CTL_ZERO_BYTES, stream);
    Args a{};
    for (int i = 0; i < 30; ++i) a.in[i] = (const float*)d_in[i];
    a.out = (float*)d_out; a.ws = (unsigned char*)d_ws;
#if MK_PER_PHASE
    for (int p = 0; p < NPH; ++p) { a.ph_lo = p; a.ph_hi = p + 1; hipLaunchKernelGGL(fwd, dim3(grid), dim3(512), LDS_BYTES, stream, a); }
#else
    a.ph_lo = 0; a.ph_hi = NPH; hipLaunchKernelGGL(fwd, dim3(grid), dim3(512), LDS_BYTES, stream, a);
#endif
}
```

```cpp
#include <hip/hip_runtime.h>
#include <cstdio>
#include <cstdint>

#ifndef PROBE_DUP
#define PROBE_DUP 0
#endif
#ifndef MK_PER_PHASE
#define MK_PER_PHASE 0
#endif

#define GAS __attribute__((address_space(1)))
#define LAS __attribute__((address_space(3)))
typedef unsigned short bf16_t;
typedef short bf16x8 __attribute__((ext_vector_type(8)));
typedef float f32x4 __attribute__((ext_vector_type(4)));
typedef float f32x2 __attribute__((ext_vector_type(2)));
typedef unsigned u32x4 __attribute__((ext_vector_type(4)));
typedef unsigned u32x2 __attribute__((ext_vector_type(2)));
typedef __bf16 bf16x2_t __attribute__((ext_vector_type(2)));

constexpr int NB = 4, SEQ = 2048, M = NB * SEQ, D = 2048, NL = 4, FF = 5632;
constexpr int DIN = 8664, DINP = 8704;
constexpr int ZO_CQ = 0, ZO_CKV = 512, ZO_KR = 1024, ZO_NQ = 1088, ZO_KC = 2624, ZO_VC = 3008, ZO_KS = 3264, ZO_VS = 3648, ZO_KW = 3904, ZO_VW = 4288, ZO_NG = 4544, ZO_GA = 4568, ZO_GB = 6616;
constexpr float EPS = 1e-6f;
constexpr int NCMP = 127;

constexpr size_t MiB = 1u << 20;
constexpr size_t alup(size_t x) { return (x + MiB - 1) / MiB * MiB; }
constexpr size_t WS_CTL = 0, CTL_ZERO_BYTES = 1 * MiB;
constexpr size_t WS_TBL = WS_CTL + CTL_ZERO_BYTES;
constexpr size_t WS_ROPE = WS_TBL + MiB;
constexpr size_t WS_X = WS_ROPE + alup((size_t)M * 32 * 8);
constexpr size_t WS_U = WS_X + alup((size_t)M * D * 4);
constexpr size_t WS_H = WS_U + alup((size_t)M * D * 2);
constexpr size_t WS_Y = WS_H + alup((size_t)M * FF * 2);
constexpr size_t WS_Z = WS_Y + alup((size_t)M * D * 2);
constexpr size_t WS_CQKV = WS_Z + alup((size_t)(M + 64) * DINP * 2);
constexpr size_t WS_KPE = WS_CQKV + alup((size_t)M * 1024 * 2);
constexpr size_t WS_QM = WS_KPE + alup((size_t)M * 64 * 2);
constexpr size_t WS_KV = WS_QM + alup((size_t)M * 1536 * 2);
constexpr size_t WS_AB = WS_KV + alup((size_t)M * 2048 * 2);
constexpr size_t WS_MG = WS_AB + alup((size_t)M * 2048 * 2);
constexpr size_t WS_OC = WS_MG + alup((size_t)M * 2048 * 2);
constexpr size_t WS_PART = WS_OC + alup((size_t)M * 1024 * 4);
constexpr size_t WS_KC = WS_PART + alup((size_t)64 * 256 * 256 * 4);
constexpr size_t WS_SEL = WS_KC + MiB;
constexpr size_t WS_W = WS_SEL + MiB;
constexpr size_t WO_GU1 = 0, WO_D1 = WO_GU1 + (size_t)2 * FF * D, WO_GU2 = WO_D1 + (size_t)D * FF, WO_D2 = WO_GU2 + (size_t)2 * FF * D,
                 WO_IN = WO_D2 + (size_t)D * FF, WO_Q = WO_IN + (size_t)DINP * D, WO_UKV = WO_Q + (size_t)1536 * 512, WO_1K = WO_UKV + (size_t)2048 * 512,
                 WO_1V = WO_1K + (size_t)256 * 6144, WO_AB = WO_1V + (size_t)256 * 4096, WO_OUT = WO_AB + (size_t)2048 * 2048, WO_END = WO_OUT + (size_t)2048 * 2048;
constexpr size_t WS_END = WS_W + alup(WO_END * 2 * NL);
constexpr int CW_BAR = 4096;

constexpr int RING_BYTES = 131072, MISC_OFF = RING_BYTES + 320, LDS_BYTES = 147456;

#define RLX_AGENT __ATOMIC_RELAXED, __HIP_MEMORY_SCOPE_AGENT
__device__ __forceinline__ unsigned cvtpk(float lo, float hi) { f32x2 v = {lo, hi}; bf16x2_t b = __builtin_convertvector(v, bf16x2_t); return __builtin_bit_cast(unsigned, b); }
__device__ __forceinline__ float bflo(unsigned u) { return __uint_as_float(u << 16); }
__device__ __forceinline__ float bfhi(unsigned u) { return __uint_as_float(u & 0xffff0000u); }
__device__ __forceinline__ float bf1(bf16_t h) { return __uint_as_float((unsigned)h << 16); }
__device__ __forceinline__ float wave_sum(float v) {
#pragma unroll
    for (int o = 1; o < 64; o <<= 1) v += __shfl_xor(v, o);
    return v;
}
__device__ __forceinline__ float wave_max(float v) {
#pragma unroll
    for (int o = 1; o < 64; o <<= 1) v = fmaxf(v, __shfl_xor(v, o));
    return v;
}
__device__ __forceinline__ float sigmoidf_(float x) { return 1.0f / (1.0f + __expf(-x)); }

__device__ const float ROPE_INV[32] = {
    1.000000000e+00f, 7.498942614e-01f, 5.623413324e-01f, 4.216965139e-01f, 3.162277639e-01f, 2.371373773e-01f, 1.778279394e-01f, 1.333521307e-01f,
    1.000000015e-01f, 7.498941571e-02f, 5.623413250e-02f, 4.216965288e-02f, 3.162277490e-02f, 2.371373773e-02f, 1.778279431e-02f, 1.333521493e-02f,
    9.999999776e-03f, 7.498941850e-03f, 5.623413250e-03f, 4.216964822e-03f, 3.162277630e-03f, 2.371373586e-03f, 1.778279431e-03f, 1.333521446e-03f,
    1.000000047e-03f, 7.498942432e-04f, 5.623413017e-04f, 4.216965172e-04f, 3.162277571e-04f, 2.371373703e-04f, 1.778279402e-04f, 1.333521504e-04f};
__device__ const unsigned char REL_BUCKET[129] = {
    0, 1, 2, 3, 4, 5, 6, 7, 8, 9, 10, 11, 12, 13, 14, 15, 16, 16, 16, 17, 17, 18, 18, 18, 19, 19, 19, 20, 20, 20, 20, 21, 21, 21, 21, 22, 22, 22, 22, 22, 23, 23, 23, 23, 23, 23, 24, 24, 24, 24, 24, 24,
    25, 25, 25, 25, 25, 25, 25, 26, 26, 26, 26, 26, 26, 26, 26, 27, 27, 27, 27, 27, 27, 27, 27, 27, 27, 28, 28, 28, 28, 28, 28, 28, 28, 28, 28, 29, 29, 29, 29, 29, 29, 29, 29, 29, 29, 29, 29,
    30, 30, 30, 30, 30, 30, 30, 30, 30, 30, 30, 30, 30, 30, 31, 31, 31, 31, 31, 31, 31, 31, 31, 31, 31, 31, 31, 31, 31, 31};

#define XB_TMO      128
#define XB_XCNT(j)  (256  + 64 * (j))
#define XB_XSUB(j)  (1280 + 64 * (j))
#define XB_XGEN(j)  (2304 + 64 * (j))
#define XB_TOP      3328
#define XB_TOPGEN   3392
#define XCD_BAR_WORDS 3456
#define XB_SPIN_CAP (1u << 18)
__device__ __forceinline__ unsigned xb_ld(unsigned* p)              { return __hip_atomic_load(p, __ATOMIC_RELAXED, __HIP_MEMORY_SCOPE_AGENT); }
__device__ __forceinline__ unsigned xb_add(unsigned* p, unsigned v) { return __hip_atomic_fetch_add(p, v, __ATOMIC_RELAXED, __HIP_MEMORY_SCOPE_AGENT); }
__device__ __forceinline__ unsigned xb_xcc_id() { return (unsigned)__builtin_amdgcn_s_getreg((3 << 11) | 20) & 0xFu; }
#define XB_SPIN(cond, bar) do { unsigned _sp = 0; while (cond) { __builtin_amdgcn_s_sleep(1); \
    if ((++_sp & 255u) == 0u) { if (xb_ld(&(bar)[XB_TMO])) break; if (_sp > XB_SPIN_CAP) { atomicAdd(&(bar)[XB_TMO], 1u); break; } } } } while (0)
struct XcdBarrier { unsigned* bar; unsigned x; volatile LAS unsigned* st; };
__device__ __forceinline__ XcdBarrier xcd_barrier_post(unsigned* bar, volatile LAS unsigned* st) {
    XcdBarrier b; b.bar = bar; b.x = xb_xcc_id(); b.st = st;
    if (threadIdx.x == 0) (void)xb_add(&bar[XB_XCNT(b.x)], 1u);
    return b;
}
__device__ __forceinline__ void xcd_barrier_complete(unsigned* bar, unsigned x, unsigned& nloc, unsigned& nx) {
    const unsigned G = gridDim.x * gridDim.y * gridDim.z;
    unsigned sum, cnt, mine, sp = 0u;
    for (;;) {
        sum = 0u; cnt = 0u; mine = 0u;
#pragma unroll
        for (unsigned j = 0; j < 16; ++j) { const unsigned c = xb_ld(&bar[XB_XCNT(j)]); sum += c; cnt += (c > 0u) ? 1u : 0u; mine = (j == x) ? c : mine; }
        if (sum == G) break;
        __builtin_amdgcn_s_sleep(1);
        if ((++sp & 255u) == 0u) { if (xb_ld(&bar[XB_TMO])) break; if (sp > XB_SPIN_CAP) { atomicAdd(&bar[XB_TMO], 1u); break; } }
    }
    nloc = mine > 0u ? mine : 1u; nx = cnt > 0u ? cnt : 1u;
}
__device__ __forceinline__ void xcd_barrier(const XcdBarrier& b) {
    asm volatile("s_waitcnt vmcnt(0)" ::: "memory");
    __syncthreads();
    if (threadIdx.x == 0) {
        unsigned* bar = b.bar;
        __builtin_amdgcn_s_waitcnt(0);
        unsigned nloc = b.st[0], nx = b.st[1];
        if (nloc == 0u) { xcd_barrier_complete(bar, b.x, nloc, nx); b.st[0] = nloc; b.st[1] = nx; }
        const unsigned old = xb_add(&bar[XB_XSUB(b.x)], 1u);
        const unsigned gen = old / nloc;
        if (old + 1u == (gen + 1u) * nloc) {
            __builtin_amdgcn_fence(__ATOMIC_RELEASE, "agent");
            asm volatile("s_waitcnt vmcnt(0)" ::: "memory");
            const unsigned og = xb_add(&bar[XB_TOP], 1u);
            const unsigned tg = og / nx;
            if (og + 1u == (tg + 1u) * nx) xb_add(&bar[XB_TOPGEN], 1u);
            else XB_SPIN(xb_ld(&bar[XB_TOPGEN]) == tg, bar);
            __builtin_amdgcn_fence(__ATOMIC_ACQUIRE, "agent");
            xb_add(&bar[XB_XGEN(b.x)], 1u);
            asm volatile("s_waitcnt vmcnt(0)" ::: "memory");
        } else {
            XB_SPIN(xb_ld(&bar[XB_XGEN(b.x)]) == gen, bar);
            __builtin_amdgcn_fence(__ATOMIC_ACQUIRE, "agent");
            asm volatile("s_waitcnt vmcnt(0)" ::: "memory");
        }
    }
    __syncthreads();
}

namespace pg8 {
constexpr int BM = 256, BK = 64, HALF = 128, HTB = HALF * BK * 2, STAGE_BYTES = 8 * HTB, NXCD = 8, WGM = 8;
__host__ __device__ __forceinline__ int lds_byte(int r, int c) { const int st = (r >> 4) * 2 + (c >> 5), rr = r & 15, cc = c & 31, ob = rr * 64 + cc * 2; return st * 1024 + (ob ^ (((ob >> 9) & 1) << 5)); }
__host__ __device__ __forceinline__ void stage_rc(int b, int& R, int& C) { const int st = b / 1024, sb = b % 1024, swz = sb ^ (((sb >> 9) & 1) << 5); R = (st >> 1) * 16 + swz / 64; C = (st & 1) * 32 + (swz % 64) / 2; }
__host__ __device__ __forceinline__ int perm32(int rho) { const int n = rho >> 4, i = rho & 15; return 8 * (i >> 2) + 4 * n + (i & 3); }

struct Unit { const char* a; const char* b; int pm, pn, aux; };
struct Gemm { int lda, ldb, nt; size_t gstride; };

struct StaticOrder {
    int nM, nN, nwg, G, c;
    __device__ void init(int M_, int N_, int G_, int c_) { nM = M_ / BM; nN = N_ / BM; nwg = nM * nN; G = G_; c = c_; }
    __device__ bool next(int i, int& pm, int& pn) const {
        const long L = (long)i * G + c; if (L >= nwg) return false;
        int wgid = (int)L; { const int q = nwg / NXCD, r = nwg % NXCD, xcd = wgid % NXCD, off = wgid / NXCD; wgid = (xcd < r ? xcd * (q + 1) : r * (q + 1) + (xcd - r) * q) + off; }
        const int nig = WGM * nN, gid = wgid / nig, fm = gid * WGM, gsz = (nM - fm) < WGM ? (nM - fm) : WGM;
        pm = fm + ((wgid % nig) % gsz); pn = (wgid % nig) / gsz; return true;
    }
};

template <class Epi, class Sched, int KGRP>
__device__ __forceinline__ void gemm_phase(LAS unsigned char* lds, const Gemm g, const Sched& S, const Epi& E) {
    int tid_ = threadIdx.x; asm volatile("" : "+v"(tid_));
    const int tid = tid_, wid = __builtin_amdgcn_readfirstlane(tid >> 6), lane = tid & 63, wr = wid >> 2, wc = wid & 3, fr = lane & 15, fq = lane >> 4;
    const int nt = g.nt;
    unsigned voffA[2], voffB[2];
#pragma unroll
    for (int i = 0; i < 2; ++i) { int R, C; stage_rc(tid * 16 + i * 8192, R, C); const int Rb = (R & ~31) + perm32(R & 31);
        voffA[i] = (unsigned)(R * g.lda + C) * 2u; voffB[i] = (unsigned)(Rb * g.ldb + C) * 2u; }
    const size_t kstep = (size_t)(BK * 2);
    const size_t hstepA = (size_t)HALF * g.lda * 2, hstepB = (size_t)HALF * g.ldb * 2;
    const unsigned ldsw = (unsigned)wid * 1024u;
    const int aoff = lds_byte(wr * 64 + fr, fq * 8), boff = lds_byte(wc * 32 + fr, fq * 8);
    auto koffA = [&](int t) -> size_t { if constexpr (KGRP > 0) return (size_t)(t / KGRP) * g.gstride + (size_t)(t % KGRP) * kstep; else return (size_t)t * kstep; };
#define PG8_SA(b, h) (((b) * 2 + (h)) * HTB)
#define PG8_SB(b, h) ((4 + (b) * 2 + (h)) * HTB)
#define PG8_STAGE(bufoff, gbase, voff) do { _Pragma("unroll") for (int _i = 0; _i < 2; ++_i) \
        __builtin_amdgcn_global_load_lds((const unsigned*)((const char*)(gbase) + (voff)[_i]), (LAS unsigned*)(lds + (bufoff) + ldsw + _i * 8192), 16, 0, 0); } while (0)
#define PG8_LDA(dst, b, h) do { _Pragma("unroll") for (int m = 0; m < 4; ++m) _Pragma("unroll") for (int k = 0; k < 2; ++k) dst[m][k] = *(const LAS bf16x8*)(lds + PG8_SA(b, h) + aoff + m * 2048 + k * 1024); } while (0)
#define PG8_LDB(dst, b, h) do { _Pragma("unroll") for (int n = 0; n < 2; ++n) _Pragma("unroll") for (int k = 0; k < 2; ++k) dst[n][k] = *(const LAS bf16x8*)(lds + PG8_SB(b, h) + boff + n * 2048 + k * 1024); } while (0)
#define PG8_MMA(ai, bj, At, Bt) do { __builtin_amdgcn_s_setprio(1); _Pragma("unroll") for (int m = 0; m < 4; ++m) _Pragma("unroll") for (int n = 0; n < 2; ++n) _Pragma("unroll") for (int k = 0; k < 2; ++k) \
        acc[ai][bj][m][n] = __builtin_amdgcn_mfma_f32_16x16x32_bf16(Bt[n][k], At[m][k], acc[ai][bj][m][n], 0, 0, 0); __builtin_amdgcn_s_setprio(0); } while (0)
#define PG8_WAIT_V(n) asm volatile("s_waitcnt vmcnt(" #n ")" ::: "memory")
#define PG8_WAIT_L(n) asm volatile("s_waitcnt lgkmcnt(" #n ")" ::: "memory")
#define PG8_BAR __builtin_amdgcn_s_barrier()
#define PG8_SCHED __builtin_amdgcn_sched_barrier(0)
    Unit cur, nxt; int ui = 0;
    if (!S.next(0, cur)) return;
    f32x4 acc[2][2][4][2];
#pragma unroll
    for (int a = 0; a < 2; ++a)
#pragma unroll
        for (int b = 0; b < 2; ++b)
#pragma unroll
            for (int m = 0; m < 4; ++m)
#pragma unroll
                for (int n = 0; n < 2; ++n) acc[a][b][m][n] = (f32x4){0.f, 0.f, 0.f, 0.f};
    bf16x8 At[4][2], B0[2][2], B1[2][2];
    const char* cA = cur.a; const char* cB = cur.b;
    PG8_STAGE(PG8_SB(0, 0), cB, voffB); PG8_STAGE(PG8_SB(0, 1), cB + hstepB, voffB); PG8_STAGE(PG8_SA(0, 0), cA, voffA); PG8_STAGE(PG8_SA(0, 1), cA + hstepA, voffA);
    if (wr == 1) PG8_BAR;
    PG8_WAIT_V(2); PG8_BAR;
    { const char* a1p = cA + koffA(1);
      PG8_STAGE(PG8_SB(1, 0), cB + kstep, voffB); PG8_STAGE(PG8_SA(1, 0), a1p, voffA); PG8_STAGE(PG8_SB(1, 1), cB + hstepB + kstep, voffB); }
    PG8_WAIT_V(6); PG8_BAR;
    for (;;) {
        const bool has_next = S.next(ui + 1, nxt);
        const char* nA = has_next ? nxt.a : cA; const char* nB = has_next ? nxt.b : cB;
        for (int t = 0; t < nt; t += 2) {
            const bool last = (t == nt - 2);
            const char* a1 = cA + koffA(t + 1);
            const char* a2 = last ? nA : cA + koffA(t + 2); const char* b2 = last ? nB : cB + (size_t)(t + 2) * kstep;
            const char* a3 = last ? nA + koffA(1) : cA + koffA(t + 3); const char* b3 = b2 + kstep;
            PG8_LDB(B0, 0, 0); PG8_LDB(B1, 0, 1); PG8_SCHED; PG8_LDA(At, 0, 0); PG8_STAGE(PG8_SA(1, 1), a1 + hstepA, voffA);
            PG8_WAIT_V(8); PG8_WAIT_L(0); PG8_BAR; PG8_MMA(0, 0, At, B0); PG8_MMA(0, 1, At, B1); PG8_BAR; PG8_SCHED;
            PG8_LDA(At, 0, 1); PG8_STAGE(PG8_SB(0, 0), b2, voffB); PG8_STAGE(PG8_SB(0, 1), b2 + hstepB, voffB); PG8_STAGE(PG8_SA(0, 0), a2, voffA);
            PG8_WAIT_V(8); PG8_WAIT_L(0); PG8_BAR; PG8_MMA(1, 0, At, B0); PG8_MMA(1, 1, At, B1); PG8_BAR; PG8_SCHED;
            PG8_LDB(B0, 1, 0); PG8_LDB(B1, 1, 1); PG8_SCHED; PG8_LDA(At, 1, 0); PG8_STAGE(PG8_SA(0, 1), a2 + hstepA, voffA);
            PG8_WAIT_V(8); PG8_WAIT_L(0); PG8_BAR; PG8_MMA(0, 0, At, B0); PG8_MMA(0, 1, At, B1); PG8_BAR; PG8_SCHED;
            PG8_LDA(At, 1, 1); PG8_STAGE(PG8_SB(1, 0), b3, voffB); PG8_STAGE(PG8_SB(1, 1), b3 + hstepB, voffB); PG8_STAGE(PG8_SA(1, 0), a3, voffA);
            PG8_WAIT_V(8); PG8_WAIT_L(0); PG8_BAR; PG8_MMA(1, 0, At, B0); PG8_MMA(1, 1, At, B1); PG8_BAR; PG8_SCHED;
        }
        if (wr == 0) PG8_BAR;
        const bool keep = E(acc, cur, wr, wc, fr, fq);
        if (!has_next) break;
        if (!keep) {
#pragma unroll
            for (int a = 0; a < 2; ++a)
#pragma unroll
                for (int b = 0; b < 2; ++b)
#pragma unroll
                    for (int m = 0; m < 4; ++m)
#pragma unroll
                        for (int n = 0; n < 2; ++n) acc[a][b][m][n] = (f32x4){0.f, 0.f, 0.f, 0.f};
        }
        cur = nxt; cA = nA; cB = nB; ++ui;
        if (wr == 1) PG8_BAR;
    }
    PG8_WAIT_V(0);
    PG8_BAR;
#undef PG8_SA
#undef PG8_SB
#undef PG8_STAGE
#undef PG8_LDA
#undef PG8_LDB
#undef PG8_MMA
#undef PG8_WAIT_V
#undef PG8_WAIT_L
#undef PG8_BAR
#undef PG8_SCHED
}
}
using pg8::Unit; using pg8::Gemm;
typedef f32x4 Acc[2][2][4][2];

struct SchedStd {
    pg8::StaticOrder so; const char* A; const char* B; size_t tA, tB;
    __device__ void init(const bf16_t* A_, int lda, const bf16_t* B_, int ldb, int M_, int N_, int G, int c) { so.init(M_, N_, G, c); A = (const char*)A_; B = (const char*)B_; tA = (size_t)256 * lda * 2; tB = (size_t)256 * ldb * 2; }
    __device__ bool next(int i, Unit& u) const { int pm, pn; if (!so.next(i, pm, pn)) return false; u.pm = pm; u.pn = pn; u.aux = 0; u.a = A + pm * tA; u.b = B + pn * tB; return true; }
};

struct EpiBf16 {
    bf16_t* O; int ldc;
    __device__ __forceinline__ bool operator()(Acc& acc, const Unit& u, int wr, int wc, int fr, int fq) const {
        const int row0 = u.pm * 256 + wr * 64 + fr, col0 = u.pn * 256 + wc * 32 + 8 * fq;
#pragma unroll
        for (int ai = 0; ai < 2; ++ai)
#pragma unroll
            for (int m = 0; m < 4; ++m) { bf16_t* rowp = O + (size_t)(row0 + ai * 128 + m * 16) * ldc + col0;
#pragma unroll
                for (int bj = 0; bj < 2; ++bj) { const f32x4 v0 = acc[ai][bj][m][0], v1 = acc[ai][bj][m][1];
                    u32x4 w; w.x = cvtpk(v0[0], v0[1]); w.y = cvtpk(v0[2], v0[3]); w.z = cvtpk(v1[0], v1[1]); w.w = cvtpk(v1[2], v1[3]);
                    *(u32x4*)(rowp + bj * 128) = w; } }
        return false;
    }
};
struct EpiSwiGLU {
    bf16_t* O; int ldc;
    __device__ __forceinline__ bool operator()(Acc& acc, const Unit& u, int wr, int wc, int fr, int fq) const {
        const int row0 = u.pm * 256 + wr * 64 + fr, col0 = u.pn * 128 + wc * 32 + 8 * fq;
#pragma unroll
        for (int ai = 0; ai < 2; ++ai)
#pragma unroll
            for (int m = 0; m < 4; ++m) { bf16_t* rowp = O + (size_t)(row0 + ai * 128 + m * 16) * ldc + col0;
                float h[8];
#pragma unroll
                for (int n = 0; n < 2; ++n)
#pragma unroll
                    for (int e = 0; e < 4; ++e) { const float gt = acc[ai][0][m][n][e], up = acc[ai][1][m][n][e]; h[n * 4 + e] = gt * sigmoidf_(gt) * up; }
                u32x4 w; w.x = cvtpk(h[0], h[1]); w.y = cvtpk(h[2], h[3]); w.z = cvtpk(h[4], h[5]); w.w = cvtpk(h[6], h[7]);
                *(u32x4*)rowp = w; }
        return false;
    }
};
struct EpiSlab {
    float* P;
    __device__ __forceinline__ bool operator()(Acc& acc, const Unit& u, int wr, int wc, int fr, int fq) const {
        float* base = P + (size_t)u.aux * 65536;
#pragma unroll
        for (int ai = 0; ai < 2; ++ai)
#pragma unroll
            for (int m = 0; m < 4; ++m) { float* rowp = base + (size_t)(ai * 128 + wr * 64 + m * 16 + fr) * 256 + wc * 32 + 8 * fq;
#pragma unroll
                for (int bj = 0; bj < 2; ++bj) { *(f32x4*)(rowp + bj * 128) = acc[ai][bj][m][0]; *(f32x4*)(rowp + bj * 128 + 4) = acc[ai][bj][m][1]; } }
        return false;
    }
};
struct EpiQKV {
    bf16_t* Q; bf16_t* KV;
    __device__ __forceinline__ bool operator()(Acc& acc, const Unit& u, int wr, int wc, int fr, int fq) const {
        EpiBf16 e{u.aux ? KV : Q, u.aux ? 2048 : 1536}; return e(acc, u, wr, wc, fr, fq);
    }
};
struct EpiMerge {
    const bf16_t* Z; bf16_t* O;
    __device__ __forceinline__ bool operator()(Acc& acc, const Unit& u, int wr, int wc, int fr, int fq) const {
        const int row0 = u.pm * 256 + wr * 64 + fr, col0 = u.pn * 256 + wc * 32 + 8 * fq;
#pragma unroll
        for (int ai = 0; ai < 2; ++ai)
#pragma unroll
            for (int m = 0; m < 4; ++m) { const size_t row = (size_t)(row0 + ai * 128 + m * 16);
#pragma unroll
                for (int bj = 0; bj < 2; ++bj) { const int col = col0 + bj * 128;
                    const u32x4 gbw = *(const u32x4*)(Z + row * DINP + ZO_GB + col);
                    float gb[8] = {sigmoidf_(bflo(gbw.x)), sigmoidf_(bfhi(gbw.x)), sigmoidf_(bflo(gbw.y)), sigmoidf_(bfhi(gbw.y)), sigmoidf_(bflo(gbw.z)), sigmoidf_(bfhi(gbw.z)), sigmoidf_(bflo(gbw.w)), sigmoidf_(bfhi(gbw.w))};
                    if (u.aux == 0) {
                        const u32x4 gaw = *(const u32x4*)(Z + row * DINP + ZO_GA + col);
                        float ga[8] = {sigmoidf_(bflo(gaw.x)), sigmoidf_(bfhi(gaw.x)), sigmoidf_(bflo(gaw.y)), sigmoidf_(bfhi(gaw.y)), sigmoidf_(bflo(gaw.z)), sigmoidf_(bfhi(gaw.z)), sigmoidf_(bflo(gaw.w)), sigmoidf_(bfhi(gaw.w))};
#pragma unroll
                        for (int n = 0; n < 2; ++n)
#pragma unroll
                            for (int e = 0; e < 4; ++e) acc[ai][bj][m][n][e] *= ga[n * 4 + e] / gb[n * 4 + e];
                    } else {
                        float h[8];
#pragma unroll
                        for (int n = 0; n < 2; ++n)
#pragma unroll
                            for (int e = 0; e < 4; ++e) h[n * 4 + e] = acc[ai][bj][m][n][e] * gb[n * 4 + e];
                        u32x4 w; w.x = cvtpk(h[0], h[1]); w.y = cvtpk(h[2], h[3]); w.z = cvtpk(h[4], h[5]); w.w = cvtpk(h[6], h[7]);
                        *(u32x4*)(O + row * 2048 + col) = w;
                    } } }
        return u.aux == 0;
    }
};

struct Args { const float* in[30]; float* out; unsigned char* ws; int ph_lo, ph_hi; };
enum { I_X = 0, I_POS, I_RELB, I_F1PRE, I_F1POST, I_F1G, I_F1U, I_F1D, I_MPRE, I_MPOST, I_WIN, I_QNG, I_WQUP, I_KVNG, I_WUK, I_WUV, I_PEK, I_W1K, I_W2K, I_PEV, I_W1V, I_W2V, I_WA, I_WB, I_WOUT,
       I_F2PRE, I_F2POST, I_F2G, I_F2U, I_F2D };
struct Frame {
    LAS unsigned char* lds; int tid, lane, wave, G, cu;
    const float* const* in; float* out; unsigned char* ws;
};

__device__ __forceinline__ void launder(Frame& F) { unsigned long long w_ = (unsigned long long)F.ws; unsigned lo_ = (unsigned)w_, hi_ = (unsigned)(w_ >> 32);
    int cu_ = F.cu; asm volatile("" : "+v"(F.tid), "+v"(F.lane), "+v"(lo_), "+v"(hi_), "+v"(cu_));
    lo_ = (unsigned)__builtin_amdgcn_readfirstlane((int)lo_); hi_ = (unsigned)__builtin_amdgcn_readfirstlane((int)hi_); F.ws = (unsigned char*)(((unsigned long long)hi_ << 32) | lo_); F.cu = __builtin_amdgcn_readfirstlane(cu_); }
__device__ __forceinline__ void p0_transpose_item(const float* W, int K, int N, bf16_t* WT, int ldk, int koff, int mode, int row_off, LAS float* scr, int item, int lane) {
    const int nblk = (N + 31) / 32, kb = item / nblk, nb = item % nblk, k0 = 64 * kb, n0 = 32 * nb;
    const bool nok = (n0 + (lane & 31)) < N;
#pragma unroll 8
    for (int i = 0; i < 32; ++i) { const int kk = 2 * i + (lane >> 5); scr[kk * 33 + (lane & 31)] = nok ? W[(size_t)(k0 + kk) * N + n0 + (lane & 31)] : 0.f; }
    asm volatile("s_waitcnt lgkmcnt(0)" ::: "memory");
    const int c = lane & 7;
    const int rbase = mode ? ((n0 >> 7) * 256 + row_off + (n0 & 127)) : (row_off + n0);
#pragma unroll
    for (int j = 0; j < 4; ++j) { const int n = (lane >> 3) + 8 * j; const LAS float* s = scr + (8 * c) * 33 + n;
        u32x4 o; o.x = cvtpk(s[0 * 33], s[1 * 33]); o.y = cvtpk(s[2 * 33], s[3 * 33]); o.z = cvtpk(s[4 * 33], s[5 * 33]); o.w = cvtpk(s[6 * 33], s[7 * 33]);
        if (n0 + n < N) *(u32x4*)(WT + (size_t)(rbase + n) * ldk + koff + k0 + 8 * c) = o; }
    asm volatile("s_waitcnt lgkmcnt(0)" ::: "memory");
}
__device__ __forceinline__ unsigned cvt_offb(unsigned row, unsigned ch) { return 256u * row + 16u * (ch ^ (((row & 3u) << 2) | ((row >> 2) & 3u))); }
__device__ __forceinline__ void p0_cvt_tile(Frame& F, const float* W, int K, int N, bf16_t* WT, int ldk, int koff, int mode, int row_off, int item) {
    typedef short v4i16_t __attribute__((ext_vector_type(4)));
    const int ntn = (N + 127) >> 7, kb = item / ntn, nb = item - kb * ntn, k0 = kb * 128, n0 = nb * 128;
    const int tid = F.tid, lane = F.lane, w = F.wave;
    f32x4 v[8];
#pragma unroll
    for (int i = 0; i < 8; ++i) { const int c = tid + 512 * i, k = c >> 5, n = n0 + 4 * (c & 31);
        v[i] = (n < N) ? *(const f32x4*)(W + (size_t)(k0 + k) * N + n) : (f32x4){0.f, 0.f, 0.f, 0.f}; }
    __syncthreads();
#pragma unroll
    for (int i = 0; i < 8; ++i) { const int c = tid + 512 * i, k = c >> 5, nch = c & 31;
        *(LAS u32x2*)(F.lds + cvt_offb(k, nch >> 1) + 8 * (nch & 1)) = (u32x2){cvtpk(v[i].x, v[i].y), cvtpk(v[i].z, v[i].w)}; }
    __syncthreads();
    const int c4 = w & 3, ks0 = (w >> 2) * 4;
    const unsigned h = lane >> 5, blk = (lane >> 4) & 1, q = (lane & 15) >> 2, p = lane & 3;
    const int nl = 32 * c4 + (lane & 31);
    const int rbase = mode ? ((n0 >> 7) * 256 + row_off) : (row_off + n0);
    bf16_t* dst = WT + (size_t)(rbase + nl) * ldk + koff + k0 + 8 * h;
#pragma unroll
    for (int kk = 0; kk < 4; ++kk) { const int ks = ks0 + kk;
        const v4i16_t lo = __builtin_amdgcn_ds_read_tr16_b64_v4i16((LAS v4i16_t*)(F.lds + cvt_offb(16 * ks + 8 * h + q, 4 * c4 + 2 * blk + (p >> 1)) + 8 * (p & 1)));
        const v4i16_t hi = __builtin_amdgcn_ds_read_tr16_b64_v4i16((LAS v4i16_t*)(F.lds + cvt_offb(16 * ks + 8 * h + 4 + q, 4 * c4 + 2 * blk + (p >> 1)) + 8 * (p & 1)));
        const bf16x8 o = {lo[0], lo[1], lo[2], lo[3], hi[0], hi[1], hi[2], hi[3]};
        if (n0 + nl < N) *(bf16x8*)(dst + 16 * ks) = o; }
}
struct CvtJob { int in_idx, K, N, ldk, koff, mode, row_off; size_t dst_off; };
__device__ __forceinline__ CvtJob cvt_job(int j) {
    switch (j) {
    case 0:  return CvtJob{I_F1G, D, FF, D, 0, 1, 0, WO_GU1};
    case 1:  return CvtJob{I_F1U, D, FF, D, 0, 1, 128, WO_GU1};
    case 2:  return CvtJob{I_F1D, FF, D, FF, 0, 0, 0, WO_D1};
    case 3:  return CvtJob{I_F2G, D, FF, D, 0, 1, 0, WO_GU2};
    case 4:  return CvtJob{I_F2U, D, FF, D, 0, 1, 128, WO_GU2};
    case 5:  return CvtJob{I_F2D, FF, D, FF, 0, 0, 0, WO_D2};
    case 6:  return CvtJob{I_WIN, D, DIN, D, 0, 0, 0, WO_IN};
    case 7:  return CvtJob{I_WQUP, 512, 1536, 512, 0, 0, 0, WO_Q};
    case 8:  return CvtJob{I_WUK, 512, 1024, 512, 0, 0, 0, WO_UKV};
    case 9:  return CvtJob{I_WUV, 512, 1024, 512, 0, 0, 1024, WO_UKV};
    case 10: return CvtJob{I_W1K, 6144, 256, 6144, 0, 0, 0, WO_1K};
    case 11: return CvtJob{I_W1V, 4096, 256, 4096, 0, 0, 0, WO_1V};
    case 12: return CvtJob{I_WA, 1024, 2048, 2048, 0, 0, 0, WO_AB};
    case 13: return CvtJob{I_WB, 1024, 2048, 2048, 1024, 0, 0, WO_AB};
    default: return CvtJob{I_WOUT, 2048, 2048, 2048, 0, 0, 0, WO_OUT};
    }
}
constexpr int N_CVT_JOBS = 15;
__device__ __forceinline__ void p0_prologue(Frame& F) {
    LAS float* scr = (LAS float*)(F.lds + F.wave * 16384);
    const int gw = F.cu * 8 + F.wave, NGW = F.G * 8;
    bf16_t* wbase = (bf16_t*)(F.ws + WS_W);
    int rot = 0;
    for (int l = 0; l < NL; ++l)
        for (int j = 0; j < N_CVT_JOBS; ++j) {
            const CvtJob J = cvt_job(j);
            const float* src = F.in[J.in_idx] + (size_t)l * J.K * J.N;
            bf16_t* dst = wbase + (size_t)l * WO_END + J.dst_off;
            const int nitems = (J.K / 128) * ((J.N + 127) / 128);
            { int first = F.cu - rot; if (first < 0) first += F.G;
              for (int it = first; it < nitems; it += F.G) p0_cvt_tile(F, src, J.K, J.N, dst, J.ldk, J.koff, J.mode, J.row_off, it);
              rot = (rot + nitems) % F.G; }
        }
    __syncthreads();
    {
        const f32x4* xs = (const f32x4*)F.in[I_X]; f32x4* xd = (f32x4*)(F.ws + WS_X);
        for (size_t i = (size_t)F.cu * 512 + F.tid; i < (size_t)M * D / 4; i += (size_t)F.G * 512) xd[i] = xs[i];
        const int* pos = (const int*)F.in[I_POS]; f32x2* rope = (f32x2*)(F.ws + WS_ROPE);
        for (int i = F.cu * 512 + F.tid; i < M * 32; i += F.G * 512) {
            const float ang = (float)pos[i >> 5] * ROPE_INV[i & 31];
            const double rev = (double)ang * 0.15915494309189535; const float fr = (float)(rev - __builtin_rint(rev));
            rope[i] = (f32x2){__builtin_amdgcn_cosf(fr), __builtin_amdgcn_sinf(fr)};
        }
        float* tbl = (float*)(F.ws + WS_TBL);
        if (F.cu == 0) for (int i = F.tid; i < 8 * 132; i += 512) { const int h = i / 132, d = i % 132; const float tv = F.in[I_RELB][REL_BUCKET[d > 128 ? 128 : d] * 8 + h]; tbl[i] = tv; ((float*)(F.ws + WS_TBL + 16384))[i] = tv * 1.4426950408889634f; }
        if (F.cu >= 1 && F.cu <= 2 * NL) {
            const int l = (F.cu - 1) >> 1, kv = (F.cu - 1) & 1, Kk = kv ? 4096 : 6144;
            const float* pe = F.in[kv ? I_PEV : I_PEK] + (size_t)l * Kk; const float* w1 = F.in[kv ? I_W1V : I_W1K] + (size_t)l * Kk * 256;
            const int c = F.tid & 255, hf = F.tid >> 8; float s = 0.f;
            for (int k = hf * (Kk / 2); k < (hf + 1) * (Kk / 2); ++k) s += pe[k] * w1[(size_t)k * 256 + c];
            LAS float* red = (LAS float*)F.lds;
            __syncthreads();
            if (hf) red[c] = s;
            __syncthreads();
            if (!hf) ((float*)(F.ws + WS_TBL + 8192))[(l * 2 + kv) * 256 + c] = s + red[c];
            __syncthreads();
        }
    }
}

__device__ __forceinline__ void thin_first_norm(Frame& F, const float* g) {
    const int gw = F.cu * 8 + F.wave, NGW = F.G * 8;
    const float* X = (const float*)(F.ws + WS_X); bf16_t* U = (bf16_t*)(F.ws + WS_U);
    for (int m = gw; m < M; m += NGW) {
        const f32x4* xr = (const f32x4*)(X + (size_t)m * D) + F.lane; f32x4 v[8]; float s = 0.f;
#pragma unroll
        for (int j = 0; j < 8; ++j) { v[j] = xr[64 * j]; s += (v[j].x * v[j].x + v[j].y * v[j].y) + (v[j].z * v[j].z + v[j].w * v[j].w); }
        const float r = 1.0f / sqrtf(wave_sum(s) * (1.f / D) + EPS);
        u32x2* o = (u32x2*)(U + (size_t)m * D) + F.lane;
#pragma unroll
        for (int j = 0; j < 8; ++j) { const f32x4 gg = ((const f32x4*)g)[F.lane + 64 * j]; o[64 * j] = (u32x2){cvtpk(v[j].x * r * gg.x, v[j].y * r * gg.y), cvtpk(v[j].z * r * gg.z, v[j].w * r * gg.w)}; }
    }
}
__device__ __forceinline__ void thin_post_norm(Frame& F, float coef, const float* gpost, const float* gpre, float* outp) {
    const int gw = F.cu * 8 + F.wave, NGW = F.G * 8;
    float* X = (float*)(F.ws + WS_X); bf16_t* U = (bf16_t*)(F.ws + WS_U); const bf16_t* Y = (const bf16_t*)(F.ws + WS_Y);
    for (int m = gw; m < M; m += NGW) {
        f32x4* xr = (f32x4*)(X + (size_t)m * D) + F.lane; const u32x2* yr = (const u32x2*)(Y + (size_t)m * D) + F.lane;
        f32x4 y[8]; float s = 0.f;
#pragma unroll
        for (int j = 0; j < 8; ++j) { const u32x2 w = yr[64 * j]; y[j] = (f32x4){bflo(w.x), bfhi(w.x), bflo(w.y), bfhi(w.y)}; s += (y[j].x * y[j].x + y[j].y * y[j].y) + (y[j].z * y[j].z + y[j].w * y[j].w); }
        const float r = coef / sqrtf(wave_sum(s) * (1.f / D) + EPS);
        float s2 = 0.f;
#pragma unroll
        for (int j = 0; j < 8; ++j) { const f32x4 gg = ((const f32x4*)gpost)[F.lane + 64 * j]; f32x4 x = xr[64 * j];
            x.x += y[j].x * r * gg.x; x.y += y[j].y * r * gg.y; x.z += y[j].z * r * gg.z; x.w += y[j].w * r * gg.w; y[j] = x;
            s2 += (x.x * x.x + x.y * x.y) + (x.z * x.z + x.w * x.w);
            if (outp) ((f32x4*)(outp + (size_t)m * D))[F.lane + 64 * j] = x; else xr[64 * j] = x; }
        if (gpre) {
            const float r2 = 1.0f / sqrtf(wave_sum(s2) * (1.f / D) + EPS);
            u32x2* o = (u32x2*)(U + (size_t)m * D) + F.lane;
#pragma unroll
            for (int j = 0; j < 8; ++j) { const f32x4 gg = ((const f32x4*)gpre)[F.lane + 64 * j]; o[64 * j] = (u32x2){cvtpk(y[j].x * r2 * gg.x, y[j].y * r2 * gg.y), cvtpk(y[j].z * r2 * gg.z, y[j].w * r2 * gg.w)}; }
        }
    }
}
__device__ __forceinline__ void thin_mix(Frame& F, const float* gq, const float* gkv) {
    const int gw = F.cu * 8 + F.wave, NGW = F.G * 8;
    const bf16_t* Z = (const bf16_t*)(F.ws + WS_Z); bf16_t* C = (bf16_t*)(F.ws + WS_CQKV); bf16_t* KPE = (bf16_t*)(F.ws + WS_KPE); const f32x2* rope = (const f32x2*)(F.ws + WS_ROPE);
    for (int m = gw; m < M; m += NGW) {
        const bf16_t* zr = Z + (size_t)m * DINP;
#pragma unroll
        for (int part = 0; part < 2; ++part) {
            const u32x4 w = *((const u32x4*)(zr + part * 512) + F.lane);
            float v[8] = {bflo(w.x), bfhi(w.x), bflo(w.y), bfhi(w.y), bflo(w.z), bfhi(w.z), bflo(w.w), bfhi(w.w)}; float s = 0.f;
#pragma unroll
            for (int e = 0; e < 8; ++e) s += v[e] * v[e];
            const float r = 1.0f / sqrtf(wave_sum(s) * (1.f / 512.f) + EPS);
            const float* g = (part ? gkv : gq) + 8 * F.lane; const f32x4 g0 = *(const f32x4*)g, g1 = *(const f32x4*)(g + 4);
            u32x4 o; o.x = cvtpk(v[0] * r * g0.x, v[1] * r * g0.y); o.y = cvtpk(v[2] * r * g0.z, v[3] * r * g0.w); o.z = cvtpk(v[4] * r * g1.x, v[5] * r * g1.y); o.w = cvtpk(v[6] * r * g1.z, v[7] * r * g1.w);
            *((u32x4*)(C + (size_t)m * 1024 + part * 512) + F.lane) = o;
        }
        if (F.lane < 32) {
            const float x1 = bf1(zr[ZO_KR + F.lane]), x2 = bf1(zr[ZO_KR + 32 + F.lane]); const f32x2 cs = rope[(size_t)m * 32 + F.lane];
            const unsigned a = cvtpk(x1 * cs.x - x2 * cs.y, x1 * cs.y + x2 * cs.x);
            KPE[(size_t)m * 64 + F.lane] = (bf16_t)(a & 0xffffu); KPE[(size_t)m * 64 + 32 + F.lane] = (bf16_t)(a >> 16);
        }
    }
}
__device__ __forceinline__ void cmp_stage2_unit(Frame& F, int unit, int l) {
    const int kv = unit >> 6, u = unit & 63, g = u >> 5, r0 = (u & 31) * 16;
    const int NO = kv ? 128 : 192;
    const float* part = (const float*)(F.ws + WS_PART); const float* pb = (const float*)(F.ws + WS_TBL + 8192) + (l * 2 + kv) * 256;
    const float* w2 = F.in[kv ? I_W2V : I_W2K] + (size_t)l * 256 * NO;
    LAS float* hid = (LAS float*)F.lds;
    __syncthreads();
    {
        const int row = F.tid >> 5, c0 = (F.tid & 31) * 8, rp = r0 + row, rt = rp >> 8, rr = rp & 255;
        f32x4 s0 = *(const f32x4*)(pb + c0), s1 = *(const f32x4*)(pb + c0 + 4);
#pragma unroll
        for (int s = 0; s < 8; ++s) { const float* p = part + (size_t)((((kv * 2 + g) * 2 + rt) * 8) + s) * 65536 + (size_t)rr * 256 + c0; s0 += *(const f32x4*)p; s1 += *(const f32x4*)(p + 4); }
        float h[8] = {s0.x, s0.y, s0.z, s0.w, s1.x, s1.y, s1.z, s1.w};
#pragma unroll
        for (int e = 0; e < 8; ++e) hid[row * 256 + c0 + e] = h[e] * sigmoidf_(h[e]);
    }
    __syncthreads();
    bf16_t* dst = (bf16_t*)(F.ws + WS_KC + (kv ? 524288 : 0));
    for (int o = F.tid; o < 16 * NO; o += 512) {
        const int row = o / NO, n = o % NO; float a = 0.f;
#pragma unroll 8
        for (int c = 0; c < 256; ++c) a += hid[row * 256 + c] * w2[c * NO + n];
        const int rp = r0 + row, b = rp >> 7, nn = rp & 127;
        dst[(size_t)((b * 2 + g) * 128 + nn) * NO + n] = (bf16_t)(cvtpk(a, 0.f) & 0xffffu);
    }
}

template <bool ROPE>
__device__ __forceinline__ void load_q(Frame& F, const bf16_t* qp, float scale, LAS float* qs, const f32x2* rope_row) {
    if (F.lane < 24) { const u32x4 w = *((const u32x4*)qp + F.lane); LAS float* d = qs + 8 * F.lane;
        d[0] = bflo(w.x) * scale; d[1] = bfhi(w.x) * scale; d[2] = bflo(w.y) * scale; d[3] = bfhi(w.y) * scale; d[4] = bflo(w.z) * scale; d[5] = bfhi(w.z) * scale; d[6] = bflo(w.w) * scale; d[7] = bfhi(w.w) * scale; }
    if (ROPE) { if (F.lane < 32) { const float x1 = qs[128 + F.lane], x2 = qs[160 + F.lane]; const f32x2 cs = rope_row[F.lane]; qs[128 + F.lane] = x1 * cs.x - x2 * cs.y; qs[160 + F.lane] = x1 * cs.y + x2 * cs.x; } }
}
__device__ __forceinline__ float dot8(const u32x4 w, const LAS float* q) {
    const f32x4 a = *(const LAS f32x4*)q, b = *(const LAS f32x4*)(q + 4);
    return (bflo(w.x) * a.x + bfhi(w.x) * a.y) + (bflo(w.y) * a.z + bfhi(w.y) * a.w) + (bflo(w.z) * b.x + bfhi(w.z) * b.y) + (bflo(w.w) * b.z + bfhi(w.w) * b.w);
}
template <int MODE>
__device__ __forceinline__ void naive_row(Frame& F, int b, int t, int head, float gate, float& o0, float& o1, LAS float* sc, const LAS float* qs, unsigned selmask, int& nk_out) {
    const int g = head >> 2; const size_t mb = (size_t)b * SEQ;
    const bf16_t* Z = (const bf16_t*)(F.ws + WS_Z); const bf16_t* KV = (const bf16_t*)(F.ws + WS_KV); const bf16_t* KPE = (const bf16_t*)(F.ws + WS_KPE);
    const bf16_t* KC = (const bf16_t*)(F.ws + WS_KC); const bf16_t* VC = (const bf16_t*)(F.ws + WS_KC + 524288);
    const float* tbl = (const float*)(F.ws + WS_TBL) + head * 132; const int* pos = (const int*)F.in[I_POS] + mb;
    const int k0 = (MODE == 2) ? (t > 511 ? t - 511 : 0) : 0;
    const int k1 = (MODE == 3) ? (t < 31 ? -1 : (t - 31) / 16) : t;
    nk_out = k1 - k0 + 1;
    if (k1 < k0) return;
    const int qpos = (MODE != 0) ? pos[t] : 0;
    float mx = -INFINITY;
    for (int kb = k0; kb <= k1; kb += 64) {
        const int k = kb + F.lane; bool valid = k <= k1;
        if (MODE == 1) valid = valid && ((selmask >> (k >> 6)) & 1u);
        float s = -INFINITY;
        if (valid) {
            const bf16_t* p1; const bf16_t* p2;
            if (MODE == 0) { p1 = KV + (mb + k) * 2048 + head * 128; p2 = KPE + (mb + k) * 64; }
            else if (MODE == 1) { p1 = Z + (mb + k) * DINP + ZO_KS + g * 192; p2 = p1 + 128; }
            else if (MODE == 2) { p1 = Z + (mb + k) * DINP + ZO_KW + g * 192; p2 = p1 + 128; }
            else { p1 = KC + (size_t)((b * 2 + g) * 128 + k) * 192; p2 = p1 + 128; }
            float d = 0.f;
#pragma unroll
            for (int c = 0; c < 16; ++c) d += dot8(*((const u32x4*)p1 + c), qs + 8 * c);
#pragma unroll
            for (int c = 0; c < 8; ++c) d += dot8(*((const u32x4*)p2 + c), qs + 128 + 8 * c);
            if (MODE != 0) { const int kp = (MODE == 3) ? pos[16 * k + 31] : pos[k]; int dd = qpos - kp; dd = dd < 0 ? 0 : (dd > 128 ? 128 : dd); d += tbl[dd]; }
            s = d;
        }
        if (k <= k1) sc[k - k0] = s;
        mx = fmaxf(mx, s);
    }
    mx = wave_max(mx);
    float sum = 0.f;
    for (int kb = k0; kb <= k1; kb += 64) { const int k = kb + F.lane; if (k <= k1) { const float p = __expf(sc[k - k0] - mx); sc[k - k0] = p; sum += p; } }
    sum = wave_sum(sum);
    const float inv = 1.0f / sum;
    float a0 = 0.f, a1 = 0.f;
    for (int k = k0; k <= k1; ++k) {
        if (MODE == 1) { if (!((selmask >> (k >> 6)) & 1u)) { k |= 63; continue; } }
        const float p = sc[k - k0];
        const bf16_t* vp;
        if (MODE == 0) vp = KV + (mb + k) * 2048 + 1024 + head * 128;
        else if (MODE == 1) vp = Z + (mb + k) * DINP + ZO_VS + g * 128;
        else if (MODE == 2) vp = Z + (mb + k) * DINP + ZO_VW + g * 128;
        else vp = VC + (size_t)((b * 2 + g) * 128 + k) * 128;
        const unsigned w = *((const unsigned*)vp + F.lane);
        a0 += p * bflo(w); a1 += p * bfhi(w);
    }
    o0 += gate * inv * a0; o1 += gate * inv * a1;
    if (MODE == 3) { for (int kb = 0; kb <= k1; kb += 64) { const int k = kb + F.lane; if (k <= k1) sc[k] *= inv; } }
}
__device__ __forceinline__ void naive_cmp_phase(Frame& F) {
    const int gw = F.cu * 8 + F.wave, NGW = F.G * 8;
    LAS float* sc = (LAS float*)(F.lds + F.wave * 8192); LAS float* qs = (LAS float*)(F.lds + 65536 + F.wave * 1024); LAS float* ps = (LAS float*)(F.lds + 65536 + 8192 + F.wave * 512);
    const bf16_t* Z = (const bf16_t*)(F.ws + WS_Z); float* OC = (float*)(F.ws + WS_OC); unsigned* SEL = (unsigned*)(F.ws + WS_SEL);
    for (int r = gw; r < M * 2; r += NGW) {
        const int g = r & 1, m = r >> 1, b = m / SEQ, t = m % SEQ;
        ps[F.lane] = 0.f; ps[F.lane + 64] = 0.f;
        for (int j = 0; j < 4; ++j) {
            const int head = g * 4 + j; int nk = 0;
            load_q<false>(F, Z + (size_t)m * DINP + ZO_NQ + head * 192, 0.07216878364870322f, qs, nullptr);
            float o0 = 0.f, o1 = 0.f;
            const float g0 = sigmoidf_(bf1(Z[(size_t)m * DINP + ZO_NG + head * 3 + 0]));
            naive_row<3>(F, b, t, head, g0, o0, o1, sc, qs, 0u, nk);
            *(f32x2*)(OC + (size_t)m * 1024 + head * 128 + 2 * F.lane) = (f32x2){o0, o1};
            if (F.lane < nk) ps[F.lane] += sc[F.lane];
            if (F.lane + 64 < nk) ps[F.lane + 64] += sc[F.lane + 64];
        }
        const int mm = F.lane & 31; float imp = 0.f;
#pragma unroll
        for (int n = -1; n < 4; ++n) { const int nn = 4 * mm + n; if (nn >= 0 && nn < 128) imp += ps[nn]; }
        const int cur = t >> 6; const bool valid = mm <= cur, forced = valid && (mm == 0 || mm >= cur - 1);
        const float scv = forced ? 1e6f : (valid ? imp : -1.0f);
        int rank = 0;
#pragma unroll
        for (int o = 0; o < 32; ++o) { const float v = __shfl(scv, o); rank += (v > scv || (v == scv && o < mm)) ? 1 : 0; }
        const bool sel = (rank < 16) && (scv >= 0.f) && (F.lane < 32);
        const unsigned long long bal = __ballot(sel);
        if (F.lane == 0) SEL[(size_t)(b * 2 + g) * SEQ + t] = (unsigned)bal;
    }
}
__device__ __forceinline__ void naive_attn_phase(Frame& F) {
    const int gw = F.cu * 8 + F.wave, NGW = F.G * 8;
    LAS float* sc = (LAS float*)(F.lds + F.wave * 8192); LAS float* qs = (LAS float*)(F.lds + 65536 + F.wave * 1024);
    const bf16_t* Z = (const bf16_t*)(F.ws + WS_Z); const bf16_t* QM = (const bf16_t*)(F.ws + WS_QM); bf16_t* AB = (bf16_t*)(F.ws + WS_AB);
    const float* OC = (const float*)(F.ws + WS_OC); const unsigned* SEL = (const unsigned*)(F.ws + WS_SEL); const f32x2* rope = (const f32x2*)(F.ws + WS_ROPE);
    for (int r = gw; r < M * 8; r += NGW) {
        const int head = r & 7, m = r >> 3, b = m / SEQ, t = m % SEQ; int nk;
        load_q<true>(F, QM + (size_t)m * 1536 + head * 192, 0.07216878364870322f, qs, rope + (size_t)m * 32);
        float o0 = 0.f, o1 = 0.f;
        naive_row<0>(F, b, t, head, 1.0f, o0, o1, sc, qs, 0u, nk);
        *((unsigned*)(AB + (size_t)m * 2048 + head * 128) + F.lane) = cvtpk(o0, o1);
    }
    for (int r = gw; r < M * 8; r += NGW) {
        const int head = r & 7, m = r >> 3, b = m / SEQ, t = m % SEQ, g = head >> 2; int nk;
        const unsigned selmask = (unsigned)__builtin_amdgcn_readfirstlane((int)SEL[(size_t)(b * 2 + g) * SEQ + t]);
        load_q<false>(F, Z + (size_t)m * DINP + ZO_NQ + head * 192, 0.07216878364870322f, qs, nullptr);
        const float g1 = sigmoidf_(bf1(Z[(size_t)m * DINP + ZO_NG + head * 3 + 1])), g2 = sigmoidf_(bf1(Z[(size_t)m * DINP + ZO_NG + head * 3 + 2]));
        const f32x2 oc = *(const f32x2*)(OC + (size_t)m * 1024 + head * 128 + 2 * F.lane);
        float o0 = oc.x, o1 = oc.y;
        naive_row<1>(F, b, t, head, g1, o0, o1, sc, qs, selmask, nk);
        naive_row<2>(F, b, t, head, g2, o0, o1, sc, qs, 0u, nk);
        *((unsigned*)(AB + (size_t)m * 2048 + 1024 + head * 128) + F.lane) = cvtpk(o0, o1);
    }
}

namespace att {
typedef float f32x16 __attribute__((ext_vector_type(16)));
typedef short s16x4 __attribute__((ext_vector_type(4)));
typedef int i32x4 __attribute__((ext_vector_type(4)));
constexpr int KROW = 400, KBUF = 64 * KROW, VBUF = 64 * 256;
constexpr int L_K = 0, L_V = 2 * KBUF, L_KPOS = L_V + 2 * VBUF, L_KPMAX = L_KPOS + 512, L_TBL = L_KPMAX + 64, L_MISC = L_TBL + 8 * 132 * 4;
static_assert(L_MISC + 256 <= RING_BYTES, "attention LDS map");
constexpr float SL = 0.07216878364870322f * 1.4426950408889634f;
__device__ const unsigned char CLS_TYPE[40] = {1,1,1,1,1,1,1,1,1,0,1,1,1,1,0,1,1,1,1,0,1,1,1,1,0,1,1,1,0,1,1,0,1,1,0,1,1,0,1,1};
__device__ const unsigned char CLS_QB[40] = {31,30,29,28,27,26,25,24,23,7,22,21,20,19,6,18,17,16,15,5,14,13,12,11,4,10,9,8,3,7,6,2,5,4,1,3,2,0,1,0};
__device__ const unsigned short CLS_START[41] = {0,8,16,24,32,40,48,56,64,72,104,112,120,128,136,168,176,184,192,200,232,240,248,256,264,296,304,312,320,352,360,368,400,408,416,448,456,464,496,504,512};
__device__ __forceinline__ unsigned offb(unsigned row, unsigned ch) { return 256u * row + 16u * (ch ^ (((row & 3u) << 2) | ((row >> 2) & 3u))); }
struct Src { const bf16_t* k1; const bf16_t* k2; const bf16_t* v; int ldk1, ldk2, ldv; };
struct Stage { u32x4 k[3]; u32x4 v[2]; int kp; };
template <bool SAMELD = true>
__device__ __forceinline__ void stage_load(Stage& st, const Src& s, int tile, int tid, const int* posb) {
    const unsigned vo1 = (unsigned)((tid >> 4) * s.ldk1 + (tid & 15) * 8) * 2u, vo2 = (unsigned)((tid >> 3) * s.ldk2 + (tid & 7) * 8) * 2u;
    const char* b1 = (const char*)s.k1 + (size_t)tile * 64 * s.ldk1 * 2; const char* b2 = (const char*)s.k2 + (size_t)tile * 64 * s.ldk2 * 2; const char* bv = (const char*)s.v + (size_t)tile * 64 * s.ldv * 2;
    st.k[0] = *(const u32x4*)(b1 + vo1); st.k[1] = *(const u32x4*)(b1 + (size_t)32 * s.ldk1 * 2 + vo1); st.k[2] = *(const u32x4*)(b2 + vo2);
    const unsigned vov = SAMELD ? vo1 : (unsigned)((tid >> 4) * s.ldv + (tid & 15) * 8) * 2u;
    st.v[0] = *(const u32x4*)(bv + vov); st.v[1] = *(const u32x4*)(bv + (size_t)32 * s.ldv * 2 + vov);
    if (posb != nullptr && tid < 64) st.kp = posb[tile * 64 + tid];
}
__device__ __forceinline__ void stage_store(const Stage& st, LAS unsigned char* lds, int buf, int tid, bool haspos) {
    const int rowA = tid >> 4, chA = tid & 15;
    LAS unsigned char* ka = lds + L_K + buf * KBUF + rowA * KROW + chA * 16;
    *(LAS u32x4*)ka = st.k[0]; *(LAS u32x4*)(ka + 32 * KROW) = st.k[1];
    *(LAS u32x4*)(lds + L_K + buf * KBUF + (tid >> 3) * KROW + (16 + (tid & 7)) * 16) = st.k[2];
    LAS unsigned char* va = lds + L_V + buf * VBUF + offb(rowA, chA);
    *(LAS u32x4*)va = st.v[0]; *(LAS u32x4*)(va + 8192) = st.v[1];
    if (haspos && tid < 64) { ((LAS int*)(lds + L_KPOS))[buf * 64 + tid] = st.kp; int mx = st.kp;
#pragma unroll
        for (int o = 1; o < 64; o <<= 1) { const int t = __shfl_xor(mx, o); mx = t > mx ? t : mx; }
        if (tid == 0) ((LAS int*)(lds + L_KPMAX))[buf] = mx; }
}
__device__ __forceinline__ s16x4 vtr(const LAS unsigned char* p) { typedef short v4i16_t __attribute__((ext_vector_type(4))); return __builtin_bit_cast(s16x4, __builtin_amdgcn_ds_read_tr16_b64_v4i16((LAS v4i16_t*)p)); }

__device__ __forceinline__ unsigned vtr_off(int lane_, int c, int tp) {
    const unsigned q4 = (lane_ & 15) >> 2, p = lane_ & 3, blk = (lane_ >> 4) & 1, h2 = lane_ >> 5;
    return 256u * (8u * tp + 4u * h2 + q4) + 16u * ((((unsigned)c ^ q4) << 2) | ((2u * blk + (p >> 1)) ^ (2u * tp + h2))) + 8u * (p & 1u);
}
#define ATT_ZERO16 {0.f,0.f,0.f,0.f,0.f,0.f,0.f,0.f,0.f,0.f,0.f,0.f,0.f,0.f,0.f,0.f}
template <int MODE>
__device__ __forceinline__ void run_pass(Frame& F, const Src& src, unsigned tmask, const bf16x8 (&qf)[12], f32x16 (&oacc)[4], float& m_run, float& l_run,
                                         int tq, int tq_wmin, int tq_wmax, unsigned selq, int qpos, int qpos_wmin, int head, const int* posb) {
    if (tmask == 0u) return;
    const int tid = F.tid, lane = F.lane, r = lane & 31, hh = lane >> 5;
    LAS unsigned char* lds = F.lds;
    int tile = __builtin_ctz(tmask); unsigned rem = tmask & (tmask - 1u);
    Stage st; st.kp = 0;
    stage_load(st, src, tile, tid, posb); stage_store(st, lds, 0, tid, posb != nullptr); __syncthreads();
    int buf = 0;
    const LAS float* tblh = (const LAS float*)(lds + L_TBL) + head * 132;
    for (;;) {
        const int nxt = rem ? __builtin_ctz(rem) : -1;
        if (nxt >= 0) stage_load(st, src, nxt, tid, posb);
        const bool active = (MODE != 0) || (tile * 64 <= tq_wmax);
        if (active) {
            const LAS unsigned char* kb_ = lds + L_K + buf * KBUF + r * KROW + 16 * hh;
            const LAS unsigned char* vbuf = lds + L_V + buf * VBUF;
            bool far = true; if (MODE != 0) { const int kpmax = __builtin_amdgcn_readfirstlane(((const LAS int*)(lds + L_KPMAX))[buf]); far = (qpos_wmin - kpmax >= 128); }
            int lim = tq - tile * 64 - 4 * hh;
            if (MODE == 1) { if (!((selq >> tile) & 1u)) lim = -1; }
            const bool need = (MODE == 1) || (MODE == 2) || (tile * 64 + 63 > tq_wmin);
#pragma unroll
            for (int kb = 0; kb < 2; ++kb) {
                f32x16 sa = ATT_ZERO16;
#pragma unroll
                for (int s = 0; s < 12; ++s) { const bf16x8 a0 = *(const LAS bf16x8*)(kb_ + kb * 32 * KROW + 32 * s); sa = __builtin_amdgcn_mfma_f32_32x32x16_bf16(a0, qf[s], sa, 0, 0, 0); }
                float x[16];
                if (MODE == 0) {
#pragma unroll
                    for (int i = 0; i < 16; ++i) x[i] = sa[i] * SL;
                } else if (far) { const float cb = tblh[128];
#pragma unroll
                    for (int i = 0; i < 16; ++i) x[i] = sa[i] * SL + cb;
                } else {
                    const LAS int* kp = (const LAS int*)(lds + L_KPOS) + buf * 64 + 4 * hh + 32 * kb;
#pragma unroll
                    for (int g4 = 0; g4 < 4; ++g4) { const i32x4 kv = *(const LAS i32x4*)(kp + 8 * g4);
#pragma unroll
                        for (int e = 0; e < 4; ++e) { int d = qpos - kv[e]; d = d < 0 ? 0 : (d > 128 ? 128 : d); x[4 * g4 + e] = sa[4 * g4 + e] * SL + tblh[d]; } }
                }
                if (need) {
#pragma unroll
                    for (int i = 0; i < 16; ++i) { const int ci = 32 * kb + 8 * (i >> 2) + (i & 3); if (ci > lim) x[i] = -INFINITY; if (MODE == 2) { if (ci <= lim - 512) x[i] = -INFINITY; } }
                }
                float ml = x[0];
#pragma unroll
                for (int i = 1; i < 16; ++i) ml = fmaxf(ml, x[i]);
                ml = fmaxf(ml, __shfl_xor(ml, 32));
                const float mnew = fmaxf(m_run, ml), alpha = __builtin_amdgcn_exp2f(m_run - mnew);
                m_run = mnew;
                float ps = 0.f;
#pragma unroll
                for (int i = 0; i < 16; ++i) { x[i] = __builtin_amdgcn_exp2f(x[i] - mnew); ps += x[i]; }
                l_run = l_run * alpha + ps;
                if (!__all(alpha == 1.0f)) {
#pragma unroll
                    for (int c = 0; c < 4; ++c) oacc[c] = oacc[c] * alpha;
                }
                bf16x8 pf[2];
#pragma unroll
                for (int k2 = 0; k2 < 2; ++k2) { u32x4 w; w.x = cvtpk(x[8 * k2 + 0], x[8 * k2 + 1]); w.y = cvtpk(x[8 * k2 + 2], x[8 * k2 + 3]); w.z = cvtpk(x[8 * k2 + 4], x[8 * k2 + 5]); w.w = cvtpk(x[8 * k2 + 6], x[8 * k2 + 7]); pf[k2] = __builtin_bit_cast(bf16x8, w); }
#pragma unroll
                for (int c = 0; c < 4; ++c) { int lane_ = lane; asm volatile("" : "+v"(lane_)); const unsigned v0 = vtr_off(lane_, c, 0), v1 = vtr_off(lane_, c, 1);
#pragma unroll
                    for (int k2 = 0; k2 < 2; ++k2) { const int ks = 2 * kb + k2; const s16x4 lo = vtr(vbuf + v0 + ks * 4096), hi = vtr(vbuf + v1 + ks * 4096);
                        const bf16x8 a = {lo[0], lo[1], lo[2], lo[3], hi[0], hi[1], hi[2], hi[3]};
                        oacc[c] = __builtin_amdgcn_mfma_f32_32x32x16_bf16(a, pf[k2], oacc[c], 0, 0, 0); } }
            }
        }
        if (nxt >= 0) stage_store(st, lds, buf ^ 1, tid, posb != nullptr);
        __syncthreads();
        if (nxt < 0) break;
        tile = nxt; rem &= rem - 1u; buf ^= 1;
    }
}
template <bool ROPE>
__device__ __forceinline__ void load_qfrags(bf16x8 (&qf)[12], const bf16_t* qrow, int hh, const f32x2* rope_row) {
#pragma unroll
    for (int s = 0; s < 12; ++s) qf[s] = *(const bf16x8*)(qrow + 16 * s + 8 * hh);
    if (ROPE) {
#pragma unroll
        for (int pr = 0; pr < 2; ++pr) {
            const int i0 = 16 * pr + 8 * hh; bf16x8 a = qf[8 + pr], b = qf[10 + pr];
#pragma unroll
            for (int j = 0; j < 8; ++j) { const f32x2 cs = rope_row[i0 + j]; const float x1 = bf1((bf16_t)a[j]), x2 = bf1((bf16_t)b[j]);
                const unsigned w = cvtpk(x1 * cs.x - x2 * cs.y, x1 * cs.y + x2 * cs.x); a[j] = (short)(w & 0xffffu); b[j] = (short)(w >> 16); }
            qf[8 + pr] = a; qf[10 + pr] = b;
        }
    }
}
__device__ __forceinline__ void mla_unit(Frame& F, int b, int h, int qb) {
    const int lane = F.lane, r = lane & 31, hh = lane >> 5, w = F.wave;
    const int t0 = 256 * qb, tq = t0 + 32 * w + r; const size_t m = (size_t)b * SEQ + tq;
    const bf16_t* KV = (const bf16_t*)(F.ws + WS_KV);
    Src src{KV + (size_t)b * SEQ * 2048 + h * 128, (const bf16_t*)(F.ws + WS_KPE) + (size_t)b * SEQ * 64, KV + (size_t)b * SEQ * 2048 + 1024 + h * 128, 2048, 64, 2048};
    bf16x8 qf[12]; load_qfrags<true>(qf, (const bf16_t*)(F.ws + WS_QM) + m * 1536 + h * 192, hh, (const f32x2*)(F.ws + WS_ROPE) + m * 32);
    f32x16 oacc[4] = {ATT_ZERO16, ATT_ZERO16, ATT_ZERO16, ATT_ZERO16}; float m_run = -1e30f, l_run = 0.f;
    const unsigned tmask = (qb == 7) ? 0xffffffffu : ((1u << (4 * qb + 4)) - 1u);
    run_pass<0>(F, src, tmask, qf, oacc, m_run, l_run, tq, t0 + 32 * w, t0 + 32 * w + 31, 0u, 0, 0, h, nullptr);
    const float inv = 1.0f / (l_run + __shfl_xor(l_run, 32));
    bf16_t* o = (bf16_t*)(F.ws + WS_AB) + m * 2048 + h * 128 + 4 * hh;
#pragma unroll
    for (int c = 0; c < 4; ++c)
#pragma unroll
        for (int g4 = 0; g4 < 4; ++g4) *(u32x2*)(o + 32 * c + 8 * g4) = (u32x2){cvtpk(oacc[c][4 * g4] * inv, oacc[c][4 * g4 + 1] * inv), cvtpk(oacc[c][4 * g4 + 2] * inv, oacc[c][4 * g4 + 3] * inv)};
}
__device__ __forceinline__ void nsa_unit(Frame& F, int b, int g, int qb) {
    const int lane = F.lane, r = lane & 31, hh = lane >> 5, w = F.wave, head = 4 * g + (w >> 1);
    const int t0 = 64 * qb, tq = t0 + 32 * (w & 1) + r; const size_t m = (size_t)b * SEQ + tq;
    const bf16_t* Zb = (const bf16_t*)(F.ws + WS_Z) + (size_t)b * SEQ * DINP; const bf16_t* zr = (const bf16_t*)(F.ws + WS_Z) + m * DINP;
    const unsigned* SELb = (const unsigned*)(F.ws + WS_SEL) + (size_t)(b * 2 + g) * SEQ; const int* posb = (const int*)F.in[I_POS] + (size_t)b * SEQ;
    LAS unsigned* misc = (LAS unsigned*)(F.lds + L_MISC);
    if (w == 0) { unsigned v = SELb[t0 + lane];
#pragma unroll
        for (int o = 1; o < 64; o <<= 1) v |= (unsigned)__shfl_xor((int)v, o);
        if (lane == 0) misc[4] = v; }
    const unsigned selq = SELb[tq]; const int qpos = posb[tq]; int qmin = qpos;
#pragma unroll
    for (int o = 1; o < 64; o <<= 1) { const int t = __shfl_xor(qmin, o); qmin = t < qmin ? t : qmin; }
    qmin = __builtin_amdgcn_readfirstlane(qmin);
    bf16x8 qf[12]; load_qfrags<false>(qf, zr + ZO_NQ + head * 192, hh, nullptr);
    __syncthreads();
    const unsigned causal = (qb == 31) ? 0xffffffffu : ((2u << qb) - 1u);
    const unsigned umask = (unsigned)__builtin_amdgcn_readfirstlane((int)misc[4]) & causal;
    const int wlo = qb > 8 ? qb - 8 : 0; const unsigned wmask = causal & ~((1u << wlo) - 1u);
    f32x16 oacc[4] = {ATT_ZERO16, ATT_ZERO16, ATT_ZERO16, ATT_ZERO16}; float m_run = -1e30f, l_run = 0.f;
    {
        Src src{Zb + ZO_KS + g * 192, Zb + ZO_KS + g * 192 + 128, Zb + ZO_VS + g * 128, DINP, DINP, DINP};
        run_pass<1>(F, src, umask, qf, oacc, m_run, l_run, tq, t0 + 32 * (w & 1), t0 + 32 * (w & 1) + 31, selq, qpos, qmin, head, posb);
        asm volatile("" ::: "memory");
        const size_t m1 = (size_t)b * SEQ + t0 + 32 * (w & 1) + (F.lane & 31);
        const float g1 = sigmoidf_(bf1(((const bf16_t*)(F.ws + WS_Z))[m1 * DINP + ZO_NG + head * 3 + 1]));
        bf16_t* o = (bf16_t*)(F.ws + WS_AB) + m1 * 2048 + 1024 + head * 128 + 4 * (F.lane >> 5); const float* oc = (const float*)(F.ws + WS_OC) + m1 * 1024 + head * 128 + 4 * (F.lane >> 5);
        const float inv = g1 / (l_run + __shfl_xor(l_run, 32));
#pragma unroll
        for (int c = 0; c < 4; ++c)
#pragma unroll
            for (int g4 = 0; g4 < 4; ++g4) { const f32x4 cv = *(const f32x4*)(oc + 32 * c + 8 * g4);
                *(u32x2*)(o + 32 * c + 8 * g4) = (u32x2){cvtpk(oacc[c][4 * g4] * inv + cv.x, oacc[c][4 * g4 + 1] * inv + cv.y), cvtpk(oacc[c][4 * g4 + 2] * inv + cv.z, oacc[c][4 * g4 + 3] * inv + cv.w)}; }
    }
#pragma unroll
    for (int c = 0; c < 4; ++c) oacc[c] = (f32x16)ATT_ZERO16;
    m_run = -1e30f; l_run = 0.f;
    {
        Src src{Zb + ZO_KW + g * 192, Zb + ZO_KW + g * 192 + 128, Zb + ZO_VW + g * 128, DINP, DINP, DINP};
        run_pass<2>(F, src, wmask, qf, oacc, m_run, l_run, tq, t0 + 32 * (w & 1), t0 + 32 * (w & 1) + 31, 0u, qpos, qmin, head, posb);
        asm volatile("" ::: "memory");
        const size_t m1 = (size_t)b * SEQ + t0 + 32 * (w & 1) + (F.lane & 31);
        const float g2 = sigmoidf_(bf1(((const bf16_t*)(F.ws + WS_Z))[m1 * DINP + ZO_NG + head * 3 + 2]));
        bf16_t* o = (bf16_t*)(F.ws + WS_AB) + m1 * 2048 + 1024 + head * 128 + 4 * (F.lane >> 5);
        const float inv = g2 / (l_run + __shfl_xor(l_run, 32));
#pragma unroll
        for (int c = 0; c < 4; ++c)
#pragma unroll
            for (int g4 = 0; g4 < 4; ++g4) { const u32x2 pv = *(const u32x2*)(o + 32 * c + 8 * g4);
                *(u32x2*)(o + 32 * c + 8 * g4) = (u32x2){cvtpk(oacc[c][4 * g4] * inv + bflo(pv.x), oacc[c][4 * g4 + 1] * inv + bfhi(pv.x)), cvtpk(oacc[c][4 * g4 + 2] * inv + bflo(pv.y), oacc[c][4 * g4 + 3] * inv + bfhi(pv.y))}; }
    }
}
__device__ __forceinline__ void cmp_unit(Frame& F, int b, int g, int qb) {
    const int tid = F.tid, lane = F.lane, r = lane & 31, hh = lane >> 5, w = F.wave;
    const int t0 = 256 * qb, tq = t0 + 32 * w + r; const size_t m = (size_t)b * SEQ + tq;
    LAS unsigned char* lds = F.lds;
    const int* posb = (const int*)F.in[I_POS] + (size_t)b * SEQ;
    {
        Src src{(const bf16_t*)(F.ws + WS_KC) + (size_t)(b * 2 + g) * 128 * 192, (const bf16_t*)(F.ws + WS_KC) + (size_t)(b * 2 + g) * 128 * 192 + 128, (const bf16_t*)(F.ws + WS_KC + 524288) + (size_t)(b * 2 + g) * 128 * 128, 192, 192, 128};
        Stage st; st.kp = 0;
        stage_load<false>(st, src, 0, tid, nullptr); stage_store(st, lds, 0, tid, false);
        stage_load<false>(st, src, 1, tid, nullptr); stage_store(st, lds, 1, tid, false);
        if (tid < 128) { int kt = 16 * tid + 31; kt = kt > SEQ - 1 ? SEQ - 1 : kt; ((LAS int*)(lds + L_KPOS))[tid] = posb[kt]; }
    }
    __syncthreads();
    const int qpos = posb[tq];
    const int nmax = tq >= 31 ? (tq - 31) >> 4 : -1;
    float imp[16];
#pragma unroll
    for (int i = 0; i < 16; ++i) imp[i] = 0.f;
    const LAS unsigned char* kb_ = lds + L_K + r * KROW + 16 * hh;
    const LAS unsigned char* vbuf = lds + L_V;
    const bf16_t* zr = (const bf16_t*)(F.ws + WS_Z) + m * DINP;
#pragma unroll 1
    for (int j = 0; j < 4; ++j) {
        const int head = 4 * g + j;
        const LAS float* tblh = (const LAS float*)(lds + L_TBL) + head * 132;
        bf16x8 qf[12]; load_qfrags<false>(qf, zr + ZO_NQ + head * 192, hh, nullptr);
        float m_run = -1e30f, l_run = 0.f;
#define CMP_SCORES(kb) \
                f32x16 sa = ATT_ZERO16; \
                _Pragma("unroll") for (int s = 0; s < 12; ++s) { const bf16x8 a0 = *(const LAS bf16x8*)(kb_ + (kb) * 32 * KROW + 32 * s); sa = __builtin_amdgcn_mfma_f32_32x32x16_bf16(a0, qf[s], sa, 0, 0, 0); } \
                float x[16]; \
                { const LAS int* kp = (const LAS int*)(lds + L_KPOS) + 4 * hh + 32 * (kb); int nm_ = nmax; asm volatile("" : "+v"(nm_)); const int lim = nm_ - 32 * (kb) - 4 * hh; \
                _Pragma("unroll") for (int g4 = 0; g4 < 4; ++g4) { const i32x4 kv = *(const LAS i32x4*)(kp + 8 * g4); \
                    _Pragma("unroll") for (int e = 0; e < 4; ++e) { int d = qpos - kv[e]; d = d < 0 ? 0 : (d > 128 ? 128 : d); const float v = sa[4 * g4 + e] * SL + tblh[d]; x[4 * g4 + e] = (8 * g4 + e > lim) ? -INFINITY : v; } } }
#pragma unroll
        for (int kb = 0; kb < 4; ++kb) {
            CMP_SCORES(kb)
            float ml = x[0];
#pragma unroll
            for (int i = 1; i < 16; ++i) ml = fmaxf(ml, x[i]);
            ml = fmaxf(ml, __shfl_xor(ml, 32));
            const float mnew = fmaxf(m_run, ml), alpha = __builtin_amdgcn_exp2f(m_run - mnew); m_run = mnew;
            float ps = 0.f;
#pragma unroll
            for (int i = 0; i < 16; ++i) ps += __builtin_amdgcn_exp2f(x[i] - mnew);
            l_run = l_run * alpha + ps;
            asm volatile("" ::: "memory");
        }
        const float lt = l_run + __shfl_xor(l_run, 32), inv = lt > 0.f ? 1.0f / lt : 0.f;
        f32x16 oacc[4] = {ATT_ZERO16, ATT_ZERO16, ATT_ZERO16, ATT_ZERO16};
        float carry = 0.f;
#pragma unroll
        for (int kb = 0; kb < 4; ++kb) {
            CMP_SCORES(kb)
#pragma unroll
            for (int i = 0; i < 16; ++i) x[i] = __builtin_amdgcn_exp2f(x[i] - m_run) * inv;
#pragma unroll
            for (int g4 = 0; g4 < 4; ++g4) { const float e3 = x[4 * g4 + 3], sw = __shfl_xor(e3, 32);
                imp[4 * kb + g4] += ((x[4 * g4] + x[4 * g4 + 1]) + (x[4 * g4 + 2] + e3)) + (hh ? sw : carry); carry = sw; }
            bf16x8 pf[2];
#pragma unroll
            for (int k2 = 0; k2 < 2; ++k2) { u32x4 wv; wv.x = cvtpk(x[8 * k2 + 0], x[8 * k2 + 1]); wv.y = cvtpk(x[8 * k2 + 2], x[8 * k2 + 3]); wv.z = cvtpk(x[8 * k2 + 4], x[8 * k2 + 5]); wv.w = cvtpk(x[8 * k2 + 6], x[8 * k2 + 7]); pf[k2] = __builtin_bit_cast(bf16x8, wv); }
#pragma unroll
            for (int c = 0; c < 4; ++c) { int lane_ = lane; asm volatile("" : "+v"(lane_)); const unsigned v0 = vtr_off(lane_, c, 0), v1 = vtr_off(lane_, c, 1);
#pragma unroll
                for (int k2 = 0; k2 < 2; ++k2) { const int ks = 2 * kb + k2; const s16x4 lo = vtr(vbuf + v0 + ks * 4096), hi = vtr(vbuf + v1 + ks * 4096);
                    const bf16x8 a = {lo[0], lo[1], lo[2], lo[3], hi[0], hi[1], hi[2], hi[3]};
                    oacc[c] = __builtin_amdgcn_mfma_f32_32x32x16_bf16(a, pf[k2], oacc[c], 0, 0, 0); } }
            asm volatile("" ::: "memory");
        }
#undef CMP_SCORES
        {
            const float g0 = sigmoidf_(bf1(zr[ZO_NG + head * 3 + 0]));
            float* oc = (float*)(F.ws + WS_OC) + m * 1024 + head * 128 + 4 * hh;
#pragma unroll
            for (int c = 0; c < 4; ++c)
#pragma unroll
                for (int g4 = 0; g4 < 4; ++g4) *(f32x4*)(oc + 32 * c + 8 * g4) = (f32x4){oacc[c][4 * g4] * g0, oacc[c][4 * g4 + 1] * g0, oacc[c][4 * g4 + 2] * g0, oacc[c][4 * g4 + 3] * g0};
        }
    }
    {
        LAS float* impl = (LAS float*)(lds + 90112);
#pragma unroll
        for (int i = 0; i < 4; ++i) *(LAS f32x4*)(impl + (w * 64 + lane) * 16 + 4 * i) = (f32x4){imp[4 * i], imp[4 * i + 1], imp[4 * i + 2], imp[4 * i + 3]};
        asm volatile("s_waitcnt lgkmcnt(0)" ::: "memory");
        int lane2 = F.tid & 63; asm volatile("" : "+v"(lane2));
        const int hh2 = lane2 >> 5;
        const int cur = (t0 + 32 * w + (lane2 & 31)) >> 6; float own[16], oth[16];
#pragma unroll
        for (int i = 0; i < 4; ++i) { const f32x4 a = *(const LAS f32x4*)(impl + (w * 64 + lane2) * 16 + 4 * i), c = *(const LAS f32x4*)(impl + (w * 64 + (lane2 ^ 32)) * 16 + 4 * i);
            own[4 * i] = a.x; own[4 * i + 1] = a.y; own[4 * i + 2] = a.z; own[4 * i + 3] = a.w; oth[4 * i] = c.x; oth[4 * i + 1] = c.y; oth[4 * i + 2] = c.z; oth[4 * i + 3] = c.w; }
#pragma unroll
        for (int i = 0; i < 16; ++i) { const int mo = 2 * i + hh2, mp = 2 * i + 1 - hh2; const bool vo = mo <= cur, fo = vo && (mo == 0 || mo >= cur - 1), vp = mp <= cur, fp = vp && (mp == 0 || mp >= cur - 1);
            own[i] = fo ? 1e6f : (vo ? own[i] : -1.0f); oth[i] = fp ? 1e6f : (vp ? oth[i] : -1.0f); }
        unsigned bits = 0u;
#pragma unroll
        for (int i = 0; i < 16; ++i) { const float v = own[i]; int rank = 0;
#pragma unroll
            for (int k = 0; k < 16; ++k) {
                if (k < i) rank += (own[k] >= v) ? 1 : 0; else if (k > i) rank += (own[k] > v) ? 1 : 0;
                if (k < i) rank += (oth[k] >= v) ? 1 : 0; else if (k > i) rank += (oth[k] > v) ? 1 : 0; else rank += hh2 ? ((oth[k] >= v) ? 1 : 0) : ((oth[k] > v) ? 1 : 0);
                asm volatile("" : "+v"(rank)); }
            if (rank < 16 && v >= 0.f) bits |= 1u << (2 * i + hh2); }
        bits |= (unsigned)__shfl_xor((int)bits, 32);
        if (hh2 == 0) ((unsigned*)(F.ws + WS_SEL))[(size_t)(b * 2 + g) * SEQ + t0 + 32 * w + (lane2 & 31)] = bits;
    }
    __syncthreads();
}
__device__ __forceinline__ void cmp_phase(Frame& F) {
    LAS float* tblL = (LAS float*)(F.lds + L_TBL); const float* tg = (const float*)(F.ws + WS_TBL + 16384);
    for (int i = F.tid; i < 8 * 132; i += 512) tblL[i] = tg[i];
    __syncthreads();
    for (int u = F.cu; u < 64; u += F.G) cmp_unit(F, u >> 4, (u >> 3) & 1, u & 7);
}
constexpr int CW_QUEUE = 8192;
__device__ __forceinline__ void attn_phase(Frame& F, int l, int qoff = 0) {
    LAS float* tblL = (LAS float*)(F.lds + L_TBL); const float* tg = (const float*)(F.ws + WS_TBL + 16384);
    for (int i = F.tid; i < 8 * 132; i += 512) tblL[i] = tg[i];
    LAS unsigned* misc = (LAS unsigned*)(F.lds + L_MISC);
    unsigned* qctr = (unsigned*)(F.ws + WS_CTL) + CW_QUEUE + 64 * l + qoff;
    __syncthreads();
    for (;;) {
        launder(F);
        if (F.tid == 0) misc[0] = __hip_atomic_fetch_add(qctr, 1u, __ATOMIC_RELAXED, __HIP_MEMORY_SCOPE_AGENT);
        __syncthreads();
        const int u = __builtin_amdgcn_readfirstlane((int)misc[0]);
        __syncthreads();
        if (u >= 256) break;
        mla_unit(F, (u & 31) >> 3, u & 7, 7 - (u >> 5));
    }
    for (;;) {
        launder(F);
        if (F.tid == 0) misc[0] = __hip_atomic_fetch_add(qctr + 16, 1u, __ATOMIC_RELAXED, __HIP_MEMORY_SCOPE_AGENT);
        __syncthreads();
        const int u = __builtin_amdgcn_readfirstlane((int)misc[0]);
        __syncthreads();
        if (u >= 256) break;
        nsa_unit(F, (u & 7) >> 1, u & 1, 31 - (u >> 3));
    }
}
}

struct SchedCmp {
    const char* Zb; const char* Wb; int c0, c, kv;
    __device__ bool next(int i, Unit& u) const {
        const int j = c - c0; if (i != 0 || j < 0 || j >= 32) return false;
        const int g = j >> 4, rt = (j >> 3) & 1, s = j & 7;
        u.a = Zb + ((size_t)(kv ? ZO_VC + 128 * g : ZO_KC + 192 * g) + (size_t)rt * 256 * 16 * DINP + (size_t)s * 4 * DINP) * 2;
        u.b = Wb + (size_t)s * (kv ? 8 : 12) * 64 * 2; u.pm = 0; u.pn = 0; u.aux = kv * 32 + j; return true;
    }
};
struct SchedQKV {
    const char* C; const char* WQ; const char* WUKV; int G, c;
    __device__ bool next(int i, Unit& u) const {
        int j = i * G + c; if (j >= 448) return false;
        if (j < 192) { u.aux = 0; u.pn = j / 32; u.pm = j % 32; u.a = C + (size_t)u.pm * 256 * 1024 * 2; u.b = WQ + (size_t)u.pn * 256 * 512 * 2; }
        else { j -= 192; u.aux = 1; u.pn = j / 32; u.pm = j % 32; u.a = C + ((size_t)u.pm * 256 * 1024 + 512) * 2; u.b = WUKV + (size_t)u.pn * 256 * 512 * 2; }
        return true;
    }
};
struct SchedMerge {
    const char* A; const char* W; int G, c;
    __device__ bool next(int i, Unit& u) const {
        const int ti = (i >> 1) * G + c, kh = i & 1; if (ti >= 256) return false;
        u.pm = ti % 32; u.pn = ti / 32; u.aux = kh;
        u.a = A + ((size_t)u.pm * 256 * 2048 + kh * 1024) * 2; u.b = W + ((size_t)u.pn * 256 * 2048 + kh * 1024) * 2; return true;
    }
};

constexpr int NPH = 2 + NL * 14;
__global__ void __launch_bounds__(512, 2) fwd(Args args) {
    extern __shared__ __attribute__((aligned(16))) unsigned char lds_raw[];
    Frame F;
    F.lds = (LAS unsigned char*)lds_raw; F.tid = threadIdx.x; F.lane = F.tid & 63; F.wave = __builtin_amdgcn_readfirstlane(F.tid >> 6); F.G = gridDim.x; F.cu = blockIdx.x;
    F.in = args.in; F.out = args.out; F.ws = args.ws;
    volatile LAS unsigned* MISC = (volatile LAS unsigned*)(F.lds + MISC_OFF);
    for (int u = F.tid; u < (LDS_BYTES - RING_BYTES) / 4; u += 512) ((LAS unsigned*)(F.lds + RING_BYTES))[u] = 0u;
    __syncthreads();
    unsigned* ctl = (unsigned*)(F.ws + WS_CTL);
    XcdBarrier bar; bar.bar = ctl + CW_BAR; bar.x = 0; bar.st = MISC + 8;
    if (!MK_PER_PHASE) bar = xcd_barrier_post(ctl + CW_BAR, MISC + 8);
    const int lo = args.ph_lo, hi = args.ph_hi; int pc = 0;
#define PH_IF launder(F); if (pc >= lo && pc < hi)
#define PH_END do { const bool both_ = (pc >= lo) && (pc + 1 < hi); ++pc; if (both_) xcd_barrier(bar); } while (0)
#define U ((bf16_t*)(F.ws + WS_U))
#define H ((bf16_t*)(F.ws + WS_H))
#define Y ((bf16_t*)(F.ws + WS_Y))
#define Z ((bf16_t*)(F.ws + WS_Z))
#define CQKV ((bf16_t*)(F.ws + WS_CQKV))
#define QM ((bf16_t*)(F.ws + WS_QM))
#define KV ((bf16_t*)(F.ws + WS_KV))
#define AB ((bf16_t*)(F.ws + WS_AB))
#define MG ((bf16_t*)(F.ws + WS_MG))
#define WL ((const bf16_t*)(F.ws + WS_W) + (size_t)l * WO_END)

    PH_IF { p0_prologue(F);
#if PROBE_DUP == 10
        __syncthreads(); p0_prologue(F);
#endif
    } PH_END;
    PH_IF { thin_first_norm(F, F.in[I_F1PRE]); } PH_END;
    for (int l = 0; l < NL; ++l) {
        for (int f = 0; f < 2; ++f) {
            PH_IF {
                Gemm g{D, D, D / 64, 0}; SchedStd S; S.init(U, D, WL + (f ? WO_GU2 : WO_GU1), D, M, 2 * FF, F.G, F.cu); EpiSwiGLU E{H, FF};
                pg8::gemm_phase<EpiSwiGLU, SchedStd, 0>(F.lds, g, S, E);
#if PROBE_DUP == 1
                pg8::gemm_phase<EpiSwiGLU, SchedStd, 0>(F.lds, g, S, E);
#endif
            } PH_END;
            PH_IF {
                Gemm g{FF, FF, FF / 64, 0}; SchedStd S; S.init(H, FF, WL + (f ? WO_D2 : WO_D1), FF, M, D, F.G, F.cu); EpiBf16 E{Y, D};
                pg8::gemm_phase<EpiBf16, SchedStd, 0>(F.lds, g, S, E);
            } PH_END;
            PH_IF {
#if PROBE_DUP == 11
                thin_post_norm(F, 0.0f, F.in[I_F1POST] + (size_t)l * D, F.in[I_MPRE] + (size_t)l * D, nullptr); __syncthreads();
#endif
                if (f == 0) thin_post_norm(F, 0.5f, F.in[I_F1POST] + (size_t)l * D, F.in[I_MPRE] + (size_t)l * D, nullptr);
                else thin_post_norm(F, 0.5f, F.in[I_F2POST] + (size_t)l * D, (l + 1 < NL) ? F.in[I_F1PRE] + (size_t)(l + 1) * D : nullptr, (l + 1 < NL) ? nullptr : F.out);
            } PH_END;
            if (f == 0) {
                PH_IF {
                    Gemm g{D, D, D / 64, 0}; SchedStd S; S.init(U, D, WL + WO_IN, D, M, DINP, F.G, F.cu); EpiBf16 E{Z, DINP};
                    pg8::gemm_phase<EpiBf16, SchedStd, 0>(F.lds, g, S, E);
                } PH_END;
                PH_IF {
                    thin_mix(F, F.in[I_QNG] + (size_t)l * 512, F.in[I_KVNG] + (size_t)l * 512);
                    __syncthreads();
                    EpiSlab E{(float*)(F.ws + WS_PART)};
                    { Gemm g{16 * DINP, 6144, 12, (size_t)DINP * 2}; SchedCmp S{(const char*)Z, (const char*)(WL + WO_1K), 0, F.cu, 0}; pg8::gemm_phase<EpiSlab, SchedCmp, 3>(F.lds, g, S, E); }
                    { Gemm g{16 * DINP, 4096, 8, (size_t)DINP * 2}; SchedCmp S{(const char*)Z, (const char*)(WL + WO_1V), 32, F.cu, 1}; pg8::gemm_phase<EpiSlab, SchedCmp, 2>(F.lds, g, S, E); }
                } PH_END;
                PH_IF {
                    { Gemm g{1024, 512, 8, 0}; SchedQKV S{(const char*)CQKV, (const char*)(WL + WO_Q), (const char*)(WL + WO_UKV), F.G, F.cu}; EpiQKV E{QM, KV};
                      pg8::gemm_phase<EpiQKV, SchedQKV, 0>(F.lds, g, S, E); }
                    for (int u = F.G - 1 - F.cu; u < 128; u += F.G) cmp_stage2_unit(F, u, l);
                } PH_END;
                PH_IF { att::cmp_phase(F); } PH_END;
                PH_IF { att::attn_phase(F, l);
#if PROBE_DUP == 7
                __syncthreads(); att::attn_phase(F, l, 32);
#endif
                } PH_END;
                PH_IF {
                    Gemm g{2048, 2048, 16, 0}; SchedMerge S{(const char*)AB, (const char*)(WL + WO_AB), F.G, F.cu}; EpiMerge E{Z, MG};
                    pg8::gemm_phase<EpiMerge, SchedMerge, 0>(F.lds, g, S, E);
                } PH_END;
                PH_IF {
                    Gemm g{2048, 2048, 32, 0}; SchedStd S; S.init(MG, 2048, WL + WO_OUT, 2048, M, D, F.G, F.cu); EpiBf16 E{Y, D};
                    pg8::gemm_phase<EpiBf16, SchedStd, 0>(F.lds, g, S, E);
                } PH_END;
                PH_IF { thin_post_norm(F, 1.0f, F.in[I_MPOST] + (size_t)l * D, F.in[I_F2PRE] + (size_t)l * D, nullptr); } PH_END;
            }
        }
    }
#undef PH_IF
#undef PH_END
#undef U
#undef H
#undef Y
#undef Z
#undef CQKV
#undef QM
#undef KV
#undef AB
#undef MG
#undef WL
}

extern "C" void kernel_launch(void* const* d_in, const int* in_sizes, int n_in, void* d_out, int out_size, void* d_ws, size_t ws_size, hipStream_t stream) {
    static int grid = 0;
    if (grid == 0) {
        if (n_in != 30 || in_sizes[0] != M * D || out_size != M * D || ws_size < WS_END) { fprintf(stderr, "kernel_launch: unexpected shapes / workspace (n_in %d, ws %zu < %zu)\n", n_in, ws_size, (size_t)WS_END); grid = -1; return; }
        int dev = 0, cus = 0, per_cu = 0;
        if (hipGetDevice(&dev) != hipSuccess || hipDeviceGetAttribute(&cus, hipDeviceAttributeMultiprocessorCount, dev) != hipSuccess) { grid = -1; return; }
        if (hipFuncSetAttribute((const void*)fwd, hipFuncAttributeMaxDynamicSharedMemorySize, LDS_BYTES) != hipSuccess) { fprintf(stderr, "kernel_launch: hipFuncSetAttribute failed\n"); grid = -1; return; }
        if (hipOccupancyMaxActiveBlocksPerMultiprocessor(&per_cu, (const void*)fwd, 512, LDS_BYTES) != hipSuccess || per_cu < 1) { fprintf(stderr, "kernel_launch: occupancy query says %d\n", per_cu); }
        (void)hipGetLastError();
        grid = cus;
    }
    if (grid < 0) return;
    (void)hipMemsetAsync((char*)d_ws + WS_CTL, 0, CTL_ZERO_BYTES, stream);
    Args a{};
    for (int i = 0; i < 30; ++i) a.in[i] = (const float*)d_in[i];
    a.out = (float*)d_out; a.ws = (unsigned char*)d_ws;
#if MK_PER_PHASE
    for (int p = 0; p < NPH; ++p) { a.ph_lo = p; a.ph_hi = p + 1; hipLaunchKernelGGL(fwd, dim3(grid), dim3(512), LDS_BYTES, stream, a); }
#else
    a.ph_lo = 0; a.ph_hi = NPH; hipLaunchKernelGGL(fwd, dim3(grid), dim3(512), LDS_BYTES, stream, a);
#endif
}
```

```cpp
#include <hip/hip_runtime.h>
#include <cstdio>
#include <cstdint>

#ifndef PROBE_DUP
#define PROBE_DUP 0
#endif
#ifndef MK_PER_PHASE
#define MK_PER_PHASE 0
#endif

#define GAS __attribute__((address_space(1)))
#define LAS __attribute__((address_space(3)))
typedef unsigned short bf16_t;
typedef short bf16x8 __attribute__((ext_vector_type(8)));
typedef float f32x4 __attribute__((ext_vector_type(4)));
typedef float f32x2 __attribute__((ext_vector_type(2)));
typedef unsigned u32x4 __attribute__((ext_vector_type(4)));
typedef unsigned u32x2 __attribute__((ext_vector_type(2)));
typedef __bf16 bf16x2_t __attribute__((ext_vector_type(2)));

constexpr int NB = 4, SEQ = 2048, M = NB * SEQ, D = 2048, NL = 4, FF = 5632;
constexpr int DIN = 8664, DINP = 8704;
constexpr int ZO_CQ = 0, ZO_CKV = 512, ZO_KR = 1024, ZO_NQ = 1088, ZO_KC = 2624, ZO_VC = 3008, ZO_KS = 3264, ZO_VS = 3648, ZO_KW = 3904, ZO_VW = 4288, ZO_NG = 4544, ZO_GA = 4568, ZO_GB = 6616;
constexpr float EPS = 1e-6f;
constexpr int NCMP = 127;

constexpr size_t MiB = 1u << 20;
constexpr size_t alup(size_t x) { return (x + MiB - 1) / MiB * MiB; }
constexpr size_t WS_CTL = 0, CTL_ZERO_BYTES = 1 * MiB;
constexpr size_t WS_TBL = WS_CTL + CTL_ZERO_BYTES;
constexpr size_t WS_ROPE = WS_TBL + MiB;
constexpr size_t WS_X = WS_ROPE + alup((size_t)M * 32 * 8);
constexpr size_t WS_U = WS_X + alup((size_t)M * D * 4);
constexpr size_t WS_H = WS_U + alup((size_t)M * D * 2);
constexpr size_t WS_Y = WS_H + alup((size_t)M * FF * 2);
constexpr size_t WS_Z = WS_Y + alup((size_t)M * D * 2);
constexpr size_t WS_CQKV = WS_Z + alup((size_t)(M + 64) * DINP * 2);
constexpr size_t WS_KPE = WS_CQKV + alup((size_t)M * 1024 * 2);
constexpr size_t WS_QM = WS_KPE + alup((size_t)M * 64 * 2);
constexpr size_t WS_KV = WS_QM + alup((size_t)M * 1536 * 2);
constexpr size_t WS_AB = WS_KV + alup((size_t)M * 2048 * 2);
constexpr size_t WS_MG = WS_AB + alup((size_t)M * 2048 * 2);
constexpr size_t WS_OC = WS_MG + alup((size_t)M * 2048 * 2);
constexpr size_t WS_PART = WS_OC + alup((size_t)M * 1024 * 4);
constexpr size_t WS_KC = WS_PART + alup((size_t)64 * 256 * 256 * 4);
constexpr size_t WS_SEL = WS_KC + MiB;
constexpr size_t WS_W = WS_SEL + MiB;
constexpr size_t WO_GU1 = 0, WO_D1 = WO_GU1 + (size_t)2 * FF * D, WO_GU2 = WO_D1 + (size_t)D * FF, WO_D2 = WO_GU2 + (size_t)2 * FF * D,
                 WO_IN = WO_D2 + (size_t)D * FF, WO_Q = WO_IN + (size_t)DINP * D, WO_UKV = WO_Q + (size_t)1536 * 512, WO_1K = WO_UKV + (size_t)2048 * 512,
                 WO_1V = WO_1K + (size_t)256 * 6144, WO_AB = WO_1V + (size_t)256 * 4096, WO_OUT = WO_AB + (size_t)2048 * 2048, WO_END = WO_OUT + (size_t)2048 * 2048;
constexpr size_t WS_END = WS_W + alup(WO_END * 2 * NL);
constexpr int CW_BAR = 4096;

constexpr int RING_BYTES = 131072, MISC_OFF = RING_BYTES + 320, LDS_BYTES = 147456;

#define RLX_AGENT __ATOMIC_RELAXED, __HIP_MEMORY_SCOPE_AGENT
__device__ __forceinline__ unsigned cvtpk(float lo, float hi) { f32x2 v = {lo, hi}; bf16x2_t b = __builtin_convertvector(v, bf16x2_t); return __builtin_bit_cast(unsigned, b); }
__device__ __forceinline__ float bflo(unsigned u) { return __uint_as_float(u << 16); }
__device__ __forceinline__ float bfhi(unsigned u) { return __uint_as_float(u & 0xffff0000u); }
__device__ __forceinline__ float bf1(bf16_t h) { return __uint_as_float((unsigned)h << 16); }
__device__ __forceinline__ float wave_sum(float v) {
#pragma unroll
    for (int o = 1; o < 64; o <<= 1) v += __shfl_xor(v, o);
    return v;
}
__device__ __forceinline__ float wave_max(float v) {
#pragma unroll
    for (int o = 1; o < 64; o <<= 1) v = fmaxf(v, __shfl_xor(v, o));
    return v;
}
__device__ __forceinline__ float sigmoidf_(float x) { return 1.0f / (1.0f + __expf(-x)); }

__device__ const float ROPE_INV[32] = {
    1.000000000e+00f, 7.498942614e-01f, 5.623413324e-01f, 4.216965139e-01f, 3.162277639e-01f, 2.371373773e-01f, 1.778279394e-01f, 1.333521307e-01f,
    1.000000015e-01f, 7.498941571e-02f, 5.623413250e-02f, 4.216965288e-02f, 3.162277490e-02f, 2.371373773e-02f, 1.778279431e-02f, 1.333521493e-02f,
    9.999999776e-03f, 7.498941850e-03f, 5.623413250e-03f, 4.216964822e-03f, 3.162277630e-03f, 2.371373586e-03f, 1.778279431e-03f, 1.333521446e-03f,
    1.000000047e-03f, 7.498942432e-04f, 5.623413017e-04f, 4.216965172e-04f, 3.162277571e-04f, 2.371373703e-04f, 1.778279402e-04f, 1.333521504e-04f};
__device__ const unsigned char REL_BUCKET[129] = {
    0, 1, 2, 3, 4, 5, 6, 7, 8, 9, 10, 11, 12, 13, 14, 15, 16, 16, 16, 17, 17, 18, 18, 18, 19, 19, 19, 20, 20, 20, 20, 21, 21, 21, 21, 22, 22, 22, 22, 22, 23, 23, 23, 23, 23, 23, 24, 24, 24, 24, 24, 24,
    25, 25, 25, 25, 25, 25, 25, 26, 26, 26, 26, 26, 26, 26, 26, 27, 27, 27, 27, 27, 27, 27, 27, 27, 27, 28, 28, 28, 28, 28, 28, 28, 28, 28, 28, 29, 29, 29, 29, 29, 29, 29, 29, 29, 29, 29, 29,
    30, 30, 30, 30, 30, 30, 30, 30, 30, 30, 30, 30, 30, 30, 31, 31, 31, 31, 31, 31, 31, 31, 31, 31, 31, 31, 31, 31, 31, 31};

#define XB_TMO      128
#define XB_XCNT(j)  (256  + 64 * (j))
#define XB_XSUB(j)  (1280 + 64 * (j))
#define XB_XGEN(j)  (2304 + 64 * (j))
#define XB_TOP      3328
#define XB_TOPGEN   3392
#define XCD_BAR_WORDS 3456
#define XB_SPIN_CAP (1u << 18)
__device__ __forceinline__ unsigned xb_ld(unsigned* p)              { return __hip_atomic_load(p, __ATOMIC_RELAXED, __HIP_MEMORY_SCOPE_AGENT); }
__device__ __forceinline__ unsigned xb_add(unsigned* p, unsigned v) { return __hip_atomic_fetch_add(p, v, __ATOMIC_RELAXED, __HIP_MEMORY_SCOPE_AGENT); }
__device__ __forceinline__ unsigned xb_xcc_id() { return (unsigned)__builtin_amdgcn_s_getreg((3 << 11) | 20) & 0xFu; }
#define XB_SPIN(cond, bar) do { unsigned _sp = 0; while (cond) { __builtin_amdgcn_s_sleep(1); \
    if ((++_sp & 255u) == 0u) { if (xb_ld(&(bar)[XB_TMO])) break; if (_sp > XB_SPIN_CAP) { atomicAdd(&(bar)[XB_TMO], 1u); break; } } } } while (0)
struct XcdBarrier { unsigned* bar; unsigned x; volatile LAS unsigned* st; };
__device__ __forceinline__ XcdBarrier xcd_barrier_post(unsigned* bar, volatile LAS unsigned* st) {
    XcdBarrier b; b.bar = bar; b.x = xb_xcc_id(); b.st = st;
    if (threadIdx.x == 0) (void)xb_add(&bar[XB_XCNT(b.x)], 1u);
    return b;
}
__device__ __forceinline__ void xcd_barrier_complete(unsigned* bar, unsigned x, unsigned& nloc, unsigned& nx) {
    const unsigned G = gridDim.x * gridDim.y * gridDim.z;
    unsigned sum, cnt, mine, sp = 0u;
    for (;;) {
        sum = 0u; cnt = 0u; mine = 0u;
#pragma unroll
        for (unsigned j = 0; j < 16; ++j) { const unsigned c = xb_ld(&bar[XB_XCNT(j)]); sum += c; cnt += (c > 0u) ? 1u : 0u; mine = (j == x) ? c : mine; }
        if (sum == G) break;
        __builtin_amdgcn_s_sleep(1);
        if ((++sp & 255u) == 0u) { if (xb_ld(&bar[XB_TMO])) break; if (sp > XB_SPIN_CAP) { atomicAdd(&bar[XB_TMO], 1u); break; } }
    }
    nloc = mine > 0u ? mine : 1u; nx = cnt > 0u ? cnt : 1u;
}
__device__ __forceinline__ void xcd_barrier(const XcdBarrier& b) {
    asm volatile("s_waitcnt vmcnt(0)" ::: "memory");
    __syncthreads();
    if (threadIdx.x == 0) {
        unsigned* bar = b.bar;
        __builtin_amdgcn_s_waitcnt(0);
        unsigned nloc = b.st[0], nx = b.st[1];
        if (nloc == 0u) { xcd_barrier_complete(bar, b.x, nloc, nx); b.st[0] = nloc; b.st[1] = nx; }
        const unsigned old = xb_add(&bar[XB_XSUB(b.x)], 1u);
        const unsigned gen = old / nloc;
        if (old + 1u == (gen + 1u) * nloc) {
            __builtin_amdgcn_fence(__ATOMIC_RELEASE, "agent");
            asm volatile("s_waitcnt vmcnt(0)" ::: "memory");
            const unsigned og = xb_add(&bar[XB_TOP], 1u);
            const unsigned tg = og / nx;
            if (og + 1u == (tg + 1u) * nx) xb_add(&bar[XB_TOPGEN], 1u);
            else XB_SPIN(xb_ld(&bar[XB_TOPGEN]) == tg, bar);
            __builtin_amdgcn_fence(__ATOMIC_ACQUIRE, "agent");
            xb_add(&bar[XB_XGEN(b.x)], 1u);
            asm volatile("s_waitcnt vmcnt(0)" ::: "memory");
        } else {
            XB_SPIN(xb_ld(&bar[XB_XGEN(b.x)]) == gen, bar);
            __builtin_amdgcn_fence(__ATOMIC_ACQUIRE, "agent");
            asm volatile("s_waitcnt vmcnt(0)" ::: "memory");
        }
    }
    __syncthreads();
}

namespace pg8 {
constexpr int BM = 256, BK = 64, HALF = 128, HTB = HALF * BK * 2, STAGE_BYTES = 8 * HTB, NXCD = 8, WGM = 8;
__host__ __device__ __forceinline__ int lds_byte(int r, int c) { const int st = (r >> 4) * 2 + (c >> 5), rr = r & 15, cc = c & 31, ob = rr * 64 + cc * 2; return st * 1024 + (ob ^ (((ob >> 9) & 1) << 5)); }
__host__ __device__ __forceinline__ void stage_rc(int b, int& R, int& C) { const int st = b / 1024, sb = b % 1024, swz = sb ^ (((sb >> 9) & 1) << 5); R = (st >> 1) * 16 + swz / 64; C = (st & 1) * 32 + (swz % 64) / 2; }
__host__ __device__ __forceinline__ int perm32(int rho) { const int n = rho >> 4, i = rho & 15; return 8 * (i >> 2) + 4 * n + (i & 3); }

struct Unit { const char* a; const char* b; int pm, pn, aux; };
struct Gemm { int lda, ldb, nt; size_t gstride; };

struct StaticOrder {
    int nM, nN, nwg, G, c;
    __device__ void init(int M_, int N_, int G_, int c_) { nM = M_ / BM; nN = N_ / BM; nwg = nM * nN; G = G_; c = c_; }
    __device__ bool next(int i, int& pm, int& pn) const {
        const long L = (long)i * G + c; if (L >= nwg) return false;
        int wgid = (int)L; { const int q = nwg / NXCD, r = nwg % NXCD, xcd = wgid % NXCD, off = wgid / NXCD; wgid = (xcd < r ? xcd * (q + 1) : r * (q + 1) + (xcd - r) * q) + off; }
        const int nig = WGM * nN, gid = wgid / nig, fm = gid * WGM, gsz = (nM - fm) < WGM ? (nM - fm) : WGM;
        pm = fm + ((wgid % nig) % gsz); pn = (wgid % nig) / gsz; return true;
    }
};

template <class Epi, class Sched, int KGRP>
__device__ __forceinline__ void gemm_phase(LAS unsigned char* lds, const Gemm g, const Sched& S, const Epi& E) {
    int tid_ = threadIdx.x; asm volatile("" : "+v"(tid_));
    const int tid = tid_, wid = __builtin_amdgcn_readfirstlane(tid >> 6), lane = tid & 63, wr = wid >> 2, wc = wid & 3, fr = lane & 15, fq = lane >> 4;
    const int nt = g.nt;
    unsigned voffA[2], voffB[2];
#pragma unroll
    for (int i = 0; i < 2; ++i) { int R, C; stage_rc(tid * 16 + i * 8192, R, C); const int Rb = (R & ~31) + perm32(R & 31);
        voffA[i] = (unsigned)(R * g.lda + C) * 2u; voffB[i] = (unsigned)(Rb * g.ldb + C) * 2u; }
    const size_t kstep = (size_t)(BK * 2);
    const size_t hstepA = (size_t)HALF * g.lda * 2, hstepB = (size_t)HALF * g.ldb * 2;
    const unsigned ldsw = (unsigned)wid * 1024u;
    const int aoff = lds_byte(wr * 64 + fr, fq * 8), boff = lds_byte(wc * 32 + fr, fq * 8);
    auto koffA = [&](int t) -> size_t { if constexpr (KGRP > 0) return (size_t)(t / KGRP) * g.gstride + (size_t)(t % KGRP) * kstep; else return (size_t)t * kstep; };
#define PG8_SA(b, h) (((b) * 2 + (h)) * HTB)
#define PG8_SB(b, h) ((4 + (b) * 2 + (h)) * HTB)
#define PG8_STAGE(bufoff, gbase, voff) do { _Pragma("unroll") for (int _i = 0; _i < 2; ++_i) \
        __builtin_amdgcn_global_load_lds((const unsigned*)((const char*)(gbase) + (voff)[_i]), (LAS unsigned*)(lds + (bufoff) + ldsw + _i * 8192), 16, 0, 0); } while (0)
#define PG8_LDA(dst, b, h) do { _Pragma("unroll") for (int m = 0; m < 4; ++m) _Pragma("unroll") for (int k = 0; k < 2; ++k) dst[m][k] = *(const LAS bf16x8*)(lds + PG8_SA(b, h) + aoff + m * 2048 + k * 1024); } while (0)
#define PG8_LDB(dst, b, h) do { _Pragma("unroll") for (int n = 0; n < 2; ++n) _Pragma("unroll") for (int k = 0; k < 2; ++k) dst[n][k] = *(const LAS bf16x8*)(lds + PG8_SB(b, h) + boff + n * 2048 + k * 1024); } while (0)
#define PG8_MMA(ai, bj, At, Bt) do { __builtin_amdgcn_s_setprio(1); _Pragma("unroll") for (int m = 0; m < 4; ++m) _Pragma("unroll") for (int n = 0; n < 2; ++n) _Pragma("unroll") for (int k = 0; k < 2; ++k) \
        acc[ai][bj][m][n] = __builtin_amdgcn_mfma_f32_16x16x32_bf16(Bt[n][k], At[m][k], acc[ai][bj][m][n], 0, 0, 0); __builtin_amdgcn_s_setprio(0); } while (0)
#define PG8_WAIT_V(n) asm volatile("s_waitcnt vmcnt(" #n ")" ::: "memory")
#define PG8_WAIT_L(n) asm volatile("s_waitcnt lgkmcnt(" #n ")" ::: "memory")
#define PG8_BAR __builtin_amdgcn_s_barrier()
#define PG8_SCHED __builtin_amdgcn_sched_barrier(0)
    Unit cur, nxt; int ui = 0;
    if (!S.next(0, cur)) return;
    f32x4 acc[2][2][4][2];
#pragma unroll
    for (int a = 0; a < 2; ++a)
#pragma unroll
        for (int b = 0; b < 2; ++b)
#pragma unroll
            for (int m = 0; m < 4; ++m)
#pragma unroll
                for (int n = 0; n < 2; ++n) acc[a][b][m][n] = (f32x4){0.f, 0.f, 0.f, 0.f};
    bf16x8 At[4][2], B0[2][2], B1[2][2];
    const char* cA = cur.a; const char* cB = cur.b;
    PG8_STAGE(PG8_SB(0, 0), cB, voffB); PG8_STAGE(PG8_SB(0, 1), cB + hstepB, voffB); PG8_STAGE(PG8_SA(0, 0), cA, voffA); PG8_STAGE(PG8_SA(0, 1), cA + hstepA, voffA);
    if (wr == 1) PG8_BAR;
    PG8_WAIT_V(2); PG8_BAR;
    { const char* a1p = cA + koffA(1);
      PG8_STAGE(PG8_SB(1, 0), cB + kstep, voffB); PG8_STAGE(PG8_SA(1, 0), a1p, voffA); PG8_STAGE(PG8_SB(1, 1), cB + hstepB + kstep, voffB); }
    PG8_WAIT_V(6); PG8_BAR;
    for (;;) {
        const bool has_next = S.next(ui + 1, nxt);
        const char* nA = has_next ? nxt.a : cA; const char* nB = has_next ? nxt.b : cB;
        for (int t = 0; t < nt; t += 2) {
            const bool last = (t == nt - 2);
            const char* a1 = cA + koffA(t + 1);
            const char* a2 = last ? nA : cA + koffA(t + 2); const char* b2 = last ? nB : cB + (size_t)(t + 2) * kstep;
            const char* a3 = last ? nA + koffA(1) : cA + koffA(t + 3); const char* b3 = b2 + kstep;
            PG8_LDB(B0, 0, 0); PG8_LDB(B1, 0, 1); PG8_SCHED; PG8_LDA(At, 0, 0); PG8_STAGE(PG8_SA(1, 1), a1 + hstepA, voffA);
            PG8_WAIT_V(8); PG8_WAIT_L(0); PG8_BAR; PG8_MMA(0, 0, At, B0); PG8_MMA(0, 1, At, B1); PG8_BAR; PG8_SCHED;
            PG8_LDA(At, 0, 1); PG8_STAGE(PG8_SB(0, 0), b2, voffB); PG8_STAGE(PG8_SB(0, 1), b2 + hstepB, voffB); PG8_STAGE(PG8_SA(0, 0), a2, voffA);
            PG8_WAIT_V(8); PG8_WAIT_L(0); PG8_BAR; PG8_MMA(1, 0, At, B0); PG8_MMA(1, 1, At, B1); PG8_BAR; PG8_SCHED;
            PG8_LDB(B0, 1, 0); PG8_LDB(B1, 1, 1); PG8_SCHED; PG8_LDA(At, 1, 0); PG8_STAGE(PG8_SA(0, 1), a2 + hstepA, voffA);
            PG8_WAIT_V(8); PG8_WAIT_L(0); PG8_BAR; PG8_MMA(0, 0, At, B0); PG8_MMA(0, 1, At, B1); PG8_BAR; PG8_SCHED;
            PG8_LDA(At, 1, 1); PG8_STAGE(PG8_SB(1, 0), b3, voffB); PG8_STAGE(PG8_SB(1, 1), b3 + hstepB, voffB); PG8_STAGE(PG8_SA(1, 0), a3, voffA);
            PG8_WAIT_V(8); PG8_WAIT_L(0); PG8_BAR; PG8_MMA(1, 0, At, B0); PG8_MMA(1, 1, At, B1); PG8_BAR; PG8_SCHED;
        }
        if (wr == 0) PG8_BAR;
        const bool keep = E(acc, cur, wr, wc, fr, fq);
        if (!has_next) break;
        if (!keep) {
#pragma unroll
            for (int a = 0; a < 2; ++a)
#pragma unroll
                for (int b = 0; b < 2; ++b)
#pragma unroll
                    for (int m = 0; m < 4; ++m)
#pragma unroll
                        for (int n = 0; n < 2; ++n) acc[a][b][m][n] = (f32x4){0.f, 0.f, 0.f, 0.f};
        }
        cur = nxt; cA = nA; cB = nB; ++ui;
        if (wr == 1) PG8_BAR;
    }
    PG8_WAIT_V(0);
    PG8_BAR;
#undef PG8_SA
#undef PG8_SB
#undef PG8_STAGE
#undef PG8_LDA
#undef PG8_LDB
#undef PG8_MMA
#undef PG8_WAIT_V
#undef PG8_WAIT_L
#undef PG8_BAR
#undef PG8_SCHED
}
}
using pg8::Unit; using pg8::Gemm;
typedef f32x4 Acc[2][2][4][2];

struct SchedStd {
    pg8::StaticOrder so; const char* A; const char* B; size_t tA, tB;
    __device__ void init(const bf16_t* A_, int lda, const bf16_t* B_, int ldb, int M_, int N_, int G, int c) { so.init(M_, N_, G, c); A = (const char*)A_; B = (const char*)B_; tA = (size_t)256 * lda * 2; tB = (size_t)256 * ldb * 2; }
    __device__ bool next(int i, Unit& u) const { int pm, pn; if (!so.next(i, pm, pn)) return false; u.pm = pm; u.pn = pn; u.aux = 0; u.a = A + pm * tA; u.b = B + pn * tB; return true; }
};

struct EpiBf16 {
    bf16_t* O; int ldc;
    __device__ __forceinline__ bool operator()(Acc& acc, const Unit& u, int wr, int wc, int fr, int fq) const {
        const int row0 = u.pm * 256 + wr * 64 + fr, col0 = u.pn * 256 + wc * 32 + 8 * fq;
#pragma unroll
        for (int ai = 0; ai < 2; ++ai)
#pragma unroll
            for (int m = 0; m < 4; ++m) { bf16_t* rowp = O + (size_t)(row0 + ai * 128 + m * 16) * ldc + col0;
#pragma unroll
                for (int bj = 0; bj < 2; ++bj) { const f32x4 v0 = acc[ai][bj][m][0], v1 = acc[ai][bj][m][1];
                    u32x4 w; w.x = cvtpk(v0[0], v0[1]); w.y = cvtpk(v0[2], v0[3]); w.z = cvtpk(v1[0], v1[1]); w.w = cvtpk(v1[2], v1[3]);
                    *(u32x4*)(rowp + bj * 128) = w; } }
        return false;
    }
};
struct EpiSwiGLU {
    bf16_t* O; int ldc;
    __device__ __forceinline__ bool operator()(Acc& acc, const Unit& u, int wr, int wc, int fr, int fq) const {
        const int row0 = u.pm * 256 + wr * 64 + fr, col0 = u.pn * 128 + wc * 32 + 8 * fq;
#pragma unroll
        for (int ai = 0; ai < 2; ++ai)
#pragma unroll
            for (int m = 0; m < 4; ++m) { bf16_t* rowp = O + (size_t)(row0 + ai * 128 + m * 16) * ldc + col0;
                float h[8];
#pragma unroll
                for (int n = 0; n < 2; ++n)
#pragma unroll
                    for (int e = 0; e < 4; ++e) { const float gt = acc[ai][0][m][n][e], up = acc[ai][1][m][n][e]; h[n * 4 + e] = gt * sigmoidf_(gt) * up; }
                u32x4 w; w.x = cvtpk(h[0], h[1]); w.y = cvtpk(h[2], h[3]); w.z = cvtpk(h[4], h[5]); w.w = cvtpk(h[6], h[7]);
                *(u32x4*)rowp = w; }
        return false;
    }
};
struct EpiSlab {
    float* P;
    __device__ __forceinline__ bool operator()(Acc& acc, const Unit& u, int wr, int wc, int fr, int fq) const {
        float* base = P + (size_t)u.aux * 65536;
#pragma unroll
        for (int ai = 0; ai < 2; ++ai)
#pragma unroll
            for (int m = 0; m < 4; ++m) { float* rowp = base + (size_t)(ai * 128 + wr * 64 + m * 16 + fr) * 256 + wc * 32 + 8 * fq;
#pragma unroll
                for (int bj = 0; bj < 2; ++bj) { *(f32x4*)(rowp + bj * 128) = acc[ai][bj][m][0]; *(f32x4*)(rowp + bj * 128 + 4) = acc[ai][bj][m][1]; } }
        return false;
    }
};
struct EpiQKV {
    bf16_t* Q; bf16_t* KV;
    __device__ __forceinline__ bool operator()(Acc& acc, const Unit& u, int wr, int wc, int fr, int fq) const {
        EpiBf16 e{u.aux ? KV : Q, u.aux ? 2048 : 1536}; return e(acc, u, wr, wc, fr, fq);
    }
};
struct EpiMerge {
    const bf16_t* Z; bf16_t* O;
    __device__ __forceinline__ bool operator()(Acc& acc, const Unit& u, int wr, int wc, int fr, int fq) const {
        const int row0 = u.pm * 256 + wr * 64 + fr, col0 = u.pn * 256 + wc * 32 + 8 * fq;
#pragma unroll
        for (int ai = 0; ai < 2; ++ai)
#pragma unroll
            for (int m = 0; m < 4; ++m) { const size_t row = (size_t)(row0 + ai * 128 + m * 16);
#pragma unroll
                for (int bj = 0; bj < 2; ++bj) { const int col = col0 + bj * 128;
                    const u32x4 gbw = *(const u32x4*)(Z + row * DINP + ZO_GB + col);
                    float gb[8] = {sigmoidf_(bflo(gbw.x)), sigmoidf_(bfhi(gbw.x)), sigmoidf_(bflo(gbw.y)), sigmoidf_(bfhi(gbw.y)), sigmoidf_(bflo(gbw.z)), sigmoidf_(bfhi(gbw.z)), sigmoidf_(bflo(gbw.w)), sigmoidf_(bfhi(gbw.w))};
                    if (u.aux == 0) {
                        const u32x4 gaw = *(const u32x4*)(Z + row * DINP + ZO_GA + col);
                        float ga[8] = {sigmoidf_(bflo(gaw.x)), sigmoidf_(bfhi(gaw.x)), sigmoidf_(bflo(gaw.y)), sigmoidf_(bfhi(gaw.y)), sigmoidf_(bflo(gaw.z)), sigmoidf_(bfhi(gaw.z)), sigmoidf_(bflo(gaw.w)), sigmoidf_(bfhi(gaw.w))};
#pragma unroll
                        for (int n = 0; n < 2; ++n)
#pragma unroll
                            for (int e = 0; e < 4; ++e) acc[ai][bj][m][n][e] *= ga[n * 4 + e] / gb[n * 4 + e];
                    } else {
                        float h[8];
#pragma unroll
                        for (int n = 0; n < 2; ++n)
#pragma unroll
                            for (int e = 0; e < 4; ++e) h[n * 4 + e] = acc[ai][bj][m][n][e] * gb[n * 4 + e];
                        u32x4 w; w.x = cvtpk(h[0], h[1]); w.y = cvtpk(h[2], h[3]); w.z = cvtpk(h[4], h[5]); w.w = cvtpk(h[6], h[7]);
                        *(u32x4*)(O + row * 2048 + col) = w;
                    } } }
        return u.aux == 0;
    }
};

struct Args { const float* in[30]; float* out; unsigned char* ws; int ph_lo, ph_hi; };
enum { I_X = 0, I_POS, I_RELB, I_F1PRE, I_F1POST, I_F1G, I_F1U, I_F1D, I_MPRE, I_MPOST, I_WIN, I_QNG, I_WQUP, I_KVNG, I_WUK, I_WUV, I_PEK, I_W1K, I_W2K, I_PEV, I_W1V, I_W2V, I_WA, I_WB, I_WOUT,
       I_F2PRE, I_F2POST, I_F2G, I_F2U, I_F2D };
struct Frame {
    LAS unsigned char* lds; int tid, lane, wave, G, cu;
    const float* const* in; float* out; unsigned char* ws;
};

__device__ __forceinline__ void launder(Frame& F) { unsigned long long w_ = (unsigned long long)F.ws; unsigned lo_ = (unsigned)w_, hi_ = (unsigned)(w_ >> 32);
    int cu_ = F.cu; asm volatile("" : "+v"(F.tid), "+v"(F.lane), "+v"(lo_), "+v"(hi_), "+v"(cu_));
    lo_ = (unsigned)__builtin_amdgcn_readfirstlane((int)lo_); hi_ = (unsigned)__builtin_amdgcn_readfirstlane((int)hi_); F.ws = (unsigned char*)(((unsigned long long)hi_ << 32) | lo_); F.cu = __builtin_amdgcn_readfirstlane(cu_); }
__device__ __forceinline__ void p0_transpose_item(const float* W, int K, int N, bf16_t* WT, int ldk, int koff, int mode, int row_off, LAS float* scr, int item, int lane) {
    const int nblk = (N + 31) / 32, kb = item / nblk, nb = item % nblk, k0 = 64 * kb, n0 = 32 * nb;
    const bool nok = (n0 + (lane & 31)) < N;
#pragma unroll 8
    for (int i = 0; i < 32; ++i) { const int kk = 2 * i + (lane >> 5); scr[kk * 33 + (lane & 31)] = nok ? W[(size_t)(k0 + kk) * N + n0 + (lane & 31)] : 0.f; }
    asm volatile("s_waitcnt lgkmcnt(0)" ::: "memory");
    const int c = lane & 7;
    const int rbase = mode ? ((n0 >> 7) * 256 + row_off + (n0 & 127)) : (row_off + n0);
#pragma unroll
    for (int j = 0; j < 4; ++j) { const int n = (lane >> 3) + 8 * j; const LAS float* s = scr + (8 * c) * 33 + n;
        u32x4 o; o.x = cvtpk(s[0 * 33], s[1 * 33]); o.y = cvtpk(s[2 * 33], s[3 * 33]); o.z = cvtpk(s[4 * 33], s[5 * 33]); o.w = cvtpk(s[6 * 33], s[7 * 33]);
        if (n0 + n < N) *(u32x4*)(WT + (size_t)(rbase + n) * ldk + koff + k0 + 8 * c) = o; }
    asm volatile("s_waitcnt lgkmcnt(0)" ::: "memory");
}
__device__ __forceinline__ unsigned cvt_offb(unsigned row, unsigned ch) { return 256u * row + 16u * (ch ^ (((row & 3u) << 2) | ((row >> 2) & 3u))); }
__device__ __forceinline__ void p0_cvt_tile(Frame& F, const float* W, int K, int N, bf16_t* WT, int ldk, int koff, int mode, int row_off, int item) {
    typedef short v4i16_t __attribute__((ext_vector_type(4)));
    const int ntn = (N + 127) >> 7, kb = item / ntn, nb = item - kb * ntn, k0 = kb * 128, n0 = nb * 128;
    const int tid = F.tid, lane = F.lane, w = F.wave;
    f32x4 v[8];
#pragma unroll
    for (int i = 0; i < 8; ++i) { const int c = tid + 512 * i, k = c >> 5, n = n0 + 4 * (c & 31);
        v[i] = (n < N) ? *(const f32x4*)(W + (size_t)(k0 + k) * N + n) : (f32x4){0.f, 0.f, 0.f, 0.f}; }
    __syncthreads();
#pragma unroll
    for (int i = 0; i < 8; ++i) { const int c = tid + 512 * i, k = c >> 5, nch = c & 31;
        *(LAS u32x2*)(F.lds + cvt_offb(k, nch >> 1) + 8 * (nch & 1)) = (u32x2){cvtpk(v[i].x, v[i].y), cvtpk(v[i].z, v[i].w)}; }
    __syncthreads();
    const int c4 = w & 3, ks0 = (w >> 2) * 4;
    const unsigned h = lane >> 5, blk = (lane >> 4) & 1, q = (lane & 15) >> 2, p = lane & 3;
    const int nl = 32 * c4 + (lane & 31);
    const int rbase = mode ? ((n0 >> 7) * 256 + row_off) : (row_off + n0);
    bf16_t* dst = WT + (size_t)(rbase + nl) * ldk + koff + k0 + 8 * h;
#pragma unroll
    for (int kk = 0; kk < 4; ++kk) { const int ks = ks0 + kk;
        const v4i16_t lo = __builtin_amdgcn_ds_read_tr16_b64_v4i16((LAS v4i16_t*)(F.lds + cvt_offb(16 * ks + 8 * h + q, 4 * c4 + 2 * blk + (p >> 1)) + 8 * (p & 1)));
        const v4i16_t hi = __builtin_amdgcn_ds_read_tr16_b64_v4i16((LAS v4i16_t*)(F.lds + cvt_offb(16 * ks + 8 * h + 4 + q, 4 * c4 + 2 * blk + (p >> 1)) + 8 * (p & 1)));
        const bf16x8 o = {lo[0], lo[1], lo[2], lo[3], hi[0], hi[1], hi[2], hi[3]};
        if (n0 + nl < N) *(bf16x8*)(dst + 16 * ks) = o; }
}
struct CvtJob { int in_idx, K, N, ldk, koff, mode, row_off; size_t dst_off; };
__device__ __forceinline__ CvtJob cvt_job(int j) {
    switch (j) {
    case 0:  return CvtJob{I_F1G, D, FF, D, 0, 1, 0, WO_GU1};
    case 1:  return CvtJob{I_F1U, D, FF, D, 0, 1, 128, WO_GU1};
    case 2:  return CvtJob{I_F1D, FF, D, FF, 0, 0, 0, WO_D1};
    case 3:  return CvtJob{I_F2G, D, FF, D, 0, 1, 0, WO_GU2};
    case 4:  return CvtJob{I_F2U, D, FF, D, 0, 1, 128, WO_GU2};
    case 5:  return CvtJob{I_F2D, FF, D, FF, 0, 0, 0, WO_D2};
    case 6:  return CvtJob{I_WIN, D, DIN, D, 0, 0, 0, WO_IN};
    case 7:  return CvtJob{I_WQUP, 512, 1536, 512, 0, 0, 0, WO_Q};
    case 8:  return CvtJob{I_WUK, 512, 1024, 512, 0, 0, 0, WO_UKV};
    case 9:  return CvtJob{I_WUV, 512, 1024, 512, 0, 0, 1024, WO_UKV};
    case 10: return CvtJob{I_W1K, 6144, 256, 6144, 0, 0, 0, WO_1K};
    case 11: return CvtJob{I_W1V, 4096, 256, 4096, 0, 0, 0, WO_1V};
    case 12: return CvtJob{I_WA, 1024, 2048, 2048, 0, 0, 0, WO_AB};
    case 13: return CvtJob{I_WB, 1024, 2048, 2048, 1024, 0, 0, WO_AB};
    default: return CvtJob{I_WOUT, 2048, 2048, 2048, 0, 0, 0, WO_OUT};
    }
}
constexpr int N_CVT_JOBS = 15;
__device__ __forceinline__ void p0_prologue(Frame& F) {
    bf16_t* wbase = (bf16_t*)(F.ws + WS_W);
    {
        typedef short v4i16_t __attribute__((ext_vector_type(4)));
        const int tid = F.tid, lane = F.lane, w = F.wave;
        int l = 0, j = 0, base = 0, flat = F.cu; CvtJob J = cvt_job(0); int n = (J.K / 128) * ((J.N + 127) / 128);
        bool have = true;
#define P0_SEEK() do { while (flat >= base + n) { base += n; if (++j == N_CVT_JOBS) { j = 0; ++l; } if (l >= NL) { have = false; break; } J = cvt_job(j); n = (J.K / 128) * ((J.N + 127) / 128); } } while (0)
#define P0_LOAD() do { const int it_ = flat - base, ntn_ = (J.N + 127) >> 7, kb_ = it_ / ntn_, nb_ = it_ - kb_ * ntn_; const float* W_ = F.in[J.in_idx] + (size_t)l * J.K * J.N; \
        _Pragma("unroll") for (int i = 0; i < 8; ++i) { const int c = tid + 512 * i, k = c >> 5, nn = nb_ * 128 + 4 * (c & 31); \
            v[i] = (nn < J.N) ? *(const f32x4*)(W_ + (size_t)(kb_ * 128 + k) * J.N + nn) : (f32x4){0.f, 0.f, 0.f, 0.f}; } } while (0)
        P0_SEEK();
        f32x4 v[8];
        if (have) P0_LOAD();
        int pb = 0;
        while (have) {
            const CvtJob cJ = J; const int cl = l, it = flat - base;
            LAS unsigned char* buf = F.lds + pb * 32768;
#pragma unroll
            for (int i = 0; i < 8; ++i) { const int c = tid + 512 * i, k = c >> 5, nch = c & 31;
                *(LAS u32x2*)(buf + cvt_offb(k, nch >> 1) + 8 * (nch & 1)) = (u32x2){cvtpk(v[i].x, v[i].y), cvtpk(v[i].z, v[i].w)}; }
            asm volatile("s_waitcnt lgkmcnt(0)" ::: "memory"); __builtin_amdgcn_s_barrier(); asm volatile("" ::: "memory");
            flat += F.G; P0_SEEK();
            if (have) P0_LOAD();
            const int ntn = (cJ.N + 127) >> 7, kb = it / ntn, nb = it - kb * ntn, k0 = kb * 128, n0 = nb * 128;
            const int c4 = w & 3, ks0 = (w >> 2) * 4;
            const unsigned h = lane >> 5, blk = (lane >> 4) & 1, q = (lane & 15) >> 2, p = lane & 3;
            const int nl = 32 * c4 + (lane & 31);
            const int rbase = cJ.mode ? ((n0 >> 7) * 256 + cJ.row_off) : (cJ.row_off + n0);
            bf16_t* dst = wbase + (size_t)cl * WO_END + cJ.dst_off + (size_t)(rbase + nl) * cJ.ldk + cJ.koff + k0 + 8 * h;
#pragma unroll
            for (int kk = 0; kk < 4; ++kk) { const int ks = ks0 + kk;
                const v4i16_t lo = __builtin_amdgcn_ds_read_tr16_b64_v4i16((LAS v4i16_t*)(buf + cvt_offb(16 * ks + 8 * h + q, 4 * c4 + 2 * blk + (p >> 1)) + 8 * (p & 1)));
                const v4i16_t hi = __builtin_amdgcn_ds_read_tr16_b64_v4i16((LAS v4i16_t*)(buf + cvt_offb(16 * ks + 8 * h + 4 + q, 4 * c4 + 2 * blk + (p >> 1)) + 8 * (p & 1)));
                const bf16x8 o = {lo[0], lo[1], lo[2], lo[3], hi[0], hi[1], hi[2], hi[3]};
                if (n0 + nl < cJ.N) *(bf16x8*)(dst + 16 * ks) = o; }
            pb ^= 1;
        }
#undef P0_SEEK
#undef P0_LOAD
    }
    __syncthreads();
    {
        const f32x4* xs = (const f32x4*)F.in[I_X]; f32x4* xd = (f32x4*)(F.ws + WS_X);
        for (size_t i = (size_t)F.cu * 512 + F.tid; i < (size_t)M * D / 4; i += (size_t)F.G * 512) xd[i] = xs[i];
        const int* pos = (const int*)F.in[I_POS]; f32x2* rope = (f32x2*)(F.ws + WS_ROPE);
        for (int i = F.cu * 512 + F.tid; i < M * 32; i += F.G * 512) {
            const float ang = (float)pos[i >> 5] * ROPE_INV[i & 31];
            const double rev = (double)ang * 0.15915494309189535; const float fr = (float)(rev - __builtin_rint(rev));
            rope[i] = (f32x2){__builtin_amdgcn_cosf(fr), __builtin_amdgcn_sinf(fr)};
        }
        float* tbl = (float*)(F.ws + WS_TBL);
        if (F.cu == 0) for (int i = F.tid; i < 8 * 132; i += 512) { const int h = i / 132, d = i % 132; const float tv = F.in[I_RELB][REL_BUCKET[d > 128 ? 128 : d] * 8 + h]; tbl[i] = tv; ((float*)(F.ws + WS_TBL + 16384))[i] = tv * 1.4426950408889634f; }
        {
            float* pp = (float*)(F.ws + WS_TBL + 32768);
            for (int item = F.cu; item < NL * 160; item += F.G) {
                const int l = item / 160, r = item % 160, kv = r >= 96, ch = kv ? r - 96 : r, Kk = kv ? 4096 : 6144;
                const float* pe = F.in[kv ? I_PEV : I_PEK] + (size_t)l * Kk + ch * 64; const float* w1 = F.in[kv ? I_W1V : I_W1K] + ((size_t)l * Kk + ch * 64) * 256;
                const int c = F.tid & 255, hf = F.tid >> 8; float sacc = 0.f;
#pragma unroll 8
                for (int k = hf * 32; k < hf * 32 + 32; ++k) sacc += pe[k] * w1[(size_t)k * 256 + c];
                LAS float* red = (LAS float*)(F.lds + 65536);
                __syncthreads();
                if (hf) red[c] = sacc;
                __syncthreads();
                if (!hf) pp[((size_t)(l * 2 + kv) * 96 + ch) * 256 + c] = sacc + red[c];
            }
        }
    }
}
__device__ __forceinline__ void pe_bias_reduce(Frame& F) {
    const float* pp = (const float*)(F.ws + WS_TBL + 32768);
    for (int u = F.cu; u < NL * 2; u += F.G) if (F.tid < 256) {
        const int kv = u & 1, nch = kv ? 64 : 96; float s = 0.f;
        for (int ch = 0; ch < nch; ++ch) s += pp[((size_t)u * 96 + ch) * 256 + F.tid];
        ((float*)(F.ws + WS_TBL + 8192))[u * 256 + F.tid] = s;
    }
}

__device__ __forceinline__ void thin_first_norm(Frame& F, const float* g) {
    const int gw = F.cu * 8 + F.wave, NGW = F.G * 8;
    const float* X = (const float*)(F.ws + WS_X); bf16_t* U = (bf16_t*)(F.ws + WS_U);
    for (int m = gw; m < M; m += NGW) {
        const f32x4* xr = (const f32x4*)(X + (size_t)m * D) + F.lane; f32x4 v[8]; float s = 0.f;
#pragma unroll
        for (int j = 0; j < 8; ++j) { v[j] = xr[64 * j]; s += (v[j].x * v[j].x + v[j].y * v[j].y) + (v[j].z * v[j].z + v[j].w * v[j].w); }
        const float r = 1.0f / sqrtf(wave_sum(s) * (1.f / D) + EPS);
        u32x2* o = (u32x2*)(U + (size_t)m * D) + F.lane;
#pragma unroll
        for (int j = 0; j < 8; ++j) { const f32x4 gg = ((const f32x4*)g)[F.lane + 64 * j]; o[64 * j] = (u32x2){cvtpk(v[j].x * r * gg.x, v[j].y * r * gg.y), cvtpk(v[j].z * r * gg.z, v[j].w * r * gg.w)}; }
    }
}
__device__ __forceinline__ void thin_post_norm(Frame& F, float coef, const float* gpost, const float* gpre, float* outp) {
    const int gw = F.cu * 8 + F.wave, NGW = F.G * 8;
    float* X = (float*)(F.ws + WS_X); bf16_t* U = (bf16_t*)(F.ws + WS_U); const bf16_t* Y = (const bf16_t*)(F.ws + WS_Y);
    for (int m = gw; m < M; m += NGW) {
        f32x4* xr = (f32x4*)(X + (size_t)m * D) + F.lane; const u32x2* yr = (const u32x2*)(Y + (size_t)m * D) + F.lane;
        f32x4 y[8]; float s = 0.f;
#pragma unroll
        for (int j = 0; j < 8; ++j) { const u32x2 w = yr[64 * j]; y[j] = (f32x4){bflo(w.x), bfhi(w.x), bflo(w.y), bfhi(w.y)}; s += (y[j].x * y[j].x + y[j].y * y[j].y) + (y[j].z * y[j].z + y[j].w * y[j].w); }
        const float r = coef / sqrtf(wave_sum(s) * (1.f / D) + EPS);
        float s2 = 0.f;
#pragma unroll
        for (int j = 0; j < 8; ++j) { const f32x4 gg = ((const f32x4*)gpost)[F.lane + 64 * j]; f32x4 x = xr[64 * j];
            x.x += y[j].x * r * gg.x; x.y += y[j].y * r * gg.y; x.z += y[j].z * r * gg.z; x.w += y[j].w * r * gg.w; y[j] = x;
            s2 += (x.x * x.x + x.y * x.y) + (x.z * x.z + x.w * x.w);
            if (outp) ((f32x4*)(outp + (size_t)m * D))[F.lane + 64 * j] = x; else xr[64 * j] = x; }
        if (gpre) {
            const float r2 = 1.0f / sqrtf(wave_sum(s2) * (1.f / D) + EPS);
            u32x2* o = (u32x2*)(U + (size_t)m * D) + F.lane;
#pragma unroll
            for (int j = 0; j < 8; ++j) { const f32x4 gg = ((const f32x4*)gpre)[F.lane + 64 * j]; o[64 * j] = (u32x2){cvtpk(y[j].x * r2 * gg.x, y[j].y * r2 * gg.y), cvtpk(y[j].z * r2 * gg.z, y[j].w * r2 * gg.w)}; }
        }
    }
}
__device__ __forceinline__ void thin_mix(Frame& F, const float* gq, const float* gkv) {
    const int gw = F.cu * 8 + F.wave, NGW = F.G * 8;
    const bf16_t* Z = (const bf16_t*)(F.ws + WS_Z); bf16_t* C = (bf16_t*)(F.ws + WS_CQKV); bf16_t* KPE = (bf16_t*)(F.ws + WS_KPE); const f32x2* rope = (const f32x2*)(F.ws + WS_ROPE);
    for (int m = gw; m < M; m += NGW) {
        const bf16_t* zr = Z + (size_t)m * DINP;
#pragma unroll
        for (int part = 0; part < 2; ++part) {
            const u32x4 w = *((const u32x4*)(zr + part * 512) + F.lane);
            float v[8] = {bflo(w.x), bfhi(w.x), bflo(w.y), bfhi(w.y), bflo(w.z), bfhi(w.z), bflo(w.w), bfhi(w.w)}; float s = 0.f;
#pragma unroll
            for (int e = 0; e < 8; ++e) s += v[e] * v[e];
            const float r = 1.0f / sqrtf(wave_sum(s) * (1.f / 512.f) + EPS);
            const float* g = (part ? gkv : gq) + 8 * F.lane; const f32x4 g0 = *(const f32x4*)g, g1 = *(const f32x4*)(g + 4);
            u32x4 o; o.x = cvtpk(v[0] * r * g0.x, v[1] * r * g0.y); o.y = cvtpk(v[2] * r * g0.z, v[3] * r * g0.w); o.z = cvtpk(v[4] * r * g1.x, v[5] * r * g1.y); o.w = cvtpk(v[6] * r * g1.z, v[7] * r * g1.w);
            *((u32x4*)(C + (size_t)m * 1024 + part * 512) + F.lane) = o;
        }
        if (F.lane < 32) {
            const float x1 = bf1(zr[ZO_KR + F.lane]), x2 = bf1(zr[ZO_KR + 32 + F.lane]); const f32x2 cs = rope[(size_t)m * 32 + F.lane];
            const unsigned a = cvtpk(x1 * cs.x - x2 * cs.y, x1 * cs.y + x2 * cs.x);
            KPE[(size_t)m * 64 + F.lane] = (bf16_t)(a & 0xffffu); KPE[(size_t)m * 64 + 32 + F.lane] = (bf16_t)(a >> 16);
        }
    }
}
__device__ __forceinline__ void cmp_stage2_unit(Frame& F, int unit, int l) {
    const int kv = unit >> 6, u = unit & 63, g = u >> 5, r0 = (u & 31) * 16;
    const int NO = kv ? 128 : 192;
    const float* part = (const float*)(F.ws + WS_PART); const float* pb = (const float*)(F.ws + WS_TBL + 8192) + (l * 2 + kv) * 256;
    const float* w2 = F.in[kv ? I_W2V : I_W2K] + (size_t)l * 256 * NO;
    LAS float* hid = (LAS float*)F.lds;
    __syncthreads();
    {
        const int row = F.tid >> 5, c0 = (F.tid & 31) * 8, rp = r0 + row, rt = rp >> 8, rr = rp & 255;
        f32x4 s0 = *(const f32x4*)(pb + c0), s1 = *(const f32x4*)(pb + c0 + 4);
#pragma unroll
        for (int s = 0; s < 8; ++s) { const float* p = part + (size_t)((((kv * 2 + g) * 2 + rt) * 8) + s) * 65536 + (size_t)rr * 256 + c0; s0 += *(const f32x4*)p; s1 += *(const f32x4*)(p + 4); }
        float h[8] = {s0.x, s0.y, s0.z, s0.w, s1.x, s1.y, s1.z, s1.w};
#pragma unroll
        for (int e = 0; e < 8; ++e) hid[row * 256 + c0 + e] = h[e] * sigmoidf_(h[e]);
    }
    __syncthreads();
    bf16_t* dst = (bf16_t*)(F.ws + WS_KC + (kv ? 524288 : 0));
    for (int o = F.tid; o < 16 * NO; o += 512) {
        const int row = o / NO, n = o % NO; float a = 0.f;
#pragma unroll 8
        for (int c = 0; c < 256; ++c) a += hid[row * 256 + c] * w2[c * NO + n];
        const int rp = r0 + row, b = rp >> 7, nn = rp & 127;
        dst[(size_t)((b * 2 + g) * 128 + nn) * NO + n] = (bf16_t)(cvtpk(a, 0.f) & 0xffffu);
    }
}

template <bool ROPE>
__device__ __forceinline__ void load_q(Frame& F, const bf16_t* qp, float scale, LAS float* qs, const f32x2* rope_row) {
    if (F.lane < 24) { const u32x4 w = *((const u32x4*)qp + F.lane); LAS float* d = qs + 8 * F.lane;
        d[0] = bflo(w.x) * scale; d[1] = bfhi(w.x) * scale; d[2] = bflo(w.y) * scale; d[3] = bfhi(w.y) * scale; d[4] = bflo(w.z) * scale; d[5] = bfhi(w.z) * scale; d[6] = bflo(w.w) * scale; d[7] = bfhi(w.w) * scale; }
    if (ROPE) { if (F.lane < 32) { const float x1 = qs[128 + F.lane], x2 = qs[160 + F.lane]; const f32x2 cs = rope_row[F.lane]; qs[128 + F.lane] = x1 * cs.x - x2 * cs.y; qs[160 + F.lane] = x1 * cs.y + x2 * cs.x; } }
}
__device__ __forceinline__ float dot8(const u32x4 w, const LAS float* q) {
    const f32x4 a = *(const LAS f32x4*)q, b = *(const LAS f32x4*)(q + 4);
    return (bflo(w.x) * a.x + bfhi(w.x) * a.y) + (bflo(w.y) * a.z + bfhi(w.y) * a.w) + (bflo(w.z) * b.x + bfhi(w.z) * b.y) + (bflo(w.w) * b.z + bfhi(w.w) * b.w);
}
template <int MODE>
__device__ __forceinline__ void naive_row(Frame& F, int b, int t, int head, float gate, float& o0, float& o1, LAS float* sc, const LAS float* qs, unsigned selmask, int& nk_out) {
    const int g = head >> 2; const size_t mb = (size_t)b * SEQ;
    const bf16_t* Z = (const bf16_t*)(F.ws + WS_Z); const bf16_t* KV = (const bf16_t*)(F.ws + WS_KV); const bf16_t* KPE = (const bf16_t*)(F.ws + WS_KPE);
    const bf16_t* KC = (const bf16_t*)(F.ws + WS_KC); const bf16_t* VC = (const bf16_t*)(F.ws + WS_KC + 524288);
    const float* tbl = (const float*)(F.ws + WS_TBL) + head * 132; const int* pos = (const int*)F.in[I_POS] + mb;
    const int k0 = (MODE == 2) ? (t > 511 ? t - 511 : 0) : 0;
    const int k1 = (MODE == 3) ? (t < 31 ? -1 : (t - 31) / 16) : t;
    nk_out = k1 - k0 + 1;
    if (k1 < k0) return;
    const int qpos = (MODE != 0) ? pos[t] : 0;
    float mx = -INFINITY;
    for (int kb = k0; kb <= k1; kb += 64) {
        const int k = kb + F.lane; bool valid = k <= k1;
        if (MODE == 1) valid = valid && ((selmask >> (k >> 6)) & 1u);
        float s = -INFINITY;
        if (valid) {
            const bf16_t* p1; const bf16_t* p2;
            if (MODE == 0) { p1 = KV + (mb + k) * 2048 + head * 128; p2 = KPE + (mb + k) * 64; }
            else if (MODE == 1) { p1 = Z + (mb + k) * DINP + ZO_KS + g * 192; p2 = p1 + 128; }
            else if (MODE == 2) { p1 = Z + (mb + k) * DINP + ZO_KW + g * 192; p2 = p1 + 128; }
            else { p1 = KC + (size_t)((b * 2 + g) * 128 + k) * 192; p2 = p1 + 128; }
            float d = 0.f;
#pragma unroll
            for (int c = 0; c < 16; ++c) d += dot8(*((const u32x4*)p1 + c), qs + 8 * c);
#pragma unroll
            for (int c = 0; c < 8; ++c) d += dot8(*((const u32x4*)p2 + c), qs + 128 + 8 * c);
            if (MODE != 0) { const int kp = (MODE == 3) ? pos[16 * k + 31] : pos[k]; int dd = qpos - kp; dd = dd < 0 ? 0 : (dd > 128 ? 128 : dd); d += tbl[dd]; }
            s = d;
        }
        if (k <= k1) sc[k - k0] = s;
        mx = fmaxf(mx, s);
    }
    mx = wave_max(mx);
    float sum = 0.f;
    for (int kb = k0; kb <= k1; kb += 64) { const int k = kb + F.lane; if (k <= k1) { const float p = __expf(sc[k - k0] - mx); sc[k - k0] = p; sum += p; } }
    sum = wave_sum(sum);
    const float inv = 1.0f / sum;
    float a0 = 0.f, a1 = 0.f;
    for (int k = k0; k <= k1; ++k) {
        if (MODE == 1) { if (!((selmask >> (k >> 6)) & 1u)) { k |= 63; continue; } }
        const float p = sc[k - k0];
        const bf16_t* vp;
        if (MODE == 0) vp = KV + (mb + k) * 2048 + 1024 + head * 128;
        else if (MODE == 1) vp = Z + (mb + k) * DINP + ZO_VS + g * 128;
        else if (MODE == 2) vp = Z + (mb + k) * DINP + ZO_VW + g * 128;
        else vp = VC + (size_t)((b * 2 + g) * 128 + k) * 128;
        const unsigned w = *((const unsigned*)vp + F.lane);
        a0 += p * bflo(w); a1 += p * bfhi(w);
    }
    o0 += gate * inv * a0; o1 += gate * inv * a1;
    if (MODE == 3) { for (int kb = 0; kb <= k1; kb += 64) { const int k = kb + F.lane; if (k <= k1) sc[k] *= inv; } }
}
__device__ __forceinline__ void naive_cmp_phase(Frame& F) {
    const int gw = F.cu * 8 + F.wave, NGW = F.G * 8;
    LAS float* sc = (LAS float*)(F.lds + F.wave * 8192); LAS float* qs = (LAS float*)(F.lds + 65536 + F.wave * 1024); LAS float* ps = (LAS float*)(F.lds + 65536 + 8192 + F.wave * 512);
    const bf16_t* Z = (const bf16_t*)(F.ws + WS_Z); float* OC = (float*)(F.ws + WS_OC); unsigned* SEL = (unsigned*)(F.ws + WS_SEL);
    for (int r = gw; r < M * 2; r += NGW) {
        const int g = r & 1, m = r >> 1, b = m / SEQ, t = m % SEQ;
        ps[F.lane] = 0.f; ps[F.lane + 64] = 0.f;
        for (int j = 0; j < 4; ++j) {
            const int head = g * 4 + j; int nk = 0;
            load_q<false>(F, Z + (size_t)m * DINP + ZO_NQ + head * 192, 0.07216878364870322f, qs, nullptr);
            float o0 = 0.f, o1 = 0.f;
            const float g0 = sigmoidf_(bf1(Z[(size_t)m * DINP + ZO_NG + head * 3 + 0]));
            naive_row<3>(F, b, t, head, g0, o0, o1, sc, qs, 0u, nk);
            *(f32x2*)(OC + (size_t)m * 1024 + head * 128 + 2 * F.lane) = (f32x2){o0, o1};
            if (F.lane < nk) ps[F.lane] += sc[F.lane];
            if (F.lane + 64 < nk) ps[F.lane + 64] += sc[F.lane + 64];
        }
        const int mm = F.lane & 31; float imp = 0.f;
#pragma unroll
        for (int n = -1; n < 4; ++n) { const int nn = 4 * mm + n; if (nn >= 0 && nn < 128) imp += ps[nn]; }
        const int cur = t >> 6; const bool valid = mm <= cur, forced = valid && (mm == 0 || mm >= cur - 1);
        const float scv = forced ? 1e6f : (valid ? imp : -1.0f);
        int rank = 0;
#pragma unroll
        for (int o = 0; o < 32; ++o) { const float v = __shfl(scv, o); rank += (v > scv || (v == scv && o < mm)) ? 1 : 0; }
        const bool sel = (rank < 16) && (scv >= 0.f) && (F.lane < 32);
        const unsigned long long bal = __ballot(sel);
        if (F.lane == 0) SEL[(size_t)(b * 2 + g) * SEQ + t] = (unsigned)bal;
    }
}
__device__ __forceinline__ void naive_attn_phase(Frame& F) {
    const int gw = F.cu * 8 + F.wave, NGW = F.G * 8;
    LAS float* sc = (LAS float*)(F.lds + F.wave * 8192); LAS float* qs = (LAS float*)(F.lds + 65536 + F.wave * 1024);
    const bf16_t* Z = (const bf16_t*)(F.ws + WS_Z); const bf16_t* QM = (const bf16_t*)(F.ws + WS_QM); bf16_t* AB = (bf16_t*)(F.ws + WS_AB);
    const float* OC = (const float*)(F.ws + WS_OC); const unsigned* SEL = (const unsigned*)(F.ws + WS_SEL); const f32x2* rope = (const f32x2*)(F.ws + WS_ROPE);
    for (int r = gw; r < M * 8; r += NGW) {
        const int head = r & 7, m = r >> 3, b = m / SEQ, t = m % SEQ; int nk;
        load_q<true>(F, QM + (size_t)m * 1536 + head * 192, 0.07216878364870322f, qs, rope + (size_t)m * 32);
        float o0 = 0.f, o1 = 0.f;
        naive_row<0>(F, b, t, head, 1.0f, o0, o1, sc, qs, 0u, nk);
        *((unsigned*)(AB + (size_t)m * 2048 + head * 128) + F.lane) = cvtpk(o0, o1);
    }
    for (int r = gw; r < M * 8; r += NGW) {
        const int head = r & 7, m = r >> 3, b = m / SEQ, t = m % SEQ, g = head >> 2; int nk;
        const unsigned selmask = (unsigned)__builtin_amdgcn_readfirstlane((int)SEL[(size_t)(b * 2 + g) * SEQ + t]);
        load_q<false>(F, Z + (size_t)m * DINP + ZO_NQ + head * 192, 0.07216878364870322f, qs, nullptr);
        const float g1 = sigmoidf_(bf1(Z[(size_t)m * DINP + ZO_NG + head * 3 + 1])), g2 = sigmoidf_(bf1(Z[(size_t)m * DINP + ZO_NG + head * 3 + 2]));
        const f32x2 oc = *(const f32x2*)(OC + (size_t)m * 1024 + head * 128 + 2 * F.lane);
        float o0 = oc.x, o1 = oc.y;
        naive_row<1>(F, b, t, head, g1, o0, o1, sc, qs, selmask, nk);
        naive_row<2>(F, b, t, head, g2, o0, o1, sc, qs, 0u, nk);
        *((unsigned*)(AB + (size_t)m * 2048 + 1024 + head * 128) + F.lane) = cvtpk(o0, o1);
    }
}

namespace att {
typedef float f32x16 __attribute__((ext_vector_type(16)));
typedef short s16x4 __attribute__((ext_vector_type(4)));
typedef int i32x4 __attribute__((ext_vector_type(4)));
constexpr int KROW = 400, KBUF = 64 * KROW, VBUF = 64 * 256;
constexpr int L_K = 0, L_V = 2 * KBUF, L_KPOS = L_V + 2 * VBUF, L_KPMAX = L_KPOS + 512, L_TBL = L_KPMAX + 64, L_MISC = L_TBL + 8 * 132 * 4;
static_assert(L_MISC + 256 <= RING_BYTES, "attention LDS map");
constexpr float SL = 0.07216878364870322f * 1.4426950408889634f;
__device__ const unsigned char CLS_TYPE[40] = {1,1,1,1,1,1,1,1,1,0,1,1,1,1,0,1,1,1,1,0,1,1,1,1,0,1,1,1,0,1,1,0,1,1,0,1,1,0,1,1};
__device__ const unsigned char CLS_QB[40] = {31,30,29,28,27,26,25,24,23,7,22,21,20,19,6,18,17,16,15,5,14,13,12,11,4,10,9,8,3,7,6,2,5,4,1,3,2,0,1,0};
__device__ const unsigned short CLS_START[41] = {0,8,16,24,32,40,48,56,64,72,104,112,120,128,136,168,176,184,192,200,232,240,248,256,264,296,304,312,320,352,360,368,400,408,416,448,456,464,496,504,512};
__device__ __forceinline__ unsigned offb(unsigned row, unsigned ch) { return 256u * row + 16u * (ch ^ (((row & 3u) << 2) | ((row >> 2) & 3u))); }
struct Src { const bf16_t* k1; const bf16_t* k2; const bf16_t* v; int ldk1, ldk2, ldv; };
struct Stage { u32x4 k[3]; u32x4 v[2]; int kp; };
template <bool SAMELD = true>
__device__ __forceinline__ void stage_load(Stage& st, const Src& s, int tile, int tid, const int* posb) {
    const unsigned vo1 = (unsigned)((tid >> 4) * s.ldk1 + (tid & 15) * 8) * 2u, vo2 = (unsigned)((tid >> 3) * s.ldk2 + (tid & 7) * 8) * 2u;
    const char* b1 = (const char*)s.k1 + (size_t)tile * 64 * s.ldk1 * 2; const char* b2 = (const char*)s.k2 + (size_t)tile * 64 * s.ldk2 * 2; const char* bv = (const char*)s.v + (size_t)tile * 64 * s.ldv * 2;
    st.k[0] = *(const u32x4*)(b1 + vo1); st.k[1] = *(const u32x4*)(b1 + (size_t)32 * s.ldk1 * 2 + vo1); st.k[2] = *(const u32x4*)(b2 + vo2);
    const unsigned vov = SAMELD ? vo1 : (unsigned)((tid >> 4) * s.ldv + (tid & 15) * 8) * 2u;
    st.v[0] = *(const u32x4*)(bv + vov); st.v[1] = *(const u32x4*)(bv + (size_t)32 * s.ldv * 2 + vov);
    if (posb != nullptr && tid < 64) st.kp = posb[tile * 64 + tid];
}
__device__ __forceinline__ void stage_store(const Stage& st, LAS unsigned char* lds, int buf, int tid, bool haspos) {
    const int rowA = tid >> 4, chA = tid & 15;
    LAS unsigned char* ka = lds + L_K + buf * KBUF + rowA * KROW + chA * 16;
    *(LAS u32x4*)ka = st.k[0]; *(LAS u32x4*)(ka + 32 * KROW) = st.k[1];
    *(LAS u32x4*)(lds + L_K + buf * KBUF + (tid >> 3) * KROW + (16 + (tid & 7)) * 16) = st.k[2];
    LAS unsigned char* va = lds + L_V + buf * VBUF + offb(rowA, chA);
    *(LAS u32x4*)va = st.v[0]; *(LAS u32x4*)(va + 8192) = st.v[1];
    if (haspos && tid < 64) { ((LAS int*)(lds + L_KPOS))[buf * 64 + tid] = st.kp; int mx = st.kp;
#pragma unroll
        for (int o = 1; o < 64; o <<= 1) { const int t = __shfl_xor(mx, o); mx = t > mx ? t : mx; }
        if (tid == 0) ((LAS int*)(lds + L_KPMAX))[buf] = mx; }
}
__device__ __forceinline__ s16x4 vtr(const LAS unsigned char* p) { typedef short v4i16_t __attribute__((ext_vector_type(4))); return __builtin_bit_cast(s16x4, __builtin_amdgcn_ds_read_tr16_b64_v4i16((LAS v4i16_t*)p)); }

__device__ __forceinline__ unsigned vtr_off(int lane_, int c, int tp) {
    const unsigned q4 = (lane_ & 15) >> 2, p = lane_ & 3, blk = (lane_ >> 4) & 1, h2 = lane_ >> 5;
    return 256u * (8u * tp + 4u * h2 + q4) + 16u * ((((unsigned)c ^ q4) << 2) | ((2u * blk + (p >> 1)) ^ (2u * tp + h2))) + 8u * (p & 1u);
}
#define ATT_ZERO16 {0.f,0.f,0.f,0.f,0.f,0.f,0.f,0.f,0.f,0.f,0.f,0.f,0.f,0.f,0.f,0.f}
template <int MODE>
__device__ __forceinline__ void run_pass(Frame& F, const Src& src, unsigned tmask, const bf16x8 (&qf)[12], f32x16 (&oacc)[4], float& m_run, float& l_run,
                                         int tq, int tq_wmin, int tq_wmax, unsigned selq, int qpos, int qpos_wmin, int head, const int* posb) {
    if (tmask == 0u) return;
    const int tid = F.tid, lane = F.lane, r = lane & 31, hh = lane >> 5;
    LAS unsigned char* lds = F.lds;
    int tile = __builtin_ctz(tmask); unsigned rem = tmask & (tmask - 1u);
    Stage st; st.kp = 0;
    stage_load(st, src, tile, tid, posb); stage_store(st, lds, 0, tid, posb != nullptr); __syncthreads();
    int buf = 0;
    const LAS float* tblh = (const LAS float*)(lds + L_TBL) + head * 132;
    for (;;) {
        const int nxt = rem ? __builtin_ctz(rem) : -1;
        if (nxt >= 0) stage_load(st, src, nxt, tid, posb);
        const bool active = (MODE != 0) || (tile * 64 <= tq_wmax);
        if (active) {
            const LAS unsigned char* kb_ = lds + L_K + buf * KBUF + r * KROW + 16 * hh;
            const LAS unsigned char* vbuf = lds + L_V + buf * VBUF;
            bool far = true; if (MODE != 0) { const int kpmax = __builtin_amdgcn_readfirstlane(((const LAS int*)(lds + L_KPMAX))[buf]); far = (qpos_wmin - kpmax >= 128); }
            int lim = tq - tile * 64 - 4 * hh;
            if (MODE == 1) { if (!((selq >> tile) & 1u)) lim = -1; }
            const bool need = (MODE == 1) || (MODE == 2) || (tile * 64 + 63 > tq_wmin);
#pragma unroll
            for (int kb = 0; kb < 2; ++kb) {
                f32x16 sa = ATT_ZERO16;
#pragma unroll
                for (int s = 0; s < 12; ++s) { const bf16x8 a0 = *(const LAS bf16x8*)(kb_ + kb * 32 * KROW + 32 * s); sa = __builtin_amdgcn_mfma_f32_32x32x16_bf16(a0, qf[s], sa, 0, 0, 0); }
                float x[16];
                if (MODE == 0) {
#pragma unroll
                    for (int i = 0; i < 16; ++i) x[i] = sa[i] * SL;
                } else if (far) { const float cb = tblh[128];
#pragma unroll
                    for (int i = 0; i < 16; ++i) x[i] = sa[i] * SL + cb;
                } else {
                    const LAS int* kp = (const LAS int*)(lds + L_KPOS) + buf * 64 + 4 * hh + 32 * kb;
#pragma unroll
                    for (int g4 = 0; g4 < 4; ++g4) { const i32x4 kv = *(const LAS i32x4*)(kp + 8 * g4);
#pragma unroll
                        for (int e = 0; e < 4; ++e) { int d = qpos - kv[e]; d = d < 0 ? 0 : (d > 128 ? 128 : d); x[4 * g4 + e] = sa[4 * g4 + e] * SL + tblh[d]; } }
                }
                if (need) {
#pragma unroll
                    for (int i = 0; i < 16; ++i) { const int ci = 32 * kb + 8 * (i >> 2) + (i & 3); if (ci > lim) x[i] = -INFINITY; if (MODE == 2) { if (ci <= lim - 512) x[i] = -INFINITY; } }
                }
                float ml = x[0];
#pragma unroll
                for (int i = 1; i < 16; ++i) ml = fmaxf(ml, x[i]);
                ml = fmaxf(ml, __shfl_xor(ml, 32));
                const float mnew = fmaxf(m_run, ml), alpha = __builtin_amdgcn_exp2f(m_run - mnew);
                m_run = mnew;
                float ps = 0.f;
#pragma unroll
                for (int i = 0; i < 16; ++i) { x[i] = __builtin_amdgcn_exp2f(x[i] - mnew); ps += x[i]; }
                l_run = l_run * alpha + ps;
                if (!__all(alpha == 1.0f)) {
#pragma unroll
                    for (int c = 0; c < 4; ++c) oacc[c] = oacc[c] * alpha;
                }
                bf16x8 pf[2];
#pragma unroll
                for (int k2 = 0; k2 < 2; ++k2) { u32x4 w; w.x = cvtpk(x[8 * k2 + 0], x[8 * k2 + 1]); w.y = cvtpk(x[8 * k2 + 2], x[8 * k2 + 3]); w.z = cvtpk(x[8 * k2 + 4], x[8 * k2 + 5]); w.w = cvtpk(x[8 * k2 + 6], x[8 * k2 + 7]); pf[k2] = __builtin_bit_cast(bf16x8, w); }
#pragma unroll
                for (int c = 0; c < 4; ++c) { int lane_ = lane; asm volatile("" : "+v"(lane_)); const unsigned v0 = vtr_off(lane_, c, 0), v1 = vtr_off(lane_, c, 1);
#pragma unroll
                    for (int k2 = 0; k2 < 2; ++k2) { const int ks = 2 * kb + k2; const s16x4 lo = vtr(vbuf + v0 + ks * 4096), hi = vtr(vbuf + v1 + ks * 4096);
                        const bf16x8 a = {lo[0], lo[1], lo[2], lo[3], hi[0], hi[1], hi[2], hi[3]};
                        oacc[c] = __builtin_amdgcn_mfma_f32_32x32x16_bf16(a, pf[k2], oacc[c], 0, 0, 0); } }
            }
        }
        if (nxt >= 0) stage_store(st, lds, buf ^ 1, tid, posb != nullptr);
        __syncthreads();
        if (nxt < 0) break;
        tile = nxt; rem &= rem - 1u; buf ^= 1;
    }
}
template <bool ROPE>
__device__ __forceinline__ void load_qfrags(bf16x8 (&qf)[12], const bf16_t* qrow, int hh, const f32x2* rope_row) {
#pragma unroll
    for (int s = 0; s < 12; ++s) qf[s] = *(const bf16x8*)(qrow + 16 * s + 8 * hh);
    if (ROPE) {
#pragma unroll
        for (int pr = 0; pr < 2; ++pr) {
            const int i0 = 16 * pr + 8 * hh; bf16x8 a = qf[8 + pr], b = qf[10 + pr];
#pragma unroll
            for (int j = 0; j < 8; ++j) { const f32x2 cs = rope_row[i0 + j]; const float x1 = bf1((bf16_t)a[j]), x2 = bf1((bf16_t)b[j]);
                const unsigned w = cvtpk(x1 * cs.x - x2 * cs.y, x1 * cs.y + x2 * cs.x); a[j] = (short)(w & 0xffffu); b[j] = (short)(w >> 16); }
            qf[8 + pr] = a; qf[10 + pr] = b;
        }
    }
}
__device__ __forceinline__ void mla_unit(Frame& F, int b, int h, int qb) {
    const int lane = F.lane, r = lane & 31, hh = lane >> 5, w = F.wave;
    const int t0 = 256 * qb, tq = t0 + 32 * w + r; const size_t m = (size_t)b * SEQ + tq;
    const bf16_t* KV = (const bf16_t*)(F.ws + WS_KV);
    Src src{KV + (size_t)b * SEQ * 2048 + h * 128, (const bf16_t*)(F.ws + WS_KPE) + (size_t)b * SEQ * 64, KV + (size_t)b * SEQ * 2048 + 1024 + h * 128, 2048, 64, 2048};
    bf16x8 qf[12]; load_qfrags<true>(qf, (const bf16_t*)(F.ws + WS_QM) + m * 1536 + h * 192, hh, (const f32x2*)(F.ws + WS_ROPE) + m * 32);
    f32x16 oacc[4] = {ATT_ZERO16, ATT_ZERO16, ATT_ZERO16, ATT_ZERO16}; float m_run = -1e30f, l_run = 0.f;
    const unsigned tmask = (qb == 7) ? 0xffffffffu : ((1u << (4 * qb + 4)) - 1u);
    run_pass<0>(F, src, tmask, qf, oacc, m_run, l_run, tq, t0 + 32 * w, t0 + 32 * w + 31, 0u, 0, 0, h, nullptr);
    const float inv = 1.0f / (l_run + __shfl_xor(l_run, 32));
    bf16_t* o = (bf16_t*)(F.ws + WS_AB) + m * 2048 + h * 128 + 4 * hh;
#pragma unroll
    for (int c = 0; c < 4; ++c)
#pragma unroll
        for (int g4 = 0; g4 < 4; ++g4) *(u32x2*)(o + 32 * c + 8 * g4) = (u32x2){cvtpk(oacc[c][4 * g4] * inv, oacc[c][4 * g4 + 1] * inv), cvtpk(oacc[c][4 * g4 + 2] * inv, oacc[c][4 * g4 + 3] * inv)};
}
__device__ __forceinline__ void nsa_unit(Frame& F, int b, int g, int qb) {
    const int lane = F.lane, r = lane & 31, hh = lane >> 5, w = F.wave, head = 4 * g + (w >> 1);
    const int t0 = 64 * qb, tq = t0 + 32 * (w & 1) + r; const size_t m = (size_t)b * SEQ + tq;
    const bf16_t* Zb = (const bf16_t*)(F.ws + WS_Z) + (size_t)b * SEQ * DINP; const bf16_t* zr = (const bf16_t*)(F.ws + WS_Z) + m * DINP;
    const unsigned* SELb = (const unsigned*)(F.ws + WS_SEL) + (size_t)(b * 2 + g) * SEQ; const int* posb = (const int*)F.in[I_POS] + (size_t)b * SEQ;
    LAS unsigned* misc = (LAS unsigned*)(F.lds + L_MISC);
    if (w == 0) { unsigned v = SELb[t0 + lane];
#pragma unroll
        for (int o = 1; o < 64; o <<= 1) v |= (unsigned)__shfl_xor((int)v, o);
        if (lane == 0) misc[4] = v; }
    const unsigned selq = SELb[tq]; const int qpos = posb[tq]; int qmin = qpos;
#pragma unroll
    for (int o = 1; o < 64; o <<= 1) { const int t = __shfl_xor(qmin, o); qmin = t < qmin ? t : qmin; }
    qmin = __builtin_amdgcn_readfirstlane(qmin);
    bf16x8 qf[12]; load_qfrags<false>(qf, zr + ZO_NQ + head * 192, hh, nullptr);
    __syncthreads();
    const unsigned causal = (qb == 31) ? 0xffffffffu : ((2u << qb) - 1u);
    const unsigned umask = (unsigned)__builtin_amdgcn_readfirstlane((int)misc[4]) & causal;
    const int wlo = qb > 8 ? qb - 8 : 0; const unsigned wmask = causal & ~((1u << wlo) - 1u);
    f32x16 oacc[4] = {ATT_ZERO16, ATT_ZERO16, ATT_ZERO16, ATT_ZERO16}; float m_run = -1e30f, l_run = 0.f;
    {
        Src src{Zb + ZO_KS + g * 192, Zb + ZO_KS + g * 192 + 128, Zb + ZO_VS + g * 128, DINP, DINP, DINP};
        run_pass<1>(F, src, umask, qf, oacc, m_run, l_run, tq, t0 + 32 * (w & 1), t0 + 32 * (w & 1) + 31, selq, qpos, qmin, head, posb);
        asm volatile("" ::: "memory");
        const size_t m1 = (size_t)b * SEQ + t0 + 32 * (w & 1) + (F.lane & 31);
        const float g1 = sigmoidf_(bf1(((const bf16_t*)(F.ws + WS_Z))[m1 * DINP + ZO_NG + head * 3 + 1]));
        bf16_t* o = (bf16_t*)(F.ws + WS_AB) + m1 * 2048 + 1024 + head * 128 + 4 * (F.lane >> 5); const float* oc = (const float*)(F.ws + WS_OC) + m1 * 1024 + head * 128 + 4 * (F.lane >> 5);
        const float inv = g1 / (l_run + __shfl_xor(l_run, 32));
#pragma unroll
        for (int c = 0; c < 4; ++c)
#pragma unroll
            for (int g4 = 0; g4 < 4; ++g4) { const f32x4 cv = *(const f32x4*)(oc + 32 * c + 8 * g4);
                *(u32x2*)(o + 32 * c + 8 * g4) = (u32x2){cvtpk(oacc[c][4 * g4] * inv + cv.x, oacc[c][4 * g4 + 1] * inv + cv.y), cvtpk(oacc[c][4 * g4 + 2] * inv + cv.z, oacc[c][4 * g4 + 3] * inv + cv.w)}; }
    }
#pragma unroll
    for (int c = 0; c < 4; ++c) oacc[c] = (f32x16)ATT_ZERO16;
    m_run = -1e30f; l_run = 0.f;
    {
        Src src{Zb + ZO_KW + g * 192, Zb + ZO_KW + g * 192 + 128, Zb + ZO_VW + g * 128, DINP, DINP, DINP};
        run_pass<2>(F, src, wmask, qf, oacc, m_run, l_run, tq, t0 + 32 * (w & 1), t0 + 32 * (w & 1) + 31, 0u, qpos, qmin, head, posb);
        asm volatile("" ::: "memory");
        const size_t m1 = (size_t)b * SEQ + t0 + 32 * (w & 1) + (F.lane & 31);
        const float g2 = sigmoidf_(bf1(((const bf16_t*)(F.ws + WS_Z))[m1 * DINP + ZO_NG + head * 3 + 2]));
        bf16_t* o = (bf16_t*)(F.ws + WS_AB) + m1 * 2048 + 1024 + head * 128 + 4 * (F.lane >> 5);
        const float inv = g2 / (l_run + __shfl_xor(l_run, 32));
#pragma unroll
        for (int c = 0; c < 4; ++c)
#pragma unroll
            for (int g4 = 0; g4 < 4; ++g4) { const u32x2 pv = *(const u32x2*)(o + 32 * c + 8 * g4);
                *(u32x2*)(o + 32 * c + 8 * g4) = (u32x2){cvtpk(oacc[c][4 * g4] * inv + bflo(pv.x), oacc[c][4 * g4 + 1] * inv + bfhi(pv.x)), cvtpk(oacc[c][4 * g4 + 2] * inv + bflo(pv.y), oacc[c][4 * g4 + 3] * inv + bfhi(pv.y))}; }
    }
}
__device__ __forceinline__ void cmp_unit(Frame& F, int b, int g, int qb) {
    const int tid = F.tid, lane = F.lane, r = lane & 31, hh = lane >> 5, w = F.wave;
    const int t0 = 256 * qb, tq = t0 + 32 * w + r; const size_t m = (size_t)b * SEQ + tq;
    LAS unsigned char* lds = F.lds;
    const int* posb = (const int*)F.in[I_POS] + (size_t)b * SEQ;
    {
        Src src{(const bf16_t*)(F.ws + WS_KC) + (size_t)(b * 2 + g) * 128 * 192, (const bf16_t*)(F.ws + WS_KC) + (size_t)(b * 2 + g) * 128 * 192 + 128, (const bf16_t*)(F.ws + WS_KC + 524288) + (size_t)(b * 2 + g) * 128 * 128, 192, 192, 128};
        Stage st; st.kp = 0;
        stage_load<false>(st, src, 0, tid, nullptr); stage_store(st, lds, 0, tid, false);
        stage_load<false>(st, src, 1, tid, nullptr); stage_store(st, lds, 1, tid, false);
        if (tid < 128) { int kt = 16 * tid + 31; kt = kt > SEQ - 1 ? SEQ - 1 : kt; ((LAS int*)(lds + L_KPOS))[tid] = posb[kt]; }
    }
    __syncthreads();
    const int qpos = posb[tq];
    const int nmax = tq >= 31 ? (tq - 31) >> 4 : -1;
    float imp[16];
#pragma unroll
    for (int i = 0; i < 16; ++i) imp[i] = 0.f;
    const LAS unsigned char* kb_ = lds + L_K + r * KROW + 16 * hh;
    const LAS unsigned char* vbuf = lds + L_V;
    const bf16_t* zr = (const bf16_t*)(F.ws + WS_Z) + m * DINP;
#pragma unroll 1
    for (int j = 0; j < 4; ++j) {
        const int head = 4 * g + j;
        const LAS float* tblh = (const LAS float*)(lds + L_TBL) + head * 132;
        bf16x8 qf[12]; load_qfrags<false>(qf, zr + ZO_NQ + head * 192, hh, nullptr);
        float m_run = -1e30f, l_run = 0.f;
#define CMP_SCORES(kb) \
                f32x16 sa = ATT_ZERO16; \
                _Pragma("unroll") for (int s = 0; s < 12; ++s) { const bf16x8 a0 = *(const LAS bf16x8*)(kb_ + (kb) * 32 * KROW + 32 * s); sa = __builtin_amdgcn_mfma_f32_32x32x16_bf16(a0, qf[s], sa, 0, 0, 0); } \
                float x[16]; \
                { const LAS int* kp = (const LAS int*)(lds + L_KPOS) + 4 * hh + 32 * (kb); int nm_ = nmax; asm volatile("" : "+v"(nm_)); const int lim = nm_ - 32 * (kb) - 4 * hh; \
                _Pragma("unroll") for (int g4 = 0; g4 < 4; ++g4) { const i32x4 kv = *(const LAS i32x4*)(kp + 8 * g4); \
                    _Pragma("unroll") for (int e = 0; e < 4; ++e) { int d = qpos - kv[e]; d = d < 0 ? 0 : (d > 128 ? 128 : d); const float v = sa[4 * g4 + e] * SL + tblh[d]; x[4 * g4 + e] = (8 * g4 + e > lim) ? -INFINITY : v; } } }
#pragma unroll
        for (int kb = 0; kb < 4; ++kb) {
            CMP_SCORES(kb)
            float ml = x[0];
#pragma unroll
            for (int i = 1; i < 16; ++i) ml = fmaxf(ml, x[i]);
            ml = fmaxf(ml, __shfl_xor(ml, 32));
            const float mnew = fmaxf(m_run, ml), alpha = __builtin_amdgcn_exp2f(m_run - mnew); m_run = mnew;
            float ps = 0.f;
#pragma unroll
            for (int i = 0; i < 16; ++i) ps += __builtin_amdgcn_exp2f(x[i] - mnew);
            l_run = l_run * alpha + ps;
            asm volatile("" ::: "memory");
        }
        const float lt = l_run + __shfl_xor(l_run, 32), inv = lt > 0.f ? 1.0f / lt : 0.f;
        f32x16 oacc[4] = {ATT_ZERO16, ATT_ZERO16, ATT_ZERO16, ATT_ZERO16};
        float carry = 0.f;
#pragma unroll
        for (int kb = 0; kb < 4; ++kb) {
            CMP_SCORES(kb)
#pragma unroll
            for (int i = 0; i < 16; ++i) x[i] = __builtin_amdgcn_exp2f(x[i] - m_run) * inv;
#pragma unroll
            for (int g4 = 0; g4 < 4; ++g4) { const float e3 = x[4 * g4 + 3], sw = __shfl_xor(e3, 32);
                imp[4 * kb + g4] += ((x[4 * g4] + x[4 * g4 + 1]) + (x[4 * g4 + 2] + e3)) + (hh ? sw : carry); carry = sw; }
            bf16x8 pf[2];
#pragma unroll
            for (int k2 = 0; k2 < 2; ++k2) { u32x4 wv; wv.x = cvtpk(x[8 * k2 + 0], x[8 * k2 + 1]); wv.y = cvtpk(x[8 * k2 + 2], x[8 * k2 + 3]); wv.z = cvtpk(x[8 * k2 + 4], x[8 * k2 + 5]); wv.w = cvtpk(x[8 * k2 + 6], x[8 * k2 + 7]); pf[k2] = __builtin_bit_cast(bf16x8, wv); }
#pragma unroll
            for (int c = 0; c < 4; ++c) { int lane_ = lane; asm volatile("" : "+v"(lane_)); const unsigned v0 = vtr_off(lane_, c, 0), v1 = vtr_off(lane_, c, 1);
#pragma unroll
                for (int k2 = 0; k2 < 2; ++k2) { const int ks = 2 * kb + k2; const s16x4 lo = vtr(vbuf + v0 + ks * 4096), hi = vtr(vbuf + v1 + ks * 4096);
                    const bf16x8 a = {lo[0], lo[1], lo[2], lo[3], hi[0], hi[1], hi[2], hi[3]};
                    oacc[c] = __builtin_amdgcn_mfma_f32_32x32x16_bf16(a, pf[k2], oacc[c], 0, 0, 0); } }
            asm volatile("" ::: "memory");
        }
#undef CMP_SCORES
        {
            const float g0 = sigmoidf_(bf1(zr[ZO_NG + head * 3 + 0]));
            float* oc = (float*)(F.ws + WS_OC) + m * 1024 + head * 128 + 4 * hh;
#pragma unroll
            for (int c = 0; c < 4; ++c)
#pragma unroll
                for (int g4 = 0; g4 < 4; ++g4) *(f32x4*)(oc + 32 * c + 8 * g4) = (f32x4){oacc[c][4 * g4] * g0, oacc[c][4 * g4 + 1] * g0, oacc[c][4 * g4 + 2] * g0, oacc[c][4 * g4 + 3] * g0};
        }
    }
    {
        LAS float* impl = (LAS float*)(lds + 90112);
#pragma unroll
        for (int i = 0; i < 4; ++i) *(LAS f32x4*)(impl + (w * 64 + lane) * 16 + 4 * i) = (f32x4){imp[4 * i], imp[4 * i + 1], imp[4 * i + 2], imp[4 * i + 3]};
        asm volatile("s_waitcnt lgkmcnt(0)" ::: "memory");
        int lane2 = F.tid & 63; asm volatile("" : "+v"(lane2));
        const int hh2 = lane2 >> 5;
        const int cur = (t0 + 32 * w + (lane2 & 31)) >> 6; float own[16], oth[16];
#pragma unroll
        for (int i = 0; i < 4; ++i) { const f32x4 a = *(const LAS f32x4*)(impl + (w * 64 + lane2) * 16 + 4 * i), c = *(const LAS f32x4*)(impl + (w * 64 + (lane2 ^ 32)) * 16 + 4 * i);
            own[4 * i] = a.x; own[4 * i + 1] = a.y; own[4 * i + 2] = a.z; own[4 * i + 3] = a.w; oth[4 * i] = c.x; oth[4 * i + 1] = c.y; oth[4 * i + 2] = c.z; oth[4 * i + 3] = c.w; }
#pragma unroll
        for (int i = 0; i < 16; ++i) { const int mo = 2 * i + hh2, mp = 2 * i + 1 - hh2; const bool vo = mo <= cur, fo = vo && (mo == 0 || mo >= cur - 1), vp = mp <= cur, fp = vp && (mp == 0 || mp >= cur - 1);
            own[i] = fo ? 1e6f : (vo ? own[i] : -1.0f); oth[i] = fp ? 1e6f : (vp ? oth[i] : -1.0f); }
        unsigned bits = 0u;
#pragma unroll
        for (int i = 0; i < 16; ++i) { const float v = own[i]; int rank = 0;
#pragma unroll
            for (int k = 0; k < 16; ++k) {
                if (k < i) rank += (own[k] >= v) ? 1 : 0; else if (k > i) rank += (own[k] > v) ? 1 : 0;
                if (k < i) rank += (oth[k] >= v) ? 1 : 0; else if (k > i) rank += (oth[k] > v) ? 1 : 0; else rank += hh2 ? ((oth[k] >= v) ? 1 : 0) : ((oth[k] > v) ? 1 : 0);
                asm volatile("" : "+v"(rank)); }
            if (rank < 16 && v >= 0.f) bits |= 1u << (2 * i + hh2); }
        bits |= (unsigned)__shfl_xor((int)bits, 32);
        if (hh2 == 0) ((unsigned*)(F.ws + WS_SEL))[(size_t)(b * 2 + g) * SEQ + t0 + 32 * w + (lane2 & 31)] = bits;
    }
    __syncthreads();
}
__device__ __forceinline__ void cmp_phase(Frame& F) {
    LAS float* tblL = (LAS float*)(F.lds + L_TBL); const float* tg = (const float*)(F.ws + WS_TBL + 16384);
    for (int i = F.tid; i < 8 * 132; i += 512) tblL[i] = tg[i];
    __syncthreads();
    for (int u = F.cu; u < 64; u += F.G) cmp_unit(F, u >> 4, (u >> 3) & 1, u & 7);
}
constexpr int CW_QUEUE = 8192;
__device__ __forceinline__ void attn_phase(Frame& F, int l, int qoff = 0) {
    LAS float* tblL = (LAS float*)(F.lds + L_TBL); const float* tg = (const float*)(F.ws + WS_TBL + 16384);
    for (int i = F.tid; i < 8 * 132; i += 512) tblL[i] = tg[i];
    LAS unsigned* misc = (LAS unsigned*)(F.lds + L_MISC);
    unsigned* qctr = (unsigned*)(F.ws + WS_CTL) + CW_QUEUE + 64 * l + qoff;
    __syncthreads();
    for (;;) {
        launder(F);
        if (F.tid == 0) misc[0] = __hip_atomic_fetch_add(qctr, 1u, __ATOMIC_RELAXED, __HIP_MEMORY_SCOPE_AGENT);
        __syncthreads();
        const int u = __builtin_amdgcn_readfirstlane((int)misc[0]);
        __syncthreads();
        if (u >= 256) break;
        mla_unit(F, (u & 31) >> 3, u & 7, 7 - (u >> 5));
    }
    for (;;) {
        launder(F);
        if (F.tid == 0) misc[0] = __hip_atomic_fetch_add(qctr + 16, 1u, __ATOMIC_RELAXED, __HIP_MEMORY_SCOPE_AGENT);
        __syncthreads();
        const int u = __builtin_amdgcn_readfirstlane((int)misc[0]);
        __syncthreads();
        if (u >= 256) break;
        nsa_unit(F, (u & 7) >> 1, u & 1, 31 - (u >> 3));
    }
}
}

struct SchedCmp {
    const char* Zb; const char* Wb; int c0, c, kv;
    __device__ bool next(int i, Unit& u) const {
        const int j = c - c0; if (i != 0 || j < 0 || j >= 32) return false;
        const int g = j >> 4, rt = (j >> 3) & 1, s = j & 7;
        u.a = Zb + ((size_t)(kv ? ZO_VC + 128 * g : ZO_KC + 192 * g) + (size_t)rt * 256 * 16 * DINP + (size_t)s * 4 * DINP) * 2;
        u.b = Wb + (size_t)s * (kv ? 8 : 12) * 64 * 2; u.pm = 0; u.pn = 0; u.aux = kv * 32 + j; return true;
    }
};
struct SchedQKV {
    const char* C; const char* WQ; const char* WUKV; int G, c;
    __device__ bool next(int i, Unit& u) const {
        int j = i * G + c; if (j >= 448) return false;
        if (j < 192) { u.aux = 0; u.pn = j / 32; u.pm = j % 32; u.a = C + (size_t)u.pm * 256 * 1024 * 2; u.b = WQ + (size_t)u.pn * 256 * 512 * 2; }
        else { j -= 192; u.aux = 1; u.pn = j / 32; u.pm = j % 32; u.a = C + ((size_t)u.pm * 256 * 1024 + 512) * 2; u.b = WUKV + (size_t)u.pn * 256 * 512 * 2; }
        return true;
    }
};
struct SchedMerge {
    const char* A; const char* W; int G, c;
    __device__ bool next(int i, Unit& u) const {
        const int ti = (i >> 1) * G + c, kh = i & 1; if (ti >= 256) return false;
        u.pm = ti % 32; u.pn = ti / 32; u.aux = kh;
        u.a = A + ((size_t)u.pm * 256 * 2048 + kh * 1024) * 2; u.b = W + ((size_t)u.pn * 256 * 2048 + kh * 1024) * 2; return true;
    }
};

constexpr int NPH = 2 + NL * 14;
__global__ void __launch_bounds__(512, 2) fwd(Args args) {
    extern __shared__ __attribute__((aligned(16))) unsigned char lds_raw[];
    Frame F;
    F.lds = (LAS unsigned char*)lds_raw; F.tid = threadIdx.x; F.lane = F.tid & 63; F.wave = __builtin_amdgcn_readfirstlane(F.tid >> 6); F.G = gridDim.x; F.cu = blockIdx.x;
    F.in = args.in; F.out = args.out; F.ws = args.ws;
    volatile LAS unsigned* MISC = (volatile LAS unsigned*)(F.lds + MISC_OFF);
    for (int u = F.tid; u < (LDS_BYTES - RING_BYTES) / 4; u += 512) ((LAS unsigned*)(F.lds + RING_BYTES))[u] = 0u;
    __syncthreads();
    unsigned* ctl = (unsigned*)(F.ws + WS_CTL);
    XcdBarrier bar; bar.bar = ctl + CW_BAR; bar.x = 0; bar.st = MISC + 8;
    if (!MK_PER_PHASE) bar = xcd_barrier_post(ctl + CW_BAR, MISC + 8);
    const int lo = args.ph_lo, hi = args.ph_hi; int pc = 0;
#define PH_IF launder(F); if (pc >= lo && pc < hi)
#define PH_END do { const bool both_ = (pc >= lo) && (pc + 1 < hi); ++pc; if (both_) xcd_barrier(bar); } while (0)
#define U ((bf16_t*)(F.ws + WS_U))
#define H ((bf16_t*)(F.ws + WS_H))
#define Y ((bf16_t*)(F.ws + WS_Y))
#define Z ((bf16_t*)(F.ws + WS_Z))
#define CQKV ((bf16_t*)(F.ws + WS_CQKV))
#define QM ((bf16_t*)(F.ws + WS_QM))
#define KV ((bf16_t*)(F.ws + WS_KV))
#define AB ((bf16_t*)(F.ws + WS_AB))
#define MG ((bf16_t*)(F.ws + WS_MG))
#define WL ((const bf16_t*)(F.ws + WS_W) + (size_t)l * WO_END)

    PH_IF { p0_prologue(F);
#if PROBE_DUP == 10
        __syncthreads(); p0_prologue(F);
#endif
    } PH_END;
    PH_IF { pe_bias_reduce(F); thin_first_norm(F, F.in[I_F1PRE]); } PH_END;
    for (int l = 0; l < NL; ++l) {
        for (int f = 0; f < 2; ++f) {
            PH_IF {
                Gemm g{D, D, D / 64, 0}; SchedStd S; S.init(U, D, WL + (f ? WO_GU2 : WO_GU1), D, M, 2 * FF, F.G, F.cu); EpiSwiGLU E{H, FF};
                pg8::gemm_phase<EpiSwiGLU, SchedStd, 0>(F.lds, g, S, E);
#if PROBE_DUP == 1
                pg8::gemm_phase<EpiSwiGLU, SchedStd, 0>(F.lds, g, S, E);
#endif
            } PH_END;
            PH_IF {
                Gemm g{FF, FF, FF / 64, 0}; SchedStd S; S.init(H, FF, WL + (f ? WO_D2 : WO_D1), FF, M, D, F.G, F.cu); EpiBf16 E{Y, D};
                pg8::gemm_phase<EpiBf16, SchedStd, 0>(F.lds, g, S, E);
            } PH_END;
            PH_IF {
#if PROBE_DUP == 11
                thin_post_norm(F, 0.0f, F.in[I_F1POST] + (size_t)l * D, F.in[I_MPRE] + (size_t)l * D, nullptr); __syncthreads();
#endif
                if (f == 0) thin_post_norm(F, 0.5f, F.in[I_F1POST] + (size_t)l * D, F.in[I_MPRE] + (size_t)l * D, nullptr);
                else thin_post_norm(F, 0.5f, F.in[I_F2POST] + (size_t)l * D, (l + 1 < NL) ? F.in[I_F1PRE] + (size_t)(l + 1) * D : nullptr, (l + 1 < NL) ? nullptr : F.out);
            } PH_END;
            if (f == 0) {
                PH_IF {
                    Gemm g{D, D, D / 64, 0}; SchedStd S; S.init(U, D, WL + WO_IN, D, M, DINP, F.G, F.cu); EpiBf16 E{Z, DINP};
                    pg8::gemm_phase<EpiBf16, SchedStd, 0>(F.lds, g, S, E);
                } PH_END;
                PH_IF {
                    thin_mix(F, F.in[I_QNG] + (size_t)l * 512, F.in[I_KVNG] + (size_t)l * 512);
                    __syncthreads();
                    EpiSlab E{(float*)(F.ws + WS_PART)};
                    { Gemm g{16 * DINP, 6144, 12, (size_t)DINP * 2}; SchedCmp S{(const char*)Z, (const char*)(WL + WO_1K), 0, F.cu, 0}; pg8::gemm_phase<EpiSlab, SchedCmp, 3>(F.lds, g, S, E); }
                    { Gemm g{16 * DINP, 4096, 8, (size_t)DINP * 2}; SchedCmp S{(const char*)Z, (const char*)(WL + WO_1V), 32, F.cu, 1}; pg8::gemm_phase<EpiSlab, SchedCmp, 2>(F.lds, g, S, E); }
                } PH_END;
                PH_IF {
                    { Gemm g{1024, 512, 8, 0}; SchedQKV S{(const char*)CQKV, (const char*)(WL + WO_Q), (const char*)(WL + WO_UKV), F.G, F.cu}; EpiQKV E{QM, KV};
                      pg8::gemm_phase<EpiQKV, SchedQKV, 0>(F.lds, g, S, E); }
                    for (int u = F.G - 1 - F.cu; u < 128; u += F.G) cmp_stage2_unit(F, u, l);
                } PH_END;
                PH_IF { att::cmp_phase(F); } PH_END;
                PH_IF { att::attn_phase(F, l);
#if PROBE_DUP == 7
                __syncthreads(); att::attn_phase(F, l, 32);
#endif
                } PH_END;
                PH_IF {
                    Gemm g{2048, 2048, 16, 0}; SchedMerge S{(const char*)AB, (const char*)(WL + WO_AB), F.G, F.cu}; EpiMerge E{Z, MG};
                    pg8::gemm_phase<EpiMerge, SchedMerge, 0>(F.lds, g, S, E);
                } PH_END;
                PH_IF {
                    Gemm g{2048, 2048, 32, 0}; SchedStd S; S.init(MG, 2048, WL + WO_OUT, 2048, M, D, F.G, F.cu); EpiBf16 E{Y, D};
                    pg8::gemm_phase<EpiBf16, SchedStd, 0>(F.lds, g, S, E);
                } PH_END;
                PH_IF { thin_post_norm(F, 1.0f, F.in[I_MPOST] + (size_t)l * D, F.in[I_F2PRE] + (size_t)l * D, nullptr); } PH_END;
            }
        }
    }
#undef PH_IF
#undef PH_END
#undef U
#undef H
#undef Y
#undef Z
#undef CQKV
#undef QM
#undef KV
#undef AB
#undef MG
#undef WL
}

extern "C" void kernel_launch(void* const* d_in, const int* in_sizes, int n_in, void* d_out, int out_size, void* d_ws, size_t ws_size, hipStream_t stream) {
    static int grid = 0;
    if (grid == 0) {
        if (n_in != 30 || in_sizes[0] != M * D || out_size != M * D || ws_size < WS_END) { fprintf(stderr, "kernel_launch: unexpected shapes / workspace (n_in %d, ws %zu < %zu)\n", n_in, ws_size, (size_t)WS_END); grid = -1; return; }
        int dev = 0, cus = 0, per_cu = 0;
        if (hipGetDevice(&dev) != hipSuccess || hipDeviceGetAttribute(&cus, hipDeviceAttributeMultiprocessorCount, dev) != hipSuccess) { grid = -1; return; }
        if (hipFuncSetAttribute((const void*)fwd, hipFuncAttributeMaxDynamicSharedMemorySize, LDS_BYTES) != hipSuccess) { fprintf(stderr, "kernel_launch: hipFuncSetAttribute failed\n"); grid = -1; return; }
        if (hipOccupancyMaxActiveBlocksPerMultiprocessor(&per_cu, (const void*)fwd, 512, LDS_BYTES) != hipSuccess || per_cu < 1) { fprintf(stderr, "kernel_launch: occupancy query says %d\n", per_cu); }
        (void)hipGetLastError();
        grid = cus;
    }
    if (grid < 0) return;
    (void)hipMemsetAsync((char*)d_ws + WS_CTL, 0, CTL_ZERO_BYTES, stream);
    Args a{};
    for (int i = 0; i < 30; ++i) a.in[i] = (const float*)d_in[i];
    a.out = (float*)d_out; a.ws = (unsigned char*)d_ws;
#if MK_PER_PHASE
    for (int p = 0; p < NPH; ++p) { a.ph_lo = p; a.ph_hi = p + 1; hipLaunchKernelGGL(fwd, dim3(grid), dim3(512), LDS_BYTES, stream, a); }
#else
    a.ph_lo = 0; a.ph_hi = NPH; hipLaunchKernelGGL(fwd, dim3(grid), dim3(512), LDS_BYTES, stream, a);
#endif
}
```

```cpp
#include <hip/hip_runtime.h>
#include <cstdio>
#include <cstdint>

#ifndef PROBE_DUP
#define PROBE_DUP 0
#endif
#ifndef MK_PER_PHASE
#define MK_PER_PHASE 0
#endif

#define GAS __attribute__((address_space(1)))
#define LAS __attribute__((address_space(3)))
typedef unsigned short bf16_t;
typedef short bf16x8 __attribute__((ext_vector_type(8)));
typedef float f32x4 __attribute__((ext_vector_type(4)));
typedef float f32x2 __attribute__((ext_vector_type(2)));
typedef unsigned u32x4 __attribute__((ext_vector_type(4)));
typedef unsigned u32x2 __attribute__((ext_vector_type(2)));
typedef __bf16 bf16x2_t __attribute__((ext_vector_type(2)));

constexpr int NB = 4, SEQ = 2048, M = NB * SEQ, D = 2048, NL = 4, FF = 5632;
constexpr int DIN = 8664, DINP = 8704;
constexpr int ZO_CQ = 0, ZO_CKV = 512, ZO_KR = 1024, ZO_NQ = 1088, ZO_KC = 2624, ZO_VC = 3008, ZO_KS = 3264, ZO_VS = 3648, ZO_KW = 3904, ZO_VW = 4288, ZO_NG = 4544, ZO_GA = 4568, ZO_GB = 6616;
constexpr float EPS = 1e-6f;
constexpr int NCMP = 127;

constexpr size_t MiB = 1u << 20;
constexpr size_t alup(size_t x) { return (x + MiB - 1) / MiB * MiB; }
constexpr size_t WS_CTL = 0, CTL_ZERO_BYTES = 1 * MiB;
constexpr size_t WS_TBL = WS_CTL + CTL_ZERO_BYTES;
constexpr size_t WS_ROPE = WS_TBL + MiB;
constexpr size_t WS_X = WS_ROPE + alup((size_t)M * 32 * 8);
constexpr size_t WS_U = WS_X + alup((size_t)M * D * 4);
constexpr size_t WS_H = WS_U + alup((size_t)M * D * 2);
constexpr size_t WS_Y = WS_H + alup((size_t)M * FF * 2);
constexpr size_t WS_Z = WS_Y + alup((size_t)M * D * 2);
constexpr size_t WS_CQKV = WS_Z + alup((size_t)(M + 64) * DINP * 2);
constexpr size_t WS_KPE = WS_CQKV + alup((size_t)M * 1024 * 2);
constexpr size_t WS_QM = WS_KPE + alup((size_t)M * 64 * 2);
constexpr size_t WS_KV = WS_QM + alup((size_t)M * 1536 * 2);
constexpr size_t WS_AB = WS_KV + alup((size_t)M * 2048 * 2);
constexpr size_t WS_MG = WS_AB + alup((size_t)M * 2048 * 2);
constexpr size_t WS_OC = WS_MG + alup((size_t)M * 2048 * 2);
constexpr size_t WS_PART = WS_OC + alup((size_t)M * 1024 * 4);
constexpr size_t WS_KC = WS_PART + alup((size_t)64 * 256 * 256 * 4);
constexpr size_t WS_SEL = WS_KC + MiB;
constexpr size_t WS_W = WS_SEL + MiB;
constexpr size_t WO_GU1 = 0, WO_D1 = WO_GU1 + (size_t)2 * FF * D, WO_GU2 = WO_D1 + (size_t)D * FF, WO_D2 = WO_GU2 + (size_t)2 * FF * D,
                 WO_IN = WO_D2 + (size_t)D * FF, WO_Q = WO_IN + (size_t)DINP * D, WO_UKV = WO_Q + (size_t)1536 * 512, WO_1K = WO_UKV + (size_t)2048 * 512,
                 WO_1V = WO_1K + (size_t)256 * 6144, WO_AB = WO_1V + (size_t)256 * 4096, WO_OUT = WO_AB + (size_t)2048 * 2048, WO_END = WO_OUT + (size_t)2048 * 2048;
constexpr size_t WS_END = WS_W + alup(WO_END * 2 * NL);
constexpr int CW_BAR = 4096;

constexpr int RING_BYTES = 131072, MISC_OFF = RING_BYTES + 320, LDS_BYTES = 147456;

#define RLX_AGENT __ATOMIC_RELAXED, __HIP_MEMORY_SCOPE_AGENT
__device__ __forceinline__ unsigned cvtpk(float lo, float hi) { f32x2 v = {lo, hi}; bf16x2_t b = __builtin_convertvector(v, bf16x2_t); return __builtin_bit_cast(unsigned, b); }
__device__ __forceinline__ float bflo(unsigned u) { return __uint_as_float(u << 16); }
__device__ __forceinline__ float bfhi(unsigned u) { return __uint_as_float(u & 0xffff0000u); }
__device__ __forceinline__ float bf1(bf16_t h) { return __uint_as_float((unsigned)h << 16); }
__device__ __forceinline__ float wave_sum(float v) {
#pragma unroll
    for (int o = 1; o < 64; o <<= 1) v += __shfl_xor(v, o);
    return v;
}
__device__ __forceinline__ float wave_max(float v) {
#pragma unroll
    for (int o = 1; o < 64; o <<= 1) v = fmaxf(v, __shfl_xor(v, o));
    return v;
}
__device__ __forceinline__ float sigmoidf_(float x) { return 1.0f / (1.0f + __expf(-x)); }

__device__ const float ROPE_INV[32] = {
    1.000000000e+00f, 7.498942614e-01f, 5.623413324e-01f, 4.216965139e-01f, 3.162277639e-01f, 2.371373773e-01f, 1.778279394e-01f, 1.333521307e-01f,
    1.000000015e-01f, 7.498941571e-02f, 5.623413250e-02f, 4.216965288e-02f, 3.162277490e-02f, 2.371373773e-02f, 1.778279431e-02f, 1.333521493e-02f,
    9.999999776e-03f, 7.498941850e-03f, 5.623413250e-03f, 4.216964822e-03f, 3.162277630e-03f, 2.371373586e-03f, 1.778279431e-03f, 1.333521446e-03f,
    1.000000047e-03f, 7.498942432e-04f, 5.623413017e-04f, 4.216965172e-04f, 3.162277571e-04f, 2.371373703e-04f, 1.778279402e-04f, 1.333521504e-04f};
__device__ const unsigned char REL_BUCKET[129] = {
    0, 1, 2, 3, 4, 5, 6, 7, 8, 9, 10, 11, 12, 13, 14, 15, 16, 16, 16, 17, 17, 18, 18, 18, 19, 19, 19, 20, 20, 20, 20, 21, 21, 21, 21, 22, 22, 22, 22, 22, 23, 23, 23, 23, 23, 23, 24, 24, 24, 24, 24, 24,
    25, 25, 25, 25, 25, 25, 25, 26, 26, 26, 26, 26, 26, 26, 26, 27, 27, 27, 27, 27, 27, 27, 27, 27, 27, 28, 28, 28, 28, 28, 28, 28, 28, 28, 28, 29, 29, 29, 29, 29, 29, 29, 29, 29, 29, 29, 29,
    30, 30, 30, 30, 30, 30, 30, 30, 30, 30, 30, 30, 30, 30, 31, 31, 31, 31, 31, 31, 31, 31, 31, 31, 31, 31, 31, 31, 31, 31};

#define XB_TMO      128
#define XB_XCNT(j)  (256  + 64 * (j))
#define XB_XSUB(j)  (1280 + 64 * (j))
#define XB_XGEN(j)  (2304 + 64 * (j))
#define XB_TOP      3328
#define XB_TOPGEN   3392
#define XCD_BAR_WORDS 3456
#define XB_SPIN_CAP (1u << 18)
__device__ __forceinline__ unsigned xb_ld(unsigned* p)              { return __hip_atomic_load(p, __ATOMIC_RELAXED, __HIP_MEMORY_SCOPE_AGENT); }
__device__ __forceinline__ unsigned xb_add(unsigned* p, unsigned v) { return __hip_atomic_fetch_add(p, v, __ATOMIC_RELAXED, __HIP_MEMORY_SCOPE_AGENT); }
__device__ __forceinline__ unsigned xb_xcc_id() { return (unsigned)__builtin_amdgcn_s_getreg((3 << 11) | 20) & 0xFu; }
#define XB_SPIN(cond, bar) do { unsigned _sp = 0; while (cond) { __builtin_amdgcn_s_sleep(1); \
    if ((++_sp & 255u) == 0u) { if (xb_ld(&(bar)[XB_TMO])) break; if (_sp > XB_SPIN_CAP) { atomicAdd(&(bar)[XB_TMO], 1u); break; } } } } while (0)
struct XcdBarrier { unsigned* bar; unsigned x; volatile LAS unsigned* st; };
__device__ __forceinline__ XcdBarrier xcd_barrier_post(unsigned* bar, volatile LAS unsigned* st) {
    XcdBarrier b; b.bar = bar; b.x = xb_xcc_id(); b.st = st;
    if (threadIdx.x == 0) (void)xb_add(&bar[XB_XCNT(b.x)], 1u);
    return b;
}
__device__ __forceinline__ void xcd_barrier_complete(unsigned* bar, unsigned x, unsigned& nloc, unsigned& nx) {
    const unsigned G = gridDim.x * gridDim.y * gridDim.z;
    unsigned sum, cnt, mine, sp = 0u;
    for (;;) {
        sum = 0u; cnt = 0u; mine = 0u;
#pragma unroll
        for (unsigned j = 0; j < 16; ++j) { const unsigned c = xb_ld(&bar[XB_XCNT(j)]); sum += c; cnt += (c > 0u) ? 1u : 0u; mine = (j == x) ? c : mine; }
        if (sum == G) break;
        __builtin_amdgcn_s_sleep(1);
        if ((++sp & 255u) == 0u) { if (xb_ld(&bar[XB_TMO])) break; if (sp > XB_SPIN_CAP) { atomicAdd(&bar[XB_TMO], 1u); break; } }
    }
    nloc = mine > 0u ? mine : 1u; nx = cnt > 0u ? cnt : 1u;
}
__device__ __forceinline__ void xcd_barrier(const XcdBarrier& b) {
    asm volatile("s_waitcnt vmcnt(0)" ::: "memory");
    __syncthreads();
    if (threadIdx.x == 0) {
        unsigned* bar = b.bar;
        __builtin_amdgcn_s_waitcnt(0);
        unsigned nloc = b.st[0], nx = b.st[1];
        if (nloc == 0u) { xcd_barrier_complete(bar, b.x, nloc, nx); b.st[0] = nloc; b.st[1] = nx; }
        const unsigned old = xb_add(&bar[XB_XSUB(b.x)], 1u);
        const unsigned gen = old / nloc;
        if (old + 1u == (gen + 1u) * nloc) {
            __builtin_amdgcn_fence(__ATOMIC_RELEASE, "agent");
            asm volatile("s_waitcnt vmcnt(0)" ::: "memory");
            const unsigned og = xb_add(&bar[XB_TOP], 1u);
            const unsigned tg = og / nx;
            if (og + 1u == (tg + 1u) * nx) xb_add(&bar[XB_TOPGEN], 1u);
            else XB_SPIN(xb_ld(&bar[XB_TOPGEN]) == tg, bar);
            __builtin_amdgcn_fence(__ATOMIC_ACQUIRE, "agent");
            xb_add(&bar[XB_XGEN(b.x)], 1u);
            asm volatile("s_waitcnt vmcnt(0)" ::: "memory");
        } else {
            XB_SPIN(xb_ld(&bar[XB_XGEN(b.x)]) == gen, bar);
            __builtin_amdgcn_fence(__ATOMIC_ACQUIRE, "agent");
            asm volatile("s_waitcnt vmcnt(0)" ::: "memory");
        }
    }
    __syncthreads();
}

namespace pg8 {
constexpr int BM = 256, BK = 64, HALF = 128, HTB = HALF * BK * 2, STAGE_BYTES = 8 * HTB, NXCD = 8, WGM = 8;
__host__ __device__ __forceinline__ int lds_byte(int r, int c) { const int st = (r >> 4) * 2 + (c >> 5), rr = r & 15, cc = c & 31, ob = rr * 64 + cc * 2; return st * 1024 + (ob ^ (((ob >> 9) & 1) << 5)); }
__host__ __device__ __forceinline__ void stage_rc(int b, int& R, int& C) { const int st = b / 1024, sb = b % 1024, swz = sb ^ (((sb >> 9) & 1) << 5); R = (st >> 1) * 16 + swz / 64; C = (st & 1) * 32 + (swz % 64) / 2; }
__host__ __device__ __forceinline__ int perm32(int rho) { const int n = rho >> 4, i = rho & 15; return 8 * (i >> 2) + 4 * n + (i & 3); }

struct Unit { const char* a; const char* b; int pm, pn, aux; };
struct Gemm { int lda, ldb, nt; size_t gstride; };

struct StaticOrder {
    int nM, nN, nwg, G, c;
    __device__ void init(int M_, int N_, int G_, int c_) { nM = M_ / BM; nN = N_ / BM; nwg = nM * nN; G = G_; c = c_; }
    __device__ bool next(int i, int& pm, int& pn) const {
        const long L = (long)i * G + c; if (L >= nwg) return false;
        int wgid = (int)L; { const int q = nwg / NXCD, r = nwg % NXCD, xcd = wgid % NXCD, off = wgid / NXCD; wgid = (xcd < r ? xcd * (q + 1) : r * (q + 1) + (xcd - r) * q) + off; }
        const int nig = WGM * nN, gid = wgid / nig, fm = gid * WGM, gsz = (nM - fm) < WGM ? (nM - fm) : WGM;
        pm = fm + ((wgid % nig) % gsz); pn = (wgid % nig) / gsz; return true;
    }
};

template <class Epi, class Sched, int KGRP>
__device__ __forceinline__ void gemm_phase(LAS unsigned char* lds, const Gemm g, const Sched& S, const Epi& E) {
    int tid_ = threadIdx.x; asm volatile("" : "+v"(tid_));
    const int tid = tid_, wid = __builtin_amdgcn_readfirstlane(tid >> 6), lane = tid & 63, wr = wid >> 2, wc = wid & 3, fr = lane & 15, fq = lane >> 4;
    const int nt = g.nt;
    unsigned voffA[2], voffB[2];
#pragma unroll
    for (int i = 0; i < 2; ++i) { int R, C; stage_rc(tid * 16 + i * 8192, R, C); const int Rb = (R & ~31) + perm32(R & 31);
        voffA[i] = (unsigned)(R * g.lda + C) * 2u; voffB[i] = (unsigned)(Rb * g.ldb + C) * 2u; }
    const size_t kstep = (size_t)(BK * 2);
    const size_t hstepA = (size_t)HALF * g.lda * 2, hstepB = (size_t)HALF * g.ldb * 2;
    const unsigned ldsw = (unsigned)wid * 1024u;
    const int aoff = lds_byte(wr * 64 + fr, fq * 8), boff = lds_byte(wc * 32 + fr, fq * 8);
    auto koffA = [&](int t) -> size_t { if constexpr (KGRP > 0) return (size_t)(t / KGRP) * g.gstride + (size_t)(t % KGRP) * kstep; else return (size_t)t * kstep; };
#define PG8_SA(b, h) (((b) * 2 + (h)) * HTB)
#define PG8_SB(b, h) ((4 + (b) * 2 + (h)) * HTB)
#define PG8_STAGE(bufoff, gbase, voff) do { _Pragma("unroll") for (int _i = 0; _i < 2; ++_i) \
        __builtin_amdgcn_global_load_lds((const unsigned*)((const char*)(gbase) + (voff)[_i]), (LAS unsigned*)(lds + (bufoff) + ldsw + _i * 8192), 16, 0, 0); } while (0)
#define PG8_LDA(dst, b, h) do { _Pragma("unroll") for (int m = 0; m < 4; ++m) _Pragma("unroll") for (int k = 0; k < 2; ++k) dst[m][k] = *(const LAS bf16x8*)(lds + PG8_SA(b, h) + aoff + m * 2048 + k * 1024); } while (0)
#define PG8_LDB(dst, b, h) do { _Pragma("unroll") for (int n = 0; n < 2; ++n) _Pragma("unroll") for (int k = 0; k < 2; ++k) dst[n][k] = *(const LAS bf16x8*)(lds + PG8_SB(b, h) + boff + n * 2048 + k * 1024); } while (0)
#define PG8_MMA(ai, bj, At, Bt) do { __builtin_amdgcn_s_setprio(1); _Pragma("unroll") for (int m = 0; m < 4; ++m) _Pragma("unroll") for (int n = 0; n < 2; ++n) _Pragma("unroll") for (int k = 0; k < 2; ++k) \
        acc[ai][bj][m][n] = __builtin_amdgcn_mfma_f32_16x16x32_bf16(Bt[n][k], At[m][k], acc[ai][bj][m][n], 0, 0, 0); __builtin_amdgcn_s_setprio(0); } while (0)
#define PG8_WAIT_V(n) asm volatile("s_waitcnt vmcnt(" #n ")" ::: "memory")
#define PG8_WAIT_L(n) asm volatile("s_waitcnt lgkmcnt(" #n ")" ::: "memory")
#define PG8_BAR __builtin_amdgcn_s_barrier()
#define PG8_SCHED __builtin_amdgcn_sched_barrier(0)
    Unit cur, nxt; int ui = 0;
    if (!S.next(0, cur)) return;
    f32x4 acc[2][2][4][2];
#pragma unroll
    for (int a = 0; a < 2; ++a)
#pragma unroll
        for (int b = 0; b < 2; ++b)
#pragma unroll
            for (int m = 0; m < 4; ++m)
#pragma unroll
                for (int n = 0; n < 2; ++n) acc[a][b][m][n] = (f32x4){0.f, 0.f, 0.f, 0.f};
    bf16x8 At[4][2], B0[2][2], B1[2][2];
    const char* cA = cur.a; const char* cB = cur.b;
    PG8_STAGE(PG8_SB(0, 0), cB, voffB); PG8_STAGE(PG8_SB(0, 1), cB + hstepB, voffB); PG8_STAGE(PG8_SA(0, 0), cA, voffA); PG8_STAGE(PG8_SA(0, 1), cA + hstepA, voffA);
    if (wr == 1) PG8_BAR;
    PG8_WAIT_V(2); PG8_BAR;
    { const char* a1p = cA + koffA(1);
      PG8_STAGE(PG8_SB(1, 0), cB + kstep, voffB); PG8_STAGE(PG8_SA(1, 0), a1p, voffA); PG8_STAGE(PG8_SB(1, 1), cB + hstepB + kstep, voffB); }
    PG8_WAIT_V(6); PG8_BAR;
    for (;;) {
        const bool has_next = S.next(ui + 1, nxt);
        const char* nA = has_next ? nxt.a : cA; const char* nB = has_next ? nxt.b : cB;
        for (int t = 0; t < nt; t += 2) {
            const bool last = (t == nt - 2);
            const char* a1 = cA + koffA(t + 1);
            const char* a2 = last ? nA : cA + koffA(t + 2); const char* b2 = last ? nB : cB + (size_t)(t + 2) * kstep;
            const char* a3 = last ? nA + koffA(1) : cA + koffA(t + 3); const char* b3 = b2 + kstep;
            PG8_LDB(B0, 0, 0); PG8_LDB(B1, 0, 1); PG8_SCHED; PG8_LDA(At, 0, 0); PG8_STAGE(PG8_SA(1, 1), a1 + hstepA, voffA);
            PG8_WAIT_V(8); PG8_WAIT_L(0); PG8_BAR; PG8_MMA(0, 0, At, B0); PG8_MMA(0, 1, At, B1); PG8_BAR; PG8_SCHED;
            PG8_LDA(At, 0, 1); PG8_STAGE(PG8_SB(0, 0), b2, voffB); PG8_STAGE(PG8_SB(0, 1), b2 + hstepB, voffB); PG8_STAGE(PG8_SA(0, 0), a2, voffA);
            PG8_WAIT_V(8); PG8_WAIT_L(0); PG8_BAR; PG8_MMA(1, 0, At, B0); PG8_MMA(1, 1, At, B1); PG8_BAR; PG8_SCHED;
            PG8_LDB(B0, 1, 0); PG8_LDB(B1, 1, 1); PG8_SCHED; PG8_LDA(At, 1, 0); PG8_STAGE(PG8_SA(0, 1), a2 + hstepA, voffA);
            PG8_WAIT_V(8); PG8_WAIT_L(0); PG8_BAR; PG8_MMA(0, 0, At, B0); PG8_MMA(0, 1, At, B1); PG8_BAR; PG8_SCHED;
            PG8_LDA(At, 1, 1); PG8_STAGE(PG8_SB(1, 0), b3, voffB); PG8_STAGE(PG8_SB(1, 1), b3 + hstepB, voffB); PG8_STAGE(PG8_SA(1, 0), a3, voffA);
            PG8_WAIT_V(8); PG8_WAIT_L(0); PG8_BAR; PG8_MMA(1, 0, At, B0); PG8_MMA(1, 1, At, B1); PG8_BAR; PG8_SCHED;
        }
        if (wr == 0) PG8_BAR;
        const bool keep = E(acc, cur, wr, wc, fr, fq);
        if (!has_next) break;
        if (!keep) {
#pragma unroll
            for (int a = 0; a < 2; ++a)
#pragma unroll
                for (int b = 0; b < 2; ++b)
#pragma unroll
                    for (int m = 0; m < 4; ++m)
#pragma unroll
                        for (int n = 0; n < 2; ++n) acc[a][b][m][n] = (f32x4){0.f, 0.f, 0.f, 0.f};
        }
        cur = nxt; cA = nA; cB = nB; ++ui;
        if (wr == 1) PG8_BAR;
    }
    PG8_WAIT_V(0);
    PG8_BAR;
#undef PG8_SA
#undef PG8_SB
#undef PG8_STAGE
#undef PG8_LDA
#undef PG8_LDB
#undef PG8_MMA
#undef PG8_WAIT_V
#undef PG8_WAIT_L
#undef PG8_BAR
#undef PG8_SCHED
}
}
using pg8::Unit; using pg8::Gemm;
typedef f32x4 Acc[2][2][4][2];

struct SchedStd {
    pg8::StaticOrder so; const char* A; const char* B; size_t tA, tB;
    __device__ void init(const bf16_t* A_, int lda, const bf16_t* B_, int ldb, int M_, int N_, int G, int c) { so.init(M_, N_, G, c); A = (const char*)A_; B = (const char*)B_; tA = (size_t)256 * lda * 2; tB = (size_t)256 * ldb * 2; }
    __device__ bool next(int i, Unit& u) const { int pm, pn; if (!so.next(i, pm, pn)) return false; u.pm = pm; u.pn = pn; u.aux = 0; u.a = A + pm * tA; u.b = B + pn * tB; return true; }
};

struct EpiBf16 {
    bf16_t* O; int ldc;
    __device__ __forceinline__ bool operator()(Acc& acc, const Unit& u, int wr, int wc, int fr, int fq) const {
        const int row0 = u.pm * 256 + wr * 64 + fr, col0 = u.pn * 256 + wc * 32 + 8 * fq;
#pragma unroll
        for (int ai = 0; ai < 2; ++ai)
#pragma unroll
            for (int m = 0; m < 4; ++m) { bf16_t* rowp = O + (size_t)(row0 + ai * 128 + m * 16) * ldc + col0;
#pragma unroll
                for (int bj = 0; bj < 2; ++bj) { const f32x4 v0 = acc[ai][bj][m][0], v1 = acc[ai][bj][m][1];
                    u32x4 w; w.x = cvtpk(v0[0], v0[1]); w.y = cvtpk(v0[2], v0[3]); w.z = cvtpk(v1[0], v1[1]); w.w = cvtpk(v1[2], v1[3]);
                    *(u32x4*)(rowp + bj * 128) = w; } }
        return false;
    }
};
struct EpiSwiGLU {
    bf16_t* O; int ldc;
    __device__ __forceinline__ bool operator()(Acc& acc, const Unit& u, int wr, int wc, int fr, int fq) const {
        const int row0 = u.pm * 256 + wr * 64 + fr, col0 = u.pn * 128 + wc * 32 + 8 * fq;
#pragma unroll
        for (int ai = 0; ai < 2; ++ai)
#pragma unroll
            for (int m = 0; m < 4; ++m) { bf16_t* rowp = O + (size_t)(row0 + ai * 128 + m * 16) * ldc + col0;
                float h[8];
#pragma unroll
                for (int n = 0; n < 2; ++n)
#pragma unroll
                    for (int e = 0; e < 4; ++e) { const float gt = acc[ai][0][m][n][e], up = acc[ai][1][m][n][e]; h[n * 4 + e] = gt * sigmoidf_(gt) * up; }
                u32x4 w; w.x = cvtpk(h[0], h[1]); w.y = cvtpk(h[2], h[3]); w.z = cvtpk(h[4], h[5]); w.w = cvtpk(h[6], h[7]);
                *(u32x4*)rowp = w; }
        return false;
    }
};
struct EpiSlab {
    float* P;
    __device__ __forceinline__ bool operator()(Acc& acc, const Unit& u, int wr, int wc, int fr, int fq) const {
        float* base = P + (size_t)u.aux * 65536;
#pragma unroll
        for (int ai = 0; ai < 2; ++ai)
#pragma unroll
            for (int m = 0; m < 4; ++m) { float* rowp = base + (size_t)(ai * 128 + wr * 64 + m * 16 + fr) * 256 + wc * 32 + 8 * fq;
#pragma unroll
                for (int bj = 0; bj < 2; ++bj) { *(f32x4*)(rowp + bj * 128) = acc[ai][bj][m][0]; *(f32x4*)(rowp + bj * 128 + 4) = acc[ai][bj][m][1]; } }
        return false;
    }
};
struct EpiQKV {
    bf16_t* Q; bf16_t* KV;
    __device__ __forceinline__ bool operator()(Acc& acc, const Unit& u, int wr, int wc, int fr, int fq) const {
        EpiBf16 e{u.aux ? KV : Q, u.aux ? 2048 : 1536}; return e(acc, u, wr, wc, fr, fq);
    }
};
struct EpiMerge {
    const bf16_t* Z; bf16_t* O;
    __device__ __forceinline__ bool operator()(Acc& acc, const Unit& u, int wr, int wc, int fr, int fq) const {
        const int row0 = u.pm * 256 + wr * 64 + fr, col0 = u.pn * 256 + wc * 32 + 8 * fq;
#pragma unroll
        for (int ai = 0; ai < 2; ++ai)
#pragma unroll
            for (int m = 0; m < 4; ++m) { const size_t row = (size_t)(row0 + ai * 128 + m * 16);
#pragma unroll
                for (int bj = 0; bj < 2; ++bj) { const int col = col0 + bj * 128;
                    const u32x4 gbw = *(const u32x4*)(Z + row * DINP + ZO_GB + col);
                    float gb[8] = {sigmoidf_(bflo(gbw.x)), sigmoidf_(bfhi(gbw.x)), sigmoidf_(bflo(gbw.y)), sigmoidf_(bfhi(gbw.y)), sigmoidf_(bflo(gbw.z)), sigmoidf_(bfhi(gbw.z)), sigmoidf_(bflo(gbw.w)), sigmoidf_(bfhi(gbw.w))};
                    if (u.aux == 0) {
                        const u32x4 gaw = *(const u32x4*)(Z + row * DINP + ZO_GA + col);
                        float ga[8] = {sigmoidf_(bflo(gaw.x)), sigmoidf_(bfhi(gaw.x)), sigmoidf_(bflo(gaw.y)), sigmoidf_(bfhi(gaw.y)), sigmoidf_(bflo(gaw.z)), sigmoidf_(bfhi(gaw.z)), sigmoidf_(bflo(gaw.w)), sigmoidf_(bfhi(gaw.w))};
#pragma unroll
                        for (int n = 0; n < 2; ++n)
#pragma unroll
                            for (int e = 0; e < 4; ++e) acc[ai][bj][m][n][e] *= ga[n * 4 + e] / gb[n * 4 + e];
                    } else {
                        float h[8];
#pragma unroll
                        for (int n = 0; n < 2; ++n)
#pragma unroll
                            for (int e = 0; e < 4; ++e) h[n * 4 + e] = acc[ai][bj][m][n][e] * gb[n * 4 + e];
                        u32x4 w; w.x = cvtpk(h[0], h[1]); w.y = cvtpk(h[2], h[3]); w.z = cvtpk(h[4], h[5]); w.w = cvtpk(h[6], h[7]);
                        *(u32x4*)(O + row * 2048 + col) = w;
                    } } }
        return u.aux == 0;
    }
};

struct Args { const float* in[30]; float* out; unsigned char* ws; int ph_lo, ph_hi; };
enum { I_X = 0, I_POS, I_RELB, I_F1PRE, I_F1POST, I_F1G, I_F1U, I_F1D, I_MPRE, I_MPOST, I_WIN, I_QNG, I_WQUP, I_KVNG, I_WUK, I_WUV, I_PEK, I_W1K, I_W2K, I_PEV, I_W1V, I_W2V, I_WA, I_WB, I_WOUT,
       I_F2PRE, I_F2POST, I_F2G, I_F2U, I_F2D };
struct Frame {
    LAS unsigned char* lds; int tid, lane, wave, G, cu;
    const float* const* in; float* out; unsigned char* ws;
};

__device__ __forceinline__ void launder(Frame& F) { unsigned long long w_ = (unsigned long long)F.ws; unsigned lo_ = (unsigned)w_, hi_ = (unsigned)(w_ >> 32);
    int cu_ = F.cu; asm volatile("" : "+v"(F.tid), "+v"(F.lane), "+v"(lo_), "+v"(hi_), "+v"(cu_));
    lo_ = (unsigned)__builtin_amdgcn_readfirstlane((int)lo_); hi_ = (unsigned)__builtin_amdgcn_readfirstlane((int)hi_); F.ws = (unsigned char*)(((unsigned long long)hi_ << 32) | lo_); F.cu = __builtin_amdgcn_readfirstlane(cu_); }
__device__ __forceinline__ unsigned cvt_offb(unsigned row, unsigned ch) { return 256u * row + 16u * (ch ^ (((row & 3u) << 2) | ((row >> 2) & 3u))); }
struct CvtJob { int in_idx, K, N, ldk, koff, mode, row_off; size_t dst_off; };
__device__ __forceinline__ CvtJob cvt_job(int j) {
    switch (j) {
    case 0:  return CvtJob{I_F1G, D, FF, D, 0, 1, 0, WO_GU1};
    case 1:  return CvtJob{I_F1U, D, FF, D, 0, 1, 128, WO_GU1};
    case 2:  return CvtJob{I_F1D, FF, D, FF, 0, 0, 0, WO_D1};
    case 3:  return CvtJob{I_F2G, D, FF, D, 0, 1, 0, WO_GU2};
    case 4:  return CvtJob{I_F2U, D, FF, D, 0, 1, 128, WO_GU2};
    case 5:  return CvtJob{I_F2D, FF, D, FF, 0, 0, 0, WO_D2};
    case 6:  return CvtJob{I_WIN, D, DIN, D, 0, 0, 0, WO_IN};
    case 7:  return CvtJob{I_WQUP, 512, 1536, 512, 0, 0, 0, WO_Q};
    case 8:  return CvtJob{I_WUK, 512, 1024, 512, 0, 0, 0, WO_UKV};
    case 9:  return CvtJob{I_WUV, 512, 1024, 512, 0, 0, 1024, WO_UKV};
    case 10: return CvtJob{I_W1K, 6144, 256, 6144, 0, 0, 0, WO_1K};
    case 11: return CvtJob{I_W1V, 4096, 256, 4096, 0, 0, 0, WO_1V};
    case 12: return CvtJob{I_WA, 1024, 2048, 2048, 0, 0, 0, WO_AB};
    case 13: return CvtJob{I_WB, 1024, 2048, 2048, 1024, 0, 0, WO_AB};
    default: return CvtJob{I_WOUT, 2048, 2048, 2048, 0, 0, 0, WO_OUT};
    }
}
constexpr int N_CVT_JOBS = 15;
constexpr int CVT_ITEMS_PER_LAYER = 6096;
__device__ __forceinline__ void cvt_items(Frame& F, int L, int first, int stride, int count) {
    typedef short v4i16_t __attribute__((ext_vector_type(4)));
    if (count <= 0 || first >= CVT_ITEMS_PER_LAYER) return;
    bf16_t* wbase = (bf16_t*)(F.ws + WS_W) + (size_t)L * WO_END;
    const int tid = F.tid, lane = F.lane, w = F.wave;
    int j = 0, base = 0, flat = first, done = 0; CvtJob J = cvt_job(0); int n = (J.K / 128) * ((J.N + 127) / 128);
    bool have = true;
#define P0_SEEK() do { if (flat >= CVT_ITEMS_PER_LAYER || done >= count) { have = false; break; } while (flat >= base + n) { base += n; ++j; J = cvt_job(j); n = (J.K / 128) * ((J.N + 127) / 128); } } while (0)
#define P0_LOAD() do { const int it_ = flat - base, ntn_ = (J.N + 127) >> 7, kb_ = it_ / ntn_, nb_ = it_ - kb_ * ntn_; const float* W_ = F.in[J.in_idx] + (size_t)L * J.K * J.N; \
    _Pragma("unroll") for (int i = 0; i < 8; ++i) { const int c = tid + 512 * i, k = c >> 5, nn = nb_ * 128 + 4 * (c & 31); \
        v[i] = (nn < J.N) ? *(const f32x4*)(W_ + (size_t)(kb_ * 128 + k) * J.N + nn) : (f32x4){0.f, 0.f, 0.f, 0.f}; } } while (0)
    P0_SEEK();
    f32x4 v[8];
    if (have) P0_LOAD();
    int pb = 0;
    while (have) {
        const CvtJob cJ = J; const int it = flat - base;
        LAS unsigned char* buf = F.lds + pb * 32768;
#pragma unroll
        for (int i = 0; i < 8; ++i) { const int c = tid + 512 * i, k = c >> 5, nch = c & 31;
            *(LAS u32x2*)(buf + cvt_offb(k, nch >> 1) + 8 * (nch & 1)) = (u32x2){cvtpk(v[i].x, v[i].y), cvtpk(v[i].z, v[i].w)}; }
        asm volatile("s_waitcnt lgkmcnt(0)" ::: "memory"); __builtin_amdgcn_s_barrier(); asm volatile("" ::: "memory");
        flat += stride; ++done; P0_SEEK();
        if (have) P0_LOAD();
        const int ntn = (cJ.N + 127) >> 7, kb = it / ntn, nb = it - kb * ntn, k0 = kb * 128, n0 = nb * 128;
        const int c4 = w & 3, ks0 = (w >> 2) * 4;
        const unsigned h = lane >> 5, blk = (lane >> 4) & 1, q = (lane & 15) >> 2, p = lane & 3;
        const int nl = 32 * c4 + (lane & 31);
        const int rbase = cJ.mode ? ((n0 >> 7) * 256 + cJ.row_off) : (cJ.row_off + n0);
        bf16_t* dst = wbase + cJ.dst_off + (size_t)(rbase + nl) * cJ.ldk + cJ.koff + k0 + 8 * h;
#pragma unroll
        for (int kk = 0; kk < 4; ++kk) { const int ks = ks0 + kk;
            const v4i16_t lo = __builtin_amdgcn_ds_read_tr16_b64_v4i16((LAS v4i16_t*)(buf + cvt_offb(16 * ks + 8 * h + q, 4 * c4 + 2 * blk + (p >> 1)) + 8 * (p & 1)));
            const v4i16_t hi = __builtin_amdgcn_ds_read_tr16_b64_v4i16((LAS v4i16_t*)(buf + cvt_offb(16 * ks + 8 * h + 4 + q, 4 * c4 + 2 * blk + (p >> 1)) + 8 * (p & 1)));
            const bf16x8 o = {lo[0], lo[1], lo[2], lo[3], hi[0], hi[1], hi[2], hi[3]};
            if (n0 + nl < cJ.N) *(bf16x8*)(dst + 16 * ks) = o; }
        pb ^= 1;
    }
#undef P0_SEEK
#undef P0_LOAD
    __syncthreads();
}
constexpr int FIL_GU = 8, FIL_WIN = 8, FIL_P6 = 3, FIL_CMP = 8;
constexpr int FB_GU0 = 0, FB_WIN = FB_GU0 + 128 * FIL_GU, FB_P6 = FB_WIN + 192 * FIL_WIN, FB_CMP = FB_P6 + 192 * FIL_P6, FB_GU1 = FB_CMP + 192 * FIL_CMP, FB_DRAIN = FB_GU1 + 128 * FIL_GU;
__device__ __forceinline__ void cvt_filler(Frame& F, int l, int slot_base, int c0, int k) {
    if (l + 1 >= NL || F.G != 256 || F.cu < c0) return;
    cvt_items(F, l + 1, slot_base + (F.cu - c0) * k, 1, k);
}
__device__ __forceinline__ void cvt_drain(Frame& F, int l) {
    if (l + 1 >= NL) return;
    const int b0 = (F.G == 256) ? FB_DRAIN : 0;
    cvt_items(F, l + 1, b0 + F.cu, F.G, CVT_ITEMS_PER_LAYER);
}
__device__ __forceinline__ void p0_prologue(Frame& F) {
    cvt_items(F, 0, F.cu, F.G, CVT_ITEMS_PER_LAYER);
    __syncthreads();
    {
        const f32x4* xs = (const f32x4*)F.in[I_X]; f32x4* xd = (f32x4*)(F.ws + WS_X);
        for (size_t i = (size_t)F.cu * 512 + F.tid; i < (size_t)M * D / 4; i += (size_t)F.G * 512) xd[i] = xs[i];
        const int* pos = (const int*)F.in[I_POS]; f32x2* rope = (f32x2*)(F.ws + WS_ROPE);
        for (int i = F.cu * 512 + F.tid; i < M * 32; i += F.G * 512) {
            const float ang = (float)pos[i >> 5] * ROPE_INV[i & 31];
            const double rev = (double)ang * 0.15915494309189535; const float fr = (float)(rev - __builtin_rint(rev));
            rope[i] = (f32x2){__builtin_amdgcn_cosf(fr), __builtin_amdgcn_sinf(fr)};
        }
        float* tbl = (float*)(F.ws + WS_TBL);
        if (F.cu == 0) for (int i = F.tid; i < 8 * 132; i += 512) { const int h = i / 132, d = i % 132; const float tv = F.in[I_RELB][REL_BUCKET[d > 128 ? 128 : d] * 8 + h]; tbl[i] = tv; ((float*)(F.ws + WS_TBL + 16384))[i] = tv * 1.4426950408889634f; }
        {
            float* pp = (float*)(F.ws + WS_TBL + 32768);
            for (int item = F.cu; item < NL * 160; item += F.G) {
                const int l = item / 160, r = item % 160, kv = r >= 96, ch = kv ? r - 96 : r, Kk = kv ? 4096 : 6144;
                const float* pe = F.in[kv ? I_PEV : I_PEK] + (size_t)l * Kk + ch * 64; const float* w1 = F.in[kv ? I_W1V : I_W1K] + ((size_t)l * Kk + ch * 64) * 256;
                const int c = F.tid & 255, hf = F.tid >> 8; float sacc = 0.f;
#pragma unroll 8
                for (int k = hf * 32; k < hf * 32 + 32; ++k) sacc += pe[k] * w1[(size_t)k * 256 + c];
                LAS float* red = (LAS float*)(F.lds + 65536);
                __syncthreads();
                if (hf) red[c] = sacc;
                __syncthreads();
                if (!hf) pp[((size_t)(l * 2 + kv) * 96 + ch) * 256 + c] = sacc + red[c];
            }
        }
    }
}
__device__ __forceinline__ void pe_bias_reduce(Frame& F) {
    const float* pp = (const float*)(F.ws + WS_TBL + 32768);
    for (int u = F.cu; u < NL * 2; u += F.G) if (F.tid < 256) {
        const int kv = u & 1, nch = kv ? 64 : 96; float s = 0.f;
        for (int ch = 0; ch < nch; ++ch) s += pp[((size_t)u * 96 + ch) * 256 + F.tid];
        ((float*)(F.ws + WS_TBL + 8192))[u * 256 + F.tid] = s;
    }
}

__device__ __forceinline__ void thin_first_norm(Frame& F, const float* g) {
    const int gw = F.cu * 8 + F.wave, NGW = F.G * 8;
    const float* X = (const float*)(F.ws + WS_X); bf16_t* U = (bf16_t*)(F.ws + WS_U);
    for (int m = gw; m < M; m += NGW) {
        const f32x4* xr = (const f32x4*)(X + (size_t)m * D) + F.lane; f32x4 v[8]; float s = 0.f;
#pragma unroll
        for (int j = 0; j < 8; ++j) { v[j] = xr[64 * j]; s += (v[j].x * v[j].x + v[j].y * v[j].y) + (v[j].z * v[j].z + v[j].w * v[j].w); }
        const float r = 1.0f / sqrtf(wave_sum(s) * (1.f / D) + EPS);
        u32x2* o = (u32x2*)(U + (size_t)m * D) + F.lane;
#pragma unroll
        for (int j = 0; j < 8; ++j) { const f32x4 gg = ((const f32x4*)g)[F.lane + 64 * j]; o[64 * j] = (u32x2){cvtpk(v[j].x * r * gg.x, v[j].y * r * gg.y), cvtpk(v[j].z * r * gg.z, v[j].w * r * gg.w)}; }
    }
}
__device__ __forceinline__ void thin_post_norm(Frame& F, float coef, const float* gpost, const float* gpre, float* outp) {
    const int gw = F.cu * 8 + F.wave, NGW = F.G * 8;
    float* X = (float*)(F.ws + WS_X); bf16_t* U = (bf16_t*)(F.ws + WS_U); const bf16_t* Y = (const bf16_t*)(F.ws + WS_Y);
    for (int m = gw; m < M; m += NGW) {
        f32x4* xr = (f32x4*)(X + (size_t)m * D) + F.lane; const u32x2* yr = (const u32x2*)(Y + (size_t)m * D) + F.lane;
        f32x4 y[8]; float s = 0.f;
#pragma unroll
        for (int j = 0; j < 8; ++j) { const u32x2 w = yr[64 * j]; y[j] = (f32x4){bflo(w.x), bfhi(w.x), bflo(w.y), bfhi(w.y)}; s += (y[j].x * y[j].x + y[j].y * y[j].y) + (y[j].z * y[j].z + y[j].w * y[j].w); }
        const float r = coef / sqrtf(wave_sum(s) * (1.f / D) + EPS);
        float s2 = 0.f;
#pragma unroll
        for (int j = 0; j < 8; ++j) { const f32x4 gg = ((const f32x4*)gpost)[F.lane + 64 * j]; f32x4 x = xr[64 * j];
            x.x += y[j].x * r * gg.x; x.y += y[j].y * r * gg.y; x.z += y[j].z * r * gg.z; x.w += y[j].w * r * gg.w; y[j] = x;
            s2 += (x.x * x.x + x.y * x.y) + (x.z * x.z + x.w * x.w);
            if (outp) ((f32x4*)(outp + (size_t)m * D))[F.lane + 64 * j] = x; else xr[64 * j] = x; }
        if (gpre) {
            const float r2 = 1.0f / sqrtf(wave_sum(s2) * (1.f / D) + EPS);
            u32x2* o = (u32x2*)(U + (size_t)m * D) + F.lane;
#pragma unroll
            for (int j = 0; j < 8; ++j) { const f32x4 gg = ((const f32x4*)gpre)[F.lane + 64 * j]; o[64 * j] = (u32x2){cvtpk(y[j].x * r2 * gg.x, y[j].y * r2 * gg.y), cvtpk(y[j].z * r2 * gg.z, y[j].w * r2 * gg.w)}; }
        }
    }
}
__device__ __forceinline__ void thin_mix(Frame& F, const float* gq, const float* gkv) {
    const int gw = F.cu * 8 + F.wave, NGW = F.G * 8;
    const bf16_t* Z = (const bf16_t*)(F.ws + WS_Z); bf16_t* C = (bf16_t*)(F.ws + WS_CQKV); bf16_t* KPE = (bf16_t*)(F.ws + WS_KPE); const f32x2* rope = (const f32x2*)(F.ws + WS_ROPE);
    for (int m = gw; m < M; m += NGW) {
        const bf16_t* zr = Z + (size_t)m * DINP;
#pragma unroll
        for (int part = 0; part < 2; ++part) {
            const u32x4 w = *((const u32x4*)(zr + part * 512) + F.lane);
            float v[8] = {bflo(w.x), bfhi(w.x), bflo(w.y), bfhi(w.y), bflo(w.z), bfhi(w.z), bflo(w.w), bfhi(w.w)}; float s = 0.f;
#pragma unroll
            for (int e = 0; e < 8; ++e) s += v[e] * v[e];
            const float r = 1.0f / sqrtf(wave_sum(s) * (1.f / 512.f) + EPS);
            const float* g = (part ? gkv : gq) + 8 * F.lane; const f32x4 g0 = *(const f32x4*)g, g1 = *(const f32x4*)(g + 4);
            u32x4 o; o.x = cvtpk(v[0] * r * g0.x, v[1] * r * g0.y); o.y = cvtpk(v[2] * r * g0.z, v[3] * r * g0.w); o.z = cvtpk(v[4] * r * g1.x, v[5] * r * g1.y); o.w = cvtpk(v[6] * r * g1.z, v[7] * r * g1.w);
            *((u32x4*)(C + (size_t)m * 1024 + part * 512) + F.lane) = o;
        }
        if (F.lane < 32) {
            const float x1 = bf1(zr[ZO_KR + F.lane]), x2 = bf1(zr[ZO_KR + 32 + F.lane]); const f32x2 cs = rope[(size_t)m * 32 + F.lane];
            const unsigned a = cvtpk(x1 * cs.x - x2 * cs.y, x1 * cs.y + x2 * cs.x);
            KPE[(size_t)m * 64 + F.lane] = (bf16_t)(a & 0xffffu); KPE[(size_t)m * 64 + 32 + F.lane] = (bf16_t)(a >> 16);
        }
    }
}
__device__ __forceinline__ void cmp_stage2_unit(Frame& F, int unit, int l) {
    const int kv = unit >> 6, u = unit & 63, g = u >> 5, r0 = (u & 31) * 16;
    const int NO = kv ? 128 : 192;
    const float* part = (const float*)(F.ws + WS_PART); const float* pb = (const float*)(F.ws + WS_TBL + 8192) + (l * 2 + kv) * 256;
    const float* w2 = F.in[kv ? I_W2V : I_W2K] + (size_t)l * 256 * NO;
    LAS float* hid = (LAS float*)F.lds;
    __syncthreads();
    {
        const int row = F.tid >> 5, c0 = (F.tid & 31) * 8, rp = r0 + row, rt = rp >> 8, rr = rp & 255;
        f32x4 s0 = *(const f32x4*)(pb + c0), s1 = *(const f32x4*)(pb + c0 + 4);
#pragma unroll
        for (int s = 0; s < 8; ++s) { const float* p = part + (size_t)((((kv * 2 + g) * 2 + rt) * 8) + s) * 65536 + (size_t)rr * 256 + c0; s0 += *(const f32x4*)p; s1 += *(const f32x4*)(p + 4); }
        float h[8] = {s0.x, s0.y, s0.z, s0.w, s1.x, s1.y, s1.z, s1.w};
#pragma unroll
        for (int e = 0; e < 8; ++e) hid[row * 256 + c0 + e] = h[e] * sigmoidf_(h[e]);
    }
    __syncthreads();
    bf16_t* dst = (bf16_t*)(F.ws + WS_KC + (kv ? 524288 : 0));
    for (int o = F.tid; o < 16 * NO; o += 512) {
        const int row = o / NO, n = o % NO; float a = 0.f;
#pragma unroll 8
        for (int c = 0; c < 256; ++c) a += hid[row * 256 + c] * w2[c * NO + n];
        const int rp = r0 + row, b = rp >> 7, nn = rp & 127;
        dst[(size_t)((b * 2 + g) * 128 + nn) * NO + n] = (bf16_t)(cvtpk(a, 0.f) & 0xffffu);
    }
}

template <bool ROPE>
__device__ __forceinline__ void load_q(Frame& F, const bf16_t* qp, float scale, LAS float* qs, const f32x2* rope_row) {
    if (F.lane < 24) { const u32x4 w = *((const u32x4*)qp + F.lane); LAS float* d = qs + 8 * F.lane;
        d[0] = bflo(w.x) * scale; d[1] = bfhi(w.x) * scale; d[2] = bflo(w.y) * scale; d[3] = bfhi(w.y) * scale; d[4] = bflo(w.z) * scale; d[5] = bfhi(w.z) * scale; d[6] = bflo(w.w) * scale; d[7] = bfhi(w.w) * scale; }
    if (ROPE) { if (F.lane < 32) { const float x1 = qs[128 + F.lane], x2 = qs[160 + F.lane]; const f32x2 cs = rope_row[F.lane]; qs[128 + F.lane] = x1 * cs.x - x2 * cs.y; qs[160 + F.lane] = x1 * cs.y + x2 * cs.x; } }
}
__device__ __forceinline__ float dot8(const u32x4 w, const LAS float* q) {
    const f32x4 a = *(const LAS f32x4*)q, b = *(const LAS f32x4*)(q + 4);
    return (bflo(w.x) * a.x + bfhi(w.x) * a.y) + (bflo(w.y) * a.z + bfhi(w.y) * a.w) + (bflo(w.z) * b.x + bfhi(w.z) * b.y) + (bflo(w.w) * b.z + bfhi(w.w) * b.w);
}
template <int MODE>
__device__ __forceinline__ void naive_row(Frame& F, int b, int t, int head, float gate, float& o0, float& o1, LAS float* sc, const LAS float* qs, unsigned selmask, int& nk_out) {
    const int g = head >> 2; const size_t mb = (size_t)b * SEQ;
    const bf16_t* Z = (const bf16_t*)(F.ws + WS_Z); const bf16_t* KV = (const bf16_t*)(F.ws + WS_KV); const bf16_t* KPE = (const bf16_t*)(F.ws + WS_KPE);
    const bf16_t* KC = (const bf16_t*)(F.ws + WS_KC); const bf16_t* VC = (const bf16_t*)(F.ws + WS_KC + 524288);
    const float* tbl = (const float*)(F.ws + WS_TBL) + head * 132; const int* pos = (const int*)F.in[I_POS] + mb;
    const int k0 = (MODE == 2) ? (t > 511 ? t - 511 : 0) : 0;
    const int k1 = (MODE == 3) ? (t < 31 ? -1 : (t - 31) / 16) : t;
    nk_out = k1 - k0 + 1;
    if (k1 < k0) return;
    const int qpos = (MODE != 0) ? pos[t] : 0;
    float mx = -INFINITY;
    for (int kb = k0; kb <= k1; kb += 64) {
        const int k = kb + F.lane; bool valid = k <= k1;
        if (MODE == 1) valid = valid && ((selmask >> (k >> 6)) & 1u);
        float s = -INFINITY;
        if (valid) {
            const bf16_t* p1; const bf16_t* p2;
            if (MODE == 0) { p1 = KV + (mb + k) * 2048 + head * 128; p2 = KPE + (mb + k) * 64; }
            else if (MODE == 1) { p1 = Z + (mb + k) * DINP + ZO_KS + g * 192; p2 = p1 + 128; }
            else if (MODE == 2) { p1 = Z + (mb + k) * DINP + ZO_KW + g * 192; p2 = p1 + 128; }
            else { p1 = KC + (size_t)((b * 2 + g) * 128 + k) * 192; p2 = p1 + 128; }
            float d = 0.f;
#pragma unroll
            for (int c = 0; c < 16; ++c) d += dot8(*((const u32x4*)p1 + c), qs + 8 * c);
#pragma unroll
            for (int c = 0; c < 8; ++c) d += dot8(*((const u32x4*)p2 + c), qs + 128 + 8 * c);
            if (MODE != 0) { const int kp = (MODE == 3) ? pos[16 * k + 31] : pos[k]; int dd = qpos - kp; dd = dd < 0 ? 0 : (dd > 128 ? 128 : dd); d += tbl[dd]; }
            s = d;
        }
        if (k <= k1) sc[k - k0] = s;
        mx = fmaxf(mx, s);
    }
    mx = wave_max(mx);
    float sum = 0.f;
    for (int kb = k0; kb <= k1; kb += 64) { const int k = kb + F.lane; if (k <= k1) { const float p = __expf(sc[k - k0] - mx); sc[k - k0] = p; sum += p; } }
    sum = wave_sum(sum);
    const float inv = 1.0f / sum;
    float a0 = 0.f, a1 = 0.f;
    for (int k = k0; k <= k1; ++k) {
        if (MODE == 1) { if (!((selmask >> (k >> 6)) & 1u)) { k |= 63; continue; } }
        const float p = sc[k - k0];
        const bf16_t* vp;
        if (MODE == 0) vp = KV + (mb + k) * 2048 + 1024 + head * 128;
        else if (MODE == 1) vp = Z + (mb + k) * DINP + ZO_VS + g * 128;
        else if (MODE == 2) vp = Z + (mb + k) * DINP + ZO_VW + g * 128;
        else vp = VC + (size_t)((b * 2 + g) * 128 + k) * 128;
        const unsigned w = *((const unsigned*)vp + F.lane);
        a0 += p * bflo(w); a1 += p * bfhi(w);
    }
    o0 += gate * inv * a0; o1 += gate * inv * a1;
    if (MODE == 3) { for (int kb = 0; kb <= k1; kb += 64) { const int k = kb + F.lane; if (k <= k1) sc[k] *= inv; } }
}
__device__ __forceinline__ void naive_cmp_phase(Frame& F) {
    const int gw = F.cu * 8 + F.wave, NGW = F.G * 8;
    LAS float* sc = (LAS float*)(F.lds + F.wave * 8192); LAS float* qs = (LAS float*)(F.lds + 65536 + F.wave * 1024); LAS float* ps = (LAS float*)(F.lds + 65536 + 8192 + F.wave * 512);
    const bf16_t* Z = (const bf16_t*)(F.ws + WS_Z); float* OC = (float*)(F.ws + WS_OC); unsigned* SEL = (unsigned*)(F.ws + WS_SEL);
    for (int r = gw; r < M * 2; r += NGW) {
        const int g = r & 1, m = r >> 1, b = m / SEQ, t = m % SEQ;
        ps[F.lane] = 0.f; ps[F.lane + 64] = 0.f;
        for (int j = 0; j < 4; ++j) {
            const int head = g * 4 + j; int nk = 0;
            load_q<false>(F, Z + (size_t)m * DINP + ZO_NQ + head * 192, 0.07216878364870322f, qs, nullptr);
            float o0 = 0.f, o1 = 0.f;
            const float g0 = sigmoidf_(bf1(Z[(size_t)m * DINP + ZO_NG + head * 3 + 0]));
            naive_row<3>(F, b, t, head, g0, o0, o1, sc, qs, 0u, nk);
            *(f32x2*)(OC + (size_t)m * 1024 + head * 128 + 2 * F.lane) = (f32x2){o0, o1};
            if (F.lane < nk) ps[F.lane] += sc[F.lane];
            if (F.lane + 64 < nk) ps[F.lane + 64] += sc[F.lane + 64];
        }
        const int mm = F.lane & 31; float imp = 0.f;
#pragma unroll
        for (int n = -1; n < 4; ++n) { const int nn = 4 * mm + n; if (nn >= 0 && nn < 128) imp += ps[nn]; }
        const int cur = t >> 6; const bool valid = mm <= cur, forced = valid && (mm == 0 || mm >= cur - 1);
        const float scv = forced ? 1e6f : (valid ? imp : -1.0f);
        int rank = 0;
#pragma unroll
        for (int o = 0; o < 32; ++o) { const float v = __shfl(scv, o); rank += (v > scv || (v == scv && o < mm)) ? 1 : 0; }
        const bool sel = (rank < 16) && (scv >= 0.f) && (F.lane < 32);
        const unsigned long long bal = __ballot(sel);
        if (F.lane == 0) SEL[(size_t)(b * 2 + g) * SEQ + t] = (unsigned)bal;
    }
}
__device__ __forceinline__ void naive_attn_phase(Frame& F) {
    const int gw = F.cu * 8 + F.wave, NGW = F.G * 8;
    LAS float* sc = (LAS float*)(F.lds + F.wave * 8192); LAS float* qs = (LAS float*)(F.lds + 65536 + F.wave * 1024);
    const bf16_t* Z = (const bf16_t*)(F.ws + WS_Z); const bf16_t* QM = (const bf16_t*)(F.ws + WS_QM); bf16_t* AB = (bf16_t*)(F.ws + WS_AB);
    const float* OC = (const float*)(F.ws + WS_OC); const unsigned* SEL = (const unsigned*)(F.ws + WS_SEL); const f32x2* rope = (const f32x2*)(F.ws + WS_ROPE);
    for (int r = gw; r < M * 8; r += NGW) {
        const int head = r & 7, m = r >> 3, b = m / SEQ, t = m % SEQ; int nk;
        load_q<true>(F, QM + (size_t)m * 1536 + head * 192, 0.07216878364870322f, qs, rope + (size_t)m * 32);
        float o0 = 0.f, o1 = 0.f;
        naive_row<0>(F, b, t, head, 1.0f, o0, o1, sc, qs, 0u, nk);
        *((unsigned*)(AB + (size_t)m * 2048 + head * 128) + F.lane) = cvtpk(o0, o1);
    }
    for (int r = gw; r < M * 8; r += NGW) {
        const int head = r & 7, m = r >> 3, b = m / SEQ, t = m % SEQ, g = head >> 2; int nk;
        const unsigned selmask = (unsigned)__builtin_amdgcn_readfirstlane((int)SEL[(size_t)(b * 2 + g) * SEQ + t]);
        load_q<false>(F, Z + (size_t)m * DINP + ZO_NQ + head * 192, 0.07216878364870322f, qs, nullptr);
        const float g1 = sigmoidf_(bf1(Z[(size_t)m * DINP + ZO_NG + head * 3 + 1])), g2 = sigmoidf_(bf1(Z[(size_t)m * DINP + ZO_NG + head * 3 + 2]));
        const f32x2 oc = *(const f32x2*)(OC + (size_t)m * 1024 + head * 128 + 2 * F.lane);
        float o0 = oc.x, o1 = oc.y;
        naive_row<1>(F, b, t, head, g1, o0, o1, sc, qs, selmask, nk);
        naive_row<2>(F, b, t, head, g2, o0, o1, sc, qs, 0u, nk);
        *((unsigned*)(AB + (size_t)m * 2048 + 1024 + head * 128) + F.lane) = cvtpk(o0, o1);
    }
}

namespace att {
typedef float f32x16 __attribute__((ext_vector_type(16)));
typedef short s16x4 __attribute__((ext_vector_type(4)));
typedef int i32x4 __attribute__((ext_vector_type(4)));
constexpr int KROW = 400, KBUF = 64 * KROW, VBUF = 64 * 256;
constexpr int L_K = 0, L_V = 2 * KBUF, L_KPOS = L_V + 2 * VBUF, L_KPMAX = L_KPOS + 512, L_TBL = L_KPMAX + 64, L_MISC = L_TBL + 8 * 132 * 4;
static_assert(L_MISC + 256 <= RING_BYTES, "attention LDS map");
constexpr float SL = 0.07216878364870322f * 1.4426950408889634f;
__device__ const unsigned char CLS_TYPE[40] = {1,1,1,1,1,1,1,1,1,0,1,1,1,1,0,1,1,1,1,0,1,1,1,1,0,1,1,1,0,1,1,0,1,1,0,1,1,0,1,1};
__device__ const unsigned char CLS_QB[40] = {31,30,29,28,27,26,25,24,23,7,22,21,20,19,6,18,17,16,15,5,14,13,12,11,4,10,9,8,3,7,6,2,5,4,1,3,2,0,1,0};
__device__ const unsigned short CLS_START[41] = {0,8,16,24,32,40,48,56,64,72,104,112,120,128,136,168,176,184,192,200,232,240,248,256,264,296,304,312,320,352,360,368,400,408,416,448,456,464,496,504,512};
__device__ __forceinline__ unsigned offb(unsigned row, unsigned ch) { return 256u * row + 16u * (ch ^ (((row & 3u) << 2) | ((row >> 2) & 3u))); }
struct Src { const bf16_t* k1; const bf16_t* k2; const bf16_t* v; int ldk1, ldk2, ldv; };
struct Stage { u32x4 k[3]; u32x4 v[2]; int kp; };
template <bool SAMELD = true>
__device__ __forceinline__ void stage_load(Stage& st, const Src& s, int tile, int tid, const int* posb) {
    const unsigned vo1 = (unsigned)((tid >> 4) * s.ldk1 + (tid & 15) * 8) * 2u, vo2 = (unsigned)((tid >> 3) * s.ldk2 + (tid & 7) * 8) * 2u;
    const char* b1 = (const char*)s.k1 + (size_t)tile * 64 * s.ldk1 * 2; const char* b2 = (const char*)s.k2 + (size_t)tile * 64 * s.ldk2 * 2; const char* bv = (const char*)s.v + (size_t)tile * 64 * s.ldv * 2;
    st.k[0] = *(const u32x4*)(b1 + vo1); st.k[1] = *(const u32x4*)(b1 + (size_t)32 * s.ldk1 * 2 + vo1); st.k[2] = *(const u32x4*)(b2 + vo2);
    const unsigned vov = SAMELD ? vo1 : (unsigned)((tid >> 4) * s.ldv + (tid & 15) * 8) * 2u;
    st.v[0] = *(const u32x4*)(bv + vov); st.v[1] = *(const u32x4*)(bv + (size_t)32 * s.ldv * 2 + vov);
    if (posb != nullptr && tid < 64) st.kp = posb[tile * 64 + tid];
}
__device__ __forceinline__ void stage_store(const Stage& st, LAS unsigned char* lds, int buf, int tid, bool haspos) {
    const int rowA = tid >> 4, chA = tid & 15;
    LAS unsigned char* ka = lds + L_K + buf * KBUF + rowA * KROW + chA * 16;
    *(LAS u32x4*)ka = st.k[0]; *(LAS u32x4*)(ka + 32 * KROW) = st.k[1];
    *(LAS u32x4*)(lds + L_K + buf * KBUF + (tid >> 3) * KROW + (16 + (tid & 7)) * 16) = st.k[2];
    LAS unsigned char* va = lds + L_V + buf * VBUF + offb(rowA, chA);
    *(LAS u32x4*)va = st.v[0]; *(LAS u32x4*)(va + 8192) = st.v[1];
    if (haspos && tid < 64) { ((LAS int*)(lds + L_KPOS))[buf * 64 + tid] = st.kp; int mx = st.kp;
#pragma unroll
        for (int o = 1; o < 64; o <<= 1) { const int t = __shfl_xor(mx, o); mx = t > mx ? t : mx; }
        if (tid == 0) ((LAS int*)(lds + L_KPMAX))[buf] = mx; }
}
__device__ __forceinline__ s16x4 vtr(const LAS unsigned char* p) { typedef short v4i16_t __attribute__((ext_vector_type(4))); return __builtin_bit_cast(s16x4, __builtin_amdgcn_ds_read_tr16_b64_v4i16((LAS v4i16_t*)p)); }

__device__ __forceinline__ unsigned vtr_off(int lane_, int c, int tp) {
    const unsigned q4 = (lane_ & 15) >> 2, p = lane_ & 3, blk = (lane_ >> 4) & 1, h2 = lane_ >> 5;
    return 256u * (8u * tp + 4u * h2 + q4) + 16u * ((((unsigned)c ^ q4) << 2) | ((2u * blk + (p >> 1)) ^ (2u * tp + h2))) + 8u * (p & 1u);
}
#define ATT_ZERO16 {0.f,0.f,0.f,0.f,0.f,0.f,0.f,0.f,0.f,0.f,0.f,0.f,0.f,0.f,0.f,0.f}
template <int MODE>
__device__ __forceinline__ void run_pass(Frame& F, const Src& src, unsigned tmask, const bf16x8 (&qf)[12], f32x16 (&oacc)[4], float& m_run, float& l_run,
                                         int tq, int tq_wmin, int tq_wmax, unsigned selq, int qpos, int qpos_wmin, int head, const int* posb) {
    if (tmask == 0u) return;
    const int tid = F.tid, lane = F.lane, r = lane & 31, hh = lane >> 5;
    LAS unsigned char* lds = F.lds;
    int tile = __builtin_ctz(tmask); unsigned rem = tmask & (tmask - 1u);
    Stage st; st.kp = 0;
    stage_load(st, src, tile, tid, posb); stage_store(st, lds, 0, tid, posb != nullptr); __syncthreads();
    int buf = 0;
    const LAS float* tblh = (const LAS float*)(lds + L_TBL) + head * 132;
    for (;;) {
        const int nxt = rem ? __builtin_ctz(rem) : -1;
        if (nxt >= 0) stage_load(st, src, nxt, tid, posb);
        const bool active = (MODE != 0) || (tile * 64 <= tq_wmax);
        if (active) {
            const LAS unsigned char* kb_ = lds + L_K + buf * KBUF + r * KROW + 16 * hh;
            const LAS unsigned char* vbuf = lds + L_V + buf * VBUF;
            bool far = true; if (MODE != 0) { const int kpmax = __builtin_amdgcn_readfirstlane(((const LAS int*)(lds + L_KPMAX))[buf]); far = (qpos_wmin - kpmax >= 128); }
            int lim = tq - tile * 64 - 4 * hh;
            if (MODE == 1) { if (!((selq >> tile) & 1u)) lim = -1; }
            const bool need = (MODE == 1) || (MODE == 2) || (tile * 64 + 63 > tq_wmin);
#pragma unroll
            for (int kb = 0; kb < 2; ++kb) {
                f32x16 sa = ATT_ZERO16;
#pragma unroll
                for (int s = 0; s < 12; ++s) { const bf16x8 a0 = *(const LAS bf16x8*)(kb_ + kb * 32 * KROW + 32 * s); sa = __builtin_amdgcn_mfma_f32_32x32x16_bf16(a0, qf[s], sa, 0, 0, 0); }
                float x[16];
                if (MODE == 0) {
#pragma unroll
                    for (int i = 0; i < 16; ++i) x[i] = sa[i] * SL;
                } else if (far) { const float cb = tblh[128];
#pragma unroll
                    for (int i = 0; i < 16; ++i) x[i] = sa[i] * SL + cb;
                } else {
                    const LAS int* kp = (const LAS int*)(lds + L_KPOS) + buf * 64 + 4 * hh + 32 * kb;
#pragma unroll
                    for (int g4 = 0; g4 < 4; ++g4) { const i32x4 kv = *(const LAS i32x4*)(kp + 8 * g4);
#pragma unroll
                        for (int e = 0; e < 4; ++e) { int d = qpos - kv[e]; d = d < 0 ? 0 : (d > 128 ? 128 : d); x[4 * g4 + e] = sa[4 * g4 + e] * SL + tblh[d]; } }
                }
                if (need) {
#pragma unroll
                    for (int i = 0; i < 16; ++i) { const int ci = 32 * kb + 8 * (i >> 2) + (i & 3); if (ci > lim) x[i] = -INFINITY; if (MODE == 2) { if (ci <= lim - 512) x[i] = -INFINITY; } }
                }
                float ml = x[0];
#pragma unroll
                for (int i = 1; i < 16; ++i) ml = fmaxf(ml, x[i]);
                ml = fmaxf(ml, __shfl_xor(ml, 32));
                const float mnew = fmaxf(m_run, ml), alpha = __builtin_amdgcn_exp2f(m_run - mnew);
                m_run = mnew;
                float ps = 0.f;
#pragma unroll
                for (int i = 0; i < 16; ++i) { x[i] = __builtin_amdgcn_exp2f(x[i] - mnew); ps += x[i]; }
                l_run = l_run * alpha + ps;
                if (!__all(alpha == 1.0f)) {
#pragma unroll
                    for (int c = 0; c < 4; ++c) oacc[c] = oacc[c] * alpha;
                }
                bf16x8 pf[2];
#pragma unroll
                for (int k2 = 0; k2 < 2; ++k2) { u32x4 w; w.x = cvtpk(x[8 * k2 + 0], x[8 * k2 + 1]); w.y = cvtpk(x[8 * k2 + 2], x[8 * k2 + 3]); w.z = cvtpk(x[8 * k2 + 4], x[8 * k2 + 5]); w.w = cvtpk(x[8 * k2 + 6], x[8 * k2 + 7]); pf[k2] = __builtin_bit_cast(bf16x8, w); }
#pragma unroll
                for (int c = 0; c < 4; ++c) { int lane_ = lane; asm volatile("" : "+v"(lane_)); const unsigned v0 = vtr_off(lane_, c, 0), v1 = vtr_off(lane_, c, 1);
#pragma unroll
                    for (int k2 = 0; k2 < 2; ++k2) { const int ks = 2 * kb + k2; const s16x4 lo = vtr(vbuf + v0 + ks * 4096), hi = vtr(vbuf + v1 + ks * 4096);
                        const bf16x8 a = {lo[0], lo[1], lo[2], lo[3], hi[0], hi[1], hi[2], hi[3]};
                        oacc[c] = __builtin_amdgcn_mfma_f32_32x32x16_bf16(a, pf[k2], oacc[c], 0, 0, 0); } }
            }
        }
        if (nxt >= 0) stage_store(st, lds, buf ^ 1, tid, posb != nullptr);
        __syncthreads();
        if (nxt < 0) break;
        tile = nxt; rem &= rem - 1u; buf ^= 1;
    }
}
template <bool ROPE>
__device__ __forceinline__ void load_qfrags(bf16x8 (&qf)[12], const bf16_t* qrow, int hh, const f32x2* rope_row) {
#pragma unroll
    for (int s = 0; s < 12; ++s) qf[s] = *(const bf16x8*)(qrow + 16 * s + 8 * hh);
    if (ROPE) {
#pragma unroll
        for (int pr = 0; pr < 2; ++pr) {
            const int i0 = 16 * pr + 8 * hh; bf16x8 a = qf[8 + pr], b = qf[10 + pr];
#pragma unroll
            for (int j = 0; j < 8; ++j) { const f32x2 cs = rope_row[i0 + j]; const float x1 = bf1((bf16_t)a[j]), x2 = bf1((bf16_t)b[j]);
                const unsigned w = cvtpk(x1 * cs.x - x2 * cs.y, x1 * cs.y + x2 * cs.x); a[j] = (short)(w & 0xffffu); b[j] = (short)(w >> 16); }
            qf[8 + pr] = a; qf[10 + pr] = b;
        }
    }
}
__device__ __forceinline__ void mla_unit(Frame& F, int b, int h, int qb) {
    const int lane = F.lane, r = lane & 31, hh = lane >> 5, w = F.wave;
    const int t0 = 256 * qb, tq = t0 + 32 * w + r; const size_t m = (size_t)b * SEQ + tq;
    const bf16_t* KV = (const bf16_t*)(F.ws + WS_KV);
    Src src{KV + (size_t)b * SEQ * 2048 + h * 128, (const bf16_t*)(F.ws + WS_KPE) + (size_t)b * SEQ * 64, KV + (size_t)b * SEQ * 2048 + 1024 + h * 128, 2048, 64, 2048};
    bf16x8 qf[12]; load_qfrags<true>(qf, (const bf16_t*)(F.ws + WS_QM) + m * 1536 + h * 192, hh, (const f32x2*)(F.ws + WS_ROPE) + m * 32);
    f32x16 oacc[4] = {ATT_ZERO16, ATT_ZERO16, ATT_ZERO16, ATT_ZERO16}; float m_run = -1e30f, l_run = 0.f;
    const unsigned tmask = (qb == 7) ? 0xffffffffu : ((1u << (4 * qb + 4)) - 1u);
    run_pass<0>(F, src, tmask, qf, oacc, m_run, l_run, tq, t0 + 32 * w, t0 + 32 * w + 31, 0u, 0, 0, h, nullptr);
    const float inv = 1.0f / (l_run + __shfl_xor(l_run, 32));
    bf16_t* o = (bf16_t*)(F.ws + WS_AB) + m * 2048 + h * 128 + 4 * hh;
#pragma unroll
    for (int c = 0; c < 4; ++c)
#pragma unroll
        for (int g4 = 0; g4 < 4; ++g4) *(u32x2*)(o + 32 * c + 8 * g4) = (u32x2){cvtpk(oacc[c][4 * g4] * inv, oacc[c][4 * g4 + 1] * inv), cvtpk(oacc[c][4 * g4 + 2] * inv, oacc[c][4 * g4 + 3] * inv)};
}
__device__ __forceinline__ void nsa_unit(Frame& F, int b, int g, int qb) {
    const int lane = F.lane, r = lane & 31, hh = lane >> 5, w = F.wave, head = 4 * g + (w >> 1);
    const int t0 = 64 * qb, tq = t0 + 32 * (w & 1) + r; const size_t m = (size_t)b * SEQ + tq;
    const bf16_t* Zb = (const bf16_t*)(F.ws + WS_Z) + (size_t)b * SEQ * DINP; const bf16_t* zr = (const bf16_t*)(F.ws + WS_Z) + m * DINP;
    const unsigned* SELb = (const unsigned*)(F.ws + WS_SEL) + (size_t)(b * 2 + g) * SEQ; const int* posb = (const int*)F.in[I_POS] + (size_t)b * SEQ;
    LAS unsigned* misc = (LAS unsigned*)(F.lds + L_MISC);
    if (w == 0) { unsigned v = SELb[t0 + lane];
#pragma unroll
        for (int o = 1; o < 64; o <<= 1) v |= (unsigned)__shfl_xor((int)v, o);
        if (lane == 0) misc[4] = v; }
    const unsigned selq = SELb[tq]; const int qpos = posb[tq]; int qmin = qpos;
#pragma unroll
    for (int o = 1; o < 64; o <<= 1) { const int t = __shfl_xor(qmin, o); qmin = t < qmin ? t : qmin; }
    qmin = __builtin_amdgcn_readfirstlane(qmin);
    bf16x8 qf[12]; load_qfrags<false>(qf, zr + ZO_NQ + head * 192, hh, nullptr);
    __syncthreads();
    const unsigned causal = (qb == 31) ? 0xffffffffu : ((2u << qb) - 1u);
    const unsigned umask = (unsigned)__builtin_amdgcn_readfirstlane((int)misc[4]) & causal;
    const int wlo = qb > 8 ? qb - 8 : 0; const unsigned wmask = causal & ~((1u << wlo) - 1u);
    f32x16 oacc[4] = {ATT_ZERO16, ATT_ZERO16, ATT_ZERO16, ATT_ZERO16}; float m_run = -1e30f, l_run = 0.f;
    {
        Src src{Zb + ZO_KS + g * 192, Zb + ZO_KS + g * 192 + 128, Zb + ZO_VS + g * 128, DINP, DINP, DINP};
        run_pass<1>(F, src, umask, qf, oacc, m_run, l_run, tq, t0 + 32 * (w & 1), t0 + 32 * (w & 1) + 31, selq, qpos, qmin, head, posb);
        asm volatile("" ::: "memory");
        const size_t m1 = (size_t)b * SEQ + t0 + 32 * (w & 1) + (F.lane & 31);
        const float g1 = sigmoidf_(bf1(((const bf16_t*)(F.ws + WS_Z))[m1 * DINP + ZO_NG + head * 3 + 1]));
        bf16_t* o = (bf16_t*)(F.ws + WS_AB) + m1 * 2048 + 1024 + head * 128 + 4 * (F.lane >> 5); const float* oc = (const float*)(F.ws + WS_OC) + m1 * 1024 + head * 128 + 4 * (F.lane >> 5);
        const float inv = g1 / (l_run + __shfl_xor(l_run, 32));
#pragma unroll
        for (int c = 0; c < 4; ++c)
#pragma unroll
            for (int g4 = 0; g4 < 4; ++g4) { const f32x4 cv = *(const f32x4*)(oc + 32 * c + 8 * g4);
                *(u32x2*)(o + 32 * c + 8 * g4) = (u32x2){cvtpk(oacc[c][4 * g4] * inv + cv.x, oacc[c][4 * g4 + 1] * inv + cv.y), cvtpk(oacc[c][4 * g4 + 2] * inv + cv.z, oacc[c][4 * g4 + 3] * inv + cv.w)}; }
    }
#pragma unroll
    for (int c = 0; c < 4; ++c) oacc[c] = (f32x16)ATT_ZERO16;
    m_run = -1e30f; l_run = 0.f;
    {
        Src src{Zb + ZO_KW + g * 192, Zb + ZO_KW + g * 192 + 128, Zb + ZO_VW + g * 128, DINP, DINP, DINP};
        run_pass<2>(F, src, wmask, qf, oacc, m_run, l_run, tq, t0 + 32 * (w & 1), t0 + 32 * (w & 1) + 31, 0u, qpos, qmin, head, posb);
        asm volatile("" ::: "memory");
        const size_t m1 = (size_t)b * SEQ + t0 + 32 * (w & 1) + (F.lane & 31);
        const float g2 = sigmoidf_(bf1(((const bf16_t*)(F.ws + WS_Z))[m1 * DINP + ZO_NG + head * 3 + 2]));
        bf16_t* o = (bf16_t*)(F.ws + WS_AB) + m1 * 2048 + 1024 + head * 128 + 4 * (F.lane >> 5);
        const float inv = g2 / (l_run + __shfl_xor(l_run, 32));
#pragma unroll
        for (int c = 0; c < 4; ++c)
#pragma unroll
            for (int g4 = 0; g4 < 4; ++g4) { const u32x2 pv = *(const u32x2*)(o + 32 * c + 8 * g4);
                *(u32x2*)(o + 32 * c + 8 * g4) = (u32x2){cvtpk(oacc[c][4 * g4] * inv + bflo(pv.x), oacc[c][4 * g4 + 1] * inv + bfhi(pv.x)), cvtpk(oacc[c][4 * g4 + 2] * inv + bflo(pv.y), oacc[c][4 * g4 + 3] * inv + bfhi(pv.y))}; }
    }
}
__device__ __forceinline__ void cmp_unit(Frame& F, int b, int g, int qb) {
    const int tid = F.tid, lane = F.lane, r = lane & 31, hh = lane >> 5, w = F.wave;
    const int t0 = 256 * qb, tq = t0 + 32 * w + r; const size_t m = (size_t)b * SEQ + tq;
    LAS unsigned char* lds = F.lds;
    const int* posb = (const int*)F.in[I_POS] + (size_t)b * SEQ;
    {
        Src src{(const bf16_t*)(F.ws + WS_KC) + (size_t)(b * 2 + g) * 128 * 192, (const bf16_t*)(F.ws + WS_KC) + (size_t)(b * 2 + g) * 128 * 192 + 128, (const bf16_t*)(F.ws + WS_KC + 524288) + (size_t)(b * 2 + g) * 128 * 128, 192, 192, 128};
        Stage st; st.kp = 0;
        stage_load<false>(st, src, 0, tid, nullptr); stage_store(st, lds, 0, tid, false);
        stage_load<false>(st, src, 1, tid, nullptr); stage_store(st, lds, 1, tid, false);
        if (tid < 128) { int kt = 16 * tid + 31; kt = kt > SEQ - 1 ? SEQ - 1 : kt; ((LAS int*)(lds + L_KPOS))[tid] = posb[kt]; }
    }
    __syncthreads();
    const int qpos = posb[tq];
    const int nmax = tq >= 31 ? (tq - 31) >> 4 : -1;
    float imp[16];
#pragma unroll
    for (int i = 0; i < 16; ++i) imp[i] = 0.f;
    const LAS unsigned char* kb_ = lds + L_K + r * KROW + 16 * hh;
    const LAS unsigned char* vbuf = lds + L_V;
    const bf16_t* zr = (const bf16_t*)(F.ws + WS_Z) + m * DINP;
#pragma unroll 1
    for (int j = 0; j < 4; ++j) {
        const int head = 4 * g + j;
        const LAS float* tblh = (const LAS float*)(lds + L_TBL) + head * 132;
        bf16x8 qf[12]; load_qfrags<false>(qf, zr + ZO_NQ + head * 192, hh, nullptr);
        float m_run = -1e30f, l_run = 0.f;
#define CMP_SCORES(kb) \
                f32x16 sa = ATT_ZERO16; \
                _Pragma("unroll") for (int s = 0; s < 12; ++s) { const bf16x8 a0 = *(const LAS bf16x8*)(kb_ + (kb) * 32 * KROW + 32 * s); sa = __builtin_amdgcn_mfma_f32_32x32x16_bf16(a0, qf[s], sa, 0, 0, 0); } \
                float x[16]; \
                { const LAS int* kp = (const LAS int*)(lds + L_KPOS) + 4 * hh + 32 * (kb); int nm_ = nmax; asm volatile("" : "+v"(nm_)); const int lim = nm_ - 32 * (kb) - 4 * hh; \
                _Pragma("unroll") for (int g4 = 0; g4 < 4; ++g4) { const i32x4 kv = *(const LAS i32x4*)(kp + 8 * g4); \
                    _Pragma("unroll") for (int e = 0; e < 4; ++e) { int d = qpos - kv[e]; d = d < 0 ? 0 : (d > 128 ? 128 : d); const float v = sa[4 * g4 + e] * SL + tblh[d]; x[4 * g4 + e] = (8 * g4 + e > lim) ? -INFINITY : v; } } }
#pragma unroll
        for (int kb = 0; kb < 4; ++kb) {
            CMP_SCORES(kb)
            float ml = x[0];
#pragma unroll
            for (int i = 1; i < 16; ++i) ml = fmaxf(ml, x[i]);
            ml = fmaxf(ml, __shfl_xor(ml, 32));
            const float mnew = fmaxf(m_run, ml), alpha = __builtin_amdgcn_exp2f(m_run - mnew); m_run = mnew;
            float ps = 0.f;
#pragma unroll
            for (int i = 0; i < 16; ++i) ps += __builtin_amdgcn_exp2f(x[i] - mnew);
            l_run = l_run * alpha + ps;
            asm volatile("" ::: "memory");
        }
        const float lt = l_run + __shfl_xor(l_run, 32), inv = lt > 0.f ? 1.0f / lt : 0.f;
        f32x16 oacc[4] = {ATT_ZERO16, ATT_ZERO16, ATT_ZERO16, ATT_ZERO16};
        float carry = 0.f;
#pragma unroll
        for (int kb = 0; kb < 4; ++kb) {
            CMP_SCORES(kb)
#pragma unroll
            for (int i = 0; i < 16; ++i) x[i] = __builtin_amdgcn_exp2f(x[i] - m_run) * inv;
#pragma unroll
            for (int g4 = 0; g4 < 4; ++g4) { const float e3 = x[4 * g4 + 3], sw = __shfl_xor(e3, 32);
                imp[4 * kb + g4] += ((x[4 * g4] + x[4 * g4 + 1]) + (x[4 * g4 + 2] + e3)) + (hh ? sw : carry); carry = sw; }
            bf16x8 pf[2];
#pragma unroll
            for (int k2 = 0; k2 < 2; ++k2) { u32x4 wv; wv.x = cvtpk(x[8 * k2 + 0], x[8 * k2 + 1]); wv.y = cvtpk(x[8 * k2 + 2], x[8 * k2 + 3]); wv.z = cvtpk(x[8 * k2 + 4], x[8 * k2 + 5]); wv.w = cvtpk(x[8 * k2 + 6], x[8 * k2 + 7]); pf[k2] = __builtin_bit_cast(bf16x8, wv); }
#pragma unroll
            for (int c = 0; c < 4; ++c) { int lane_ = lane; asm volatile("" : "+v"(lane_)); const unsigned v0 = vtr_off(lane_, c, 0), v1 = vtr_off(lane_, c, 1);
#pragma unroll
                for (int k2 = 0; k2 < 2; ++k2) { const int ks = 2 * kb + k2; const s16x4 lo = vtr(vbuf + v0 + ks * 4096), hi = vtr(vbuf + v1 + ks * 4096);
                    const bf16x8 a = {lo[0], lo[1], lo[2], lo[3], hi[0], hi[1], hi[2], hi[3]};
                    oacc[c] = __builtin_amdgcn_mfma_f32_32x32x16_bf16(a, pf[k2], oacc[c], 0, 0, 0); } }
            asm volatile("" ::: "memory");
        }
#undef CMP_SCORES
        {
            const float g0 = sigmoidf_(bf1(zr[ZO_NG + head * 3 + 0]));
            float* oc = (float*)(F.ws + WS_OC) + m * 1024 + head * 128 + 4 * hh;
#pragma unroll
            for (int c = 0; c < 4; ++c)
#pragma unroll
                for (int g4 = 0; g4 < 4; ++g4) *(f32x4*)(oc + 32 * c + 8 * g4) = (f32x4){oacc[c][4 * g4] * g0, oacc[c][4 * g4 + 1] * g0, oacc[c][4 * g4 + 2] * g0, oacc[c][4 * g4 + 3] * g0};
        }
    }
    {
        LAS float* impl = (LAS float*)(lds + 90112);
#pragma unroll
        for (int i = 0; i < 4; ++i) *(LAS f32x4*)(impl + (w * 64 + lane) * 16 + 4 * i) = (f32x4){imp[4 * i], imp[4 * i + 1], imp[4 * i + 2], imp[4 * i + 3]};
        asm volatile("s_waitcnt lgkmcnt(0)" ::: "memory");
        int lane2 = F.tid & 63; asm volatile("" : "+v"(lane2));
        const int hh2 = lane2 >> 5;
        const int cur = (t0 + 32 * w + (lane2 & 31)) >> 6; float own[16], oth[16];
#pragma unroll
        for (int i = 0; i < 4; ++i) { const f32x4 a = *(const LAS f32x4*)(impl + (w * 64 + lane2) * 16 + 4 * i), c = *(const LAS f32x4*)(impl + (w * 64 + (lane2 ^ 32)) * 16 + 4 * i);
            own[4 * i] = a.x; own[4 * i + 1] = a.y; own[4 * i + 2] = a.z; own[4 * i + 3] = a.w; oth[4 * i] = c.x; oth[4 * i + 1] = c.y; oth[4 * i + 2] = c.z; oth[4 * i + 3] = c.w; }
#pragma unroll
        for (int i = 0; i < 16; ++i) { const int mo = 2 * i + hh2, mp = 2 * i + 1 - hh2; const bool vo = mo <= cur, fo = vo && (mo == 0 || mo >= cur - 1), vp = mp <= cur, fp = vp && (mp == 0 || mp >= cur - 1);
            own[i] = fo ? 1e6f : (vo ? own[i] : -1.0f); oth[i] = fp ? 1e6f : (vp ? oth[i] : -1.0f); }
        unsigned bits = 0u;
#pragma unroll
        for (int i = 0; i < 16; ++i) { const float v = own[i]; int rank = 0;
#pragma unroll
            for (int k = 0; k < 16; ++k) {
                if (k < i) rank += (own[k] >= v) ? 1 : 0; else if (k > i) rank += (own[k] > v) ? 1 : 0;
                if (k < i) rank += (oth[k] >= v) ? 1 : 0; else if (k > i) rank += (oth[k] > v) ? 1 : 0; else rank += hh2 ? ((oth[k] >= v) ? 1 : 0) : ((oth[k] > v) ? 1 : 0);
                asm volatile("" : "+v"(rank)); }
            if (rank < 16 && v >= 0.f) bits |= 1u << (2 * i + hh2); }
        bits |= (unsigned)__shfl_xor((int)bits, 32);
        if (hh2 == 0) ((unsigned*)(F.ws + WS_SEL))[(size_t)(b * 2 + g) * SEQ + t0 + 32 * w + (lane2 & 31)] = bits;
    }
    __syncthreads();
}
__device__ __forceinline__ void cmp_phase(Frame& F) {
    LAS float* tblL = (LAS float*)(F.lds + L_TBL); const float* tg = (const float*)(F.ws + WS_TBL + 16384);
    for (int i = F.tid; i < 8 * 132; i += 512) tblL[i] = tg[i];
    __syncthreads();
    for (int u = F.cu; u < 64; u += F.G) cmp_unit(F, u >> 4, (u >> 3) & 1, u & 7);
}
constexpr int CW_QUEUE = 8192;
__device__ __forceinline__ void attn_phase(Frame& F, int l, int qoff = 0) {
    LAS float* tblL = (LAS float*)(F.lds + L_TBL); const float* tg = (const float*)(F.ws + WS_TBL + 16384);
    for (int i = F.tid; i < 8 * 132; i += 512) tblL[i] = tg[i];
    LAS unsigned* misc = (LAS unsigned*)(F.lds + L_MISC);
    unsigned* qctr = (unsigned*)(F.ws + WS_CTL) + CW_QUEUE + 64 * l + qoff;
    __syncthreads();
    for (;;) {
        launder(F);
        if (F.tid == 0) misc[0] = __hip_atomic_fetch_add(qctr, 1u, __ATOMIC_RELAXED, __HIP_MEMORY_SCOPE_AGENT);
        __syncthreads();
        const int u = __builtin_amdgcn_readfirstlane((int)misc[0]);
        __syncthreads();
        if (u >= 256) break;
        mla_unit(F, (u & 31) >> 3, u & 7, 7 - (u >> 5));
    }
    for (;;) {
        launder(F);
        if (F.tid == 0) misc[0] = __hip_atomic_fetch_add(qctr + 16, 1u, __ATOMIC_RELAXED, __HIP_MEMORY_SCOPE_AGENT);
        __syncthreads();
        const int u = __builtin_amdgcn_readfirstlane((int)misc[0]);
        __syncthreads();
        if (u >= 256) break;
        nsa_unit(F, (u & 7) >> 1, u & 1, 31 - (u >> 3));
    }
}
}

struct SchedCmp {
    const char* Zb; const char* Wb; int c0, c, kv;
    __device__ bool next(int i, Unit& u) const {
        const int j = c - c0; if (i != 0 || j < 0 || j >= 32) return false;
        const int g = j >> 4, rt = (j >> 3) & 1, s = j & 7;
        u.a = Zb + ((size_t)(kv ? ZO_VC + 128 * g : ZO_KC + 192 * g) + (size_t)rt * 256 * 16 * DINP + (size_t)s * 4 * DINP) * 2;
        u.b = Wb + (size_t)s * (kv ? 8 : 12) * 64 * 2; u.pm = 0; u.pn = 0; u.aux = kv * 32 + j; return true;
    }
};
struct SchedQKV {
    const char* C; const char* WQ; const char* WUKV; int G, c;
    __device__ bool next(int i, Unit& u) const {
        int j = i * G + c; if (j >= 448) return false;
        if (j < 192) { u.aux = 0; u.pn = j / 32; u.pm = j % 32; u.a = C + (size_t)u.pm * 256 * 1024 * 2; u.b = WQ + (size_t)u.pn * 256 * 512 * 2; }
        else { j -= 192; u.aux = 1; u.pn = j / 32; u.pm = j % 32; u.a = C + ((size_t)u.pm * 256 * 1024 + 512) * 2; u.b = WUKV + (size_t)u.pn * 256 * 512 * 2; }
        return true;
    }
};
struct SchedMerge {
    const char* A; const char* W; int G, c;
    __device__ bool next(int i, Unit& u) const {
        const int ti = (i >> 1) * G + c, kh = i & 1; if (ti >= 256) return false;
        u.pm = ti % 32; u.pn = ti / 32; u.aux = kh;
        u.a = A + ((size_t)u.pm * 256 * 2048 + kh * 1024) * 2; u.b = W + ((size_t)u.pn * 256 * 2048 + kh * 1024) * 2; return true;
    }
};

constexpr int NPH = 2 + NL * 14;
__global__ void __launch_bounds__(512, 2) fwd(Args args) {
    extern __shared__ __attribute__((aligned(16))) unsigned char lds_raw[];
    Frame F;
    F.lds = (LAS unsigned char*)lds_raw; F.tid = threadIdx.x; F.lane = F.tid & 63; F.wave = __builtin_amdgcn_readfirstlane(F.tid >> 6); F.G = gridDim.x; F.cu = blockIdx.x;
    F.in = args.in; F.out = args.out; F.ws = args.ws;
    volatile LAS unsigned* MISC = (volatile LAS unsigned*)(F.lds + MISC_OFF);
    for (int u = F.tid; u < (LDS_BYTES - RING_BYTES) / 4; u += 512) ((LAS unsigned*)(F.lds + RING_BYTES))[u] = 0u;
    __syncthreads();
    unsigned* ctl = (unsigned*)(F.ws + WS_CTL);
    XcdBarrier bar; bar.bar = ctl + CW_BAR; bar.x = 0; bar.st = MISC + 8;
    if (!MK_PER_PHASE) bar = xcd_barrier_post(ctl + CW_BAR, MISC + 8);
    const int lo = args.ph_lo, hi = args.ph_hi; int pc = 0;
#define PH_IF launder(F); if (pc >= lo && pc < hi)
#define PH_END do { const bool both_ = (pc >= lo) && (pc + 1 < hi); ++pc; if (both_) xcd_barrier(bar); } while (0)
#define U ((bf16_t*)(F.ws + WS_U))
#define H ((bf16_t*)(F.ws + WS_H))
#define Y ((bf16_t*)(F.ws + WS_Y))
#define Z ((bf16_t*)(F.ws + WS_Z))
#define CQKV ((bf16_t*)(F.ws + WS_CQKV))
#define QM ((bf16_t*)(F.ws + WS_QM))
#define KV ((bf16_t*)(F.ws + WS_KV))
#define AB ((bf16_t*)(F.ws + WS_AB))
#define MG ((bf16_t*)(F.ws + WS_MG))
#define WL ((const bf16_t*)(F.ws + WS_W) + (size_t)l * WO_END)

    PH_IF { p0_prologue(F);
#if PROBE_DUP == 10
        __syncthreads(); p0_prologue(F);
#endif
    } PH_END;
    PH_IF { pe_bias_reduce(F); thin_first_norm(F, F.in[I_F1PRE]); } PH_END;
    for (int l = 0; l < NL; ++l) {
        for (int f = 0; f < 2; ++f) {
            PH_IF {
                Gemm g{D, D, D / 64, 0}; SchedStd S; S.init(U, D, WL + (f ? WO_GU2 : WO_GU1), D, M, 2 * FF, F.G, F.cu); EpiSwiGLU E{H, FF};
                pg8::gemm_phase<EpiSwiGLU, SchedStd, 0>(F.lds, g, S, E);
                cvt_filler(F, l, f ? FB_GU1 : FB_GU0, 128, FIL_GU);
#if PROBE_DUP == 1
                pg8::gemm_phase<EpiSwiGLU, SchedStd, 0>(F.lds, g, S, E);
#endif
            } PH_END;
            PH_IF {
                Gemm g{FF, FF, FF / 64, 0}; SchedStd S; S.init(H, FF, WL + (f ? WO_D2 : WO_D1), FF, M, D, F.G, F.cu); EpiBf16 E{Y, D};
                pg8::gemm_phase<EpiBf16, SchedStd, 0>(F.lds, g, S, E);
            } PH_END;
            PH_IF {
#if PROBE_DUP == 11
                thin_post_norm(F, 0.0f, F.in[I_F1POST] + (size_t)l * D, F.in[I_MPRE] + (size_t)l * D, nullptr); __syncthreads();
#endif
                if (f == 0) thin_post_norm(F, 0.5f, F.in[I_F1POST] + (size_t)l * D, F.in[I_MPRE] + (size_t)l * D, nullptr);
                else { thin_post_norm(F, 0.5f, F.in[I_F2POST] + (size_t)l * D, (l + 1 < NL) ? F.in[I_F1PRE] + (size_t)(l + 1) * D : nullptr, (l + 1 < NL) ? nullptr : F.out); __syncthreads(); cvt_drain(F, l); }
            } PH_END;
            if (f == 0) {
                PH_IF {
                    Gemm g{D, D, D / 64, 0}; SchedStd S; S.init(U, D, WL + WO_IN, D, M, DINP, F.G, F.cu); EpiBf16 E{Z, DINP};
                    pg8::gemm_phase<EpiBf16, SchedStd, 0>(F.lds, g, S, E);
                    cvt_filler(F, l, FB_WIN, 64, FIL_WIN);
                } PH_END;
                PH_IF {
                    thin_mix(F, F.in[I_QNG] + (size_t)l * 512, F.in[I_KVNG] + (size_t)l * 512);
                    __syncthreads();
                    EpiSlab E{(float*)(F.ws + WS_PART)};
                    { Gemm g{16 * DINP, 6144, 12, (size_t)DINP * 2}; SchedCmp S{(const char*)Z, (const char*)(WL + WO_1K), 0, F.cu, 0}; pg8::gemm_phase<EpiSlab, SchedCmp, 3>(F.lds, g, S, E); }
                    { Gemm g{16 * DINP, 4096, 8, (size_t)DINP * 2}; SchedCmp S{(const char*)Z, (const char*)(WL + WO_1V), 32, F.cu, 1}; pg8::gemm_phase<EpiSlab, SchedCmp, 2>(F.lds, g, S, E); }
                    cvt_filler(F, l, FB_P6, 64, FIL_P6);
#if PROBE_DUP == 4
                    __syncthreads(); thin_mix(F, F.in[I_QNG] + (size_t)l * 512, F.in[I_KVNG] + (size_t)l * 512); __syncthreads();
                    { Gemm g{16 * DINP, 6144, 12, (size_t)DINP * 2}; SchedCmp S{(const char*)Z, (const char*)(WL + WO_1K), 64, F.cu, 0}; pg8::gemm_phase<EpiSlab, SchedCmp, 3>(F.lds, g, S, E); }
#endif
                } PH_END;
                PH_IF {
                    { Gemm g{1024, 512, 8, 0}; SchedQKV S{(const char*)CQKV, (const char*)(WL + WO_Q), (const char*)(WL + WO_UKV), F.G, F.cu}; EpiQKV E{QM, KV};
                      pg8::gemm_phase<EpiQKV, SchedQKV, 0>(F.lds, g, S, E); }
                    for (int u = F.G - 1 - F.cu; u < 128; u += F.G) cmp_stage2_unit(F, u, l);
#if PROBE_DUP == 5
                    __syncthreads();
                    { Gemm g{1024, 512, 8, 0}; SchedQKV S{(const char*)CQKV, (const char*)(WL + WO_Q), (const char*)(WL + WO_UKV), F.G, F.cu}; EpiQKV E{QM, KV};
                      pg8::gemm_phase<EpiQKV, SchedQKV, 0>(F.lds, g, S, E); }
                    for (int u = F.G - 1 - F.cu; u < 128; u += F.G) cmp_stage2_unit(F, u, l);
#endif
                } PH_END;
                PH_IF { att::cmp_phase(F); cvt_filler(F, l, FB_CMP, 64, FIL_CMP);
#if PROBE_DUP == 6
                __syncthreads(); att::cmp_phase(F);
#endif
                } PH_END;
                PH_IF { att::attn_phase(F, l);
#if PROBE_DUP == 7
                __syncthreads(); att::attn_phase(F, l, 32);
#endif
                } PH_END;
                PH_IF {
                    Gemm g{2048, 2048, 16, 0}; SchedMerge S{(const char*)AB, (const char*)(WL + WO_AB), F.G, F.cu}; EpiMerge E{Z, MG};
                    pg8::gemm_phase<EpiMerge, SchedMerge, 0>(F.lds, g, S, E);
                } PH_END;
                PH_IF {
                    Gemm g{2048, 2048, 32, 0}; SchedStd S; S.init(MG, 2048, WL + WO_OUT, 2048, M, D, F.G, F.cu); EpiBf16 E{Y, D};
                    pg8::gemm_phase<EpiBf16, SchedStd, 0>(F.lds, g, S, E);
                } PH_END;
                PH_IF { thin_post_norm(F, 1.0f, F.in[I_MPOST] + (size_t)l * D, F.in[I_F2PRE] + (size_t)l * D, nullptr); } PH_END;
            }
        }
    }
#undef PH_IF
#undef PH_END
#undef U
#undef H
#undef Y
#undef Z
#undef CQKV
#undef QM
#undef KV
#undef AB
#undef MG
#undef WL
}

extern "C" void kernel_launch(void* const* d_in, const int* in_sizes, int n_in, void* d_out, int out_size, void* d_ws, size_t ws_size, hipStream_t stream) {
    static int grid = 0;
    if (grid == 0) {
        if (n_in != 30 || in_sizes[0] != M * D || out_size != M * D || ws_size < WS_END) { fprintf(stderr, "kernel_launch: unexpected shapes / workspace (n_in %d, ws %zu < %zu)\n", n_in, ws_size, (size_t)WS_END); grid = -1; return; }
        int dev = 0, cus = 0, per_cu = 0;
        if (hipGetDevice(&dev) != hipSuccess || hipDeviceGetAttribute(&cus, hipDeviceAttributeMultiprocessorCount, dev) != hipSuccess) { grid = -1; return; }
        if (hipFuncSetAttribute((const void*)fwd, hipFuncAttributeMaxDynamicSharedMemorySize, LDS_BYTES) != hipSuccess) { fprintf(stderr, "kernel_launch: hipFuncSetAttribute failed\n"); grid = -1; return; }
        if (hipOccupancyMaxActiveBlocksPerMultiprocessor(&per_cu, (const void*)fwd, 512, LDS_BYTES) != hipSuccess || per_cu < 1) { fprintf(stderr, "kernel_launch: occupancy query says %d\n", per_cu); }
        (void)hipGetLastError();
        grid = cus;
    }
    if (grid < 0) return;
    (void)hipMemsetAsync((char*)d_ws + WS_CTL, 0, CTL_ZERO_BYTES, stream);
    Args a{};
    for (int i = 0; i < 30; ++i) a.in[i] = (const float*)d_in[i];
    a.out = (float*)d_out; a.ws = (unsigned char*)d_ws;
#if MK_PER_PHASE
    for (int p = 0; p < NPH; ++p) { a.ph_lo = p; a.ph_hi = p + 1; hipLaunchKernelGGL(fwd, dim3(grid), dim3(512), LDS_BYTES, stream, a); }
#else
    a.ph_lo = 0; a.ph_hi = NPH; hipLaunchKernelGGL(fwd, dim3(grid), dim3(512), LDS_BYTES, stream, a);
#endif
}
```

```cpp
#include <hip/hip_runtime.h>
#include <cstdio>
#include <cstdint>

#ifndef PROBE_DUP
#define PROBE_DUP 0
#endif
#ifndef MK_PER_PHASE
#define MK_PER_PHASE 0
#endif

#define GAS __attribute__((address_space(1)))
#define LAS __attribute__((address_space(3)))
typedef unsigned short bf16_t;
typedef short bf16x8 __attribute__((ext_vector_type(8)));
typedef float f32x4 __attribute__((ext_vector_type(4)));
typedef float f32x2 __attribute__((ext_vector_type(2)));
typedef unsigned u32x4 __attribute__((ext_vector_type(4)));
typedef unsigned u32x2 __attribute__((ext_vector_type(2)));
typedef __bf16 bf16x2_t __attribute__((ext_vector_type(2)));

constexpr int NB = 4, SEQ = 2048, M = NB * SEQ, D = 2048, NL = 4, FF = 5632;
constexpr int DIN = 8664, DINP = 8704;
constexpr int ZO_CQ = 0, ZO_CKV = 512, ZO_KR = 1024, ZO_NQ = 1088, ZO_KC = 2624, ZO_VC = 3008, ZO_KS = 3264, ZO_VS = 3648, ZO_KW = 3904, ZO_VW = 4288, ZO_NG = 4544, ZO_GA = 4568, ZO_GB = 6616;
constexpr float EPS = 1e-6f;
constexpr int NCMP = 127;

constexpr size_t MiB = 1u << 20;
constexpr size_t alup(size_t x) { return (x + MiB - 1) / MiB * MiB; }
constexpr size_t WS_CTL = 0, CTL_ZERO_BYTES = 1 * MiB;
constexpr size_t WS_TBL = WS_CTL + CTL_ZERO_BYTES;
constexpr size_t WS_ROPE = WS_TBL + MiB;
constexpr size_t WS_X = WS_ROPE + alup((size_t)M * 32 * 8);
constexpr size_t WS_U = WS_X + alup((size_t)M * D * 4);
constexpr size_t WS_H = WS_U + alup((size_t)M * D * 2);
constexpr size_t WS_Y = WS_H + alup((size_t)M * FF * 2);
constexpr size_t WS_Z = WS_Y + alup((size_t)M * D * 2);
constexpr size_t WS_CQKV = WS_Z + alup((size_t)(M + 64) * DINP * 2);
constexpr size_t WS_KPE = WS_CQKV + alup((size_t)M * 1024 * 2);
constexpr size_t WS_QM = WS_KPE + alup((size_t)M * 64 * 2);
constexpr size_t WS_KV = WS_QM + alup((size_t)M * 1536 * 2);
constexpr size_t WS_AB = WS_KV + alup((size_t)M * 2048 * 2);
constexpr size_t WS_MG = WS_AB + alup((size_t)M * 2048 * 2);
constexpr size_t WS_OC = WS_MG + alup((size_t)M * 2048 * 2);
constexpr size_t WS_PART = WS_OC + alup((size_t)M * 1024 * 4);
constexpr size_t WS_KC = WS_PART + alup((size_t)64 * 256 * 256 * 4);
constexpr size_t WS_SEL = WS_KC + MiB;
constexpr size_t WS_W = WS_SEL + MiB;
constexpr size_t WO_GU1 = 0, WO_D1 = WO_GU1 + (size_t)2 * FF * D, WO_GU2 = WO_D1 + (size_t)D * FF, WO_D2 = WO_GU2 + (size_t)2 * FF * D,
                 WO_IN = WO_D2 + (size_t)D * FF, WO_Q = WO_IN + (size_t)DINP * D, WO_UKV = WO_Q + (size_t)1536 * 512, WO_1K = WO_UKV + (size_t)2048 * 512,
                 WO_1V = WO_1K + (size_t)256 * 6144, WO_AB = WO_1V + (size_t)256 * 4096, WO_OUT = WO_AB + (size_t)2048 * 2048, WO_END = WO_OUT + (size_t)2048 * 2048;
constexpr size_t WS_END = WS_W + alup(WO_END * 2 * NL);
constexpr int CW_BAR = 4096;

constexpr int RING_BYTES = 131072, MISC_OFF = RING_BYTES + 320, LDS_BYTES = 147456;

#define RLX_AGENT __ATOMIC_RELAXED, __HIP_MEMORY_SCOPE_AGENT
__device__ __forceinline__ unsigned cvtpk(float lo, float hi) { f32x2 v = {lo, hi}; bf16x2_t b = __builtin_convertvector(v, bf16x2_t); return __builtin_bit_cast(unsigned, b); }
__device__ __forceinline__ float bflo(unsigned u) { return __uint_as_float(u << 16); }
__device__ __forceinline__ float bfhi(unsigned u) { return __uint_as_float(u & 0xffff0000u); }
__device__ __forceinline__ float bf1(bf16_t h) { return __uint_as_float((unsigned)h << 16); }
__device__ __forceinline__ float wave_sum(float v) {
#pragma unroll
    for (int o = 1; o < 64; o <<= 1) v += __shfl_xor(v, o);
    return v;
}
__device__ __forceinline__ float wave_max(float v) {
#pragma unroll
    for (int o = 1; o < 64; o <<= 1) v = fmaxf(v, __shfl_xor(v, o));
    return v;
}
__device__ __forceinline__ float sigmoidf_(float x) { return 1.0f / (1.0f + __expf(-x)); }

__device__ const float ROPE_INV[32] = {
    1.000000000e+00f, 7.498942614e-01f, 5.623413324e-01f, 4.216965139e-01f, 3.162277639e-01f, 2.371373773e-01f, 1.778279394e-01f, 1.333521307e-01f,
    1.000000015e-01f, 7.498941571e-02f, 5.623413250e-02f, 4.216965288e-02f, 3.162277490e-02f, 2.371373773e-02f, 1.778279431e-02f, 1.333521493e-02f,
    9.999999776e-03f, 7.498941850e-03f, 5.623413250e-03f, 4.216964822e-03f, 3.162277630e-03f, 2.371373586e-03f, 1.778279431e-03f, 1.333521446e-03f,
    1.000000047e-03f, 7.498942432e-04f, 5.623413017e-04f, 4.216965172e-04f, 3.162277571e-04f, 2.371373703e-04f, 1.778279402e-04f, 1.333521504e-04f};
__device__ const unsigned char REL_BUCKET[129] = {
    0, 1, 2, 3, 4, 5, 6, 7, 8, 9, 10, 11, 12, 13, 14, 15, 16, 16, 16, 17, 17, 18, 18, 18, 19, 19, 19, 20, 20, 20, 20, 21, 21, 21, 21, 22, 22, 22, 22, 22, 23, 23, 23, 23, 23, 23, 24, 24, 24, 24, 24, 24,
    25, 25, 25, 25, 25, 25, 25, 26, 26, 26, 26, 26, 26, 26, 26, 27, 27, 27, 27, 27, 27, 27, 27, 27, 27, 28, 28, 28, 28, 28, 28, 28, 28, 28, 28, 29, 29, 29, 29, 29, 29, 29, 29, 29, 29, 29, 29,
    30, 30, 30, 30, 30, 30, 30, 30, 30, 30, 30, 30, 30, 30, 31, 31, 31, 31, 31, 31, 31, 31, 31, 31, 31, 31, 31, 31, 31, 31};

#define XB_TMO      128
#define XB_XCNT(j)  (256  + 64 * (j))
#define XB_XSUB(j)  (1280 + 64 * (j))
#define XB_XGEN(j)  (2304 + 64 * (j))
#define XB_TOP      3328
#define XB_TOPGEN   3392
#define XCD_BAR_WORDS 3456
#define XB_SPIN_CAP (1u << 18)
__device__ __forceinline__ unsigned xb_ld(unsigned* p)              { return __hip_atomic_load(p, __ATOMIC_RELAXED, __HIP_MEMORY_SCOPE_AGENT); }
__device__ __forceinline__ unsigned xb_add(unsigned* p, unsigned v) { return __hip_atomic_fetch_add(p, v, __ATOMIC_RELAXED, __HIP_MEMORY_SCOPE_AGENT); }
__device__ __forceinline__ unsigned xb_xcc_id() { return (unsigned)__builtin_amdgcn_s_getreg((3 << 11) | 20) & 0xFu; }
#define XB_SPIN(cond, bar) do { unsigned _sp = 0; while (cond) { __builtin_amdgcn_s_sleep(1); \
    if ((++_sp & 255u) == 0u) { if (xb_ld(&(bar)[XB_TMO])) break; if (_sp > XB_SPIN_CAP) { atomicAdd(&(bar)[XB_TMO], 1u); break; } } } } while (0)
struct XcdBarrier { unsigned* bar; unsigned x; volatile LAS unsigned* st; };
__device__ __forceinline__ XcdBarrier xcd_barrier_post(unsigned* bar, volatile LAS unsigned* st) {
    XcdBarrier b; b.bar = bar; b.x = xb_xcc_id(); b.st = st;
    if (threadIdx.x == 0) (void)xb_add(&bar[XB_XCNT(b.x)], 1u);
    return b;
}
__device__ __forceinline__ void xcd_barrier_complete(unsigned* bar, unsigned x, unsigned& nloc, unsigned& nx) {
    const unsigned G = gridDim.x * gridDim.y * gridDim.z;
    unsigned sum, cnt, mine, sp = 0u;
    for (;;) {
        sum = 0u; cnt = 0u; mine = 0u;
#pragma unroll
        for (unsigned j = 0; j < 16; ++j) { const unsigned c = xb_ld(&bar[XB_XCNT(j)]); sum += c; cnt += (c > 0u) ? 1u : 0u; mine = (j == x) ? c : mine; }
        if (sum == G) break;
        __builtin_amdgcn_s_sleep(1);
        if ((++sp & 255u) == 0u) { if (xb_ld(&bar[XB_TMO])) break; if (sp > XB_SPIN_CAP) { atomicAdd(&bar[XB_TMO], 1u); break; } }
    }
    nloc = mine > 0u ? mine : 1u; nx = cnt > 0u ? cnt : 1u;
}
__device__ __forceinline__ void xcd_barrier(const XcdBarrier& b) {
    asm volatile("s_waitcnt vmcnt(0)" ::: "memory");
    __syncthreads();
    if (threadIdx.x == 0) {
        unsigned* bar = b.bar;
        __builtin_amdgcn_s_waitcnt(0);
        unsigned nloc = b.st[0], nx = b.st[1];
        if (nloc == 0u) { xcd_barrier_complete(bar, b.x, nloc, nx); b.st[0] = nloc; b.st[1] = nx; }
        const unsigned old = xb_add(&bar[XB_XSUB(b.x)], 1u);
        const unsigned gen = old / nloc;
        if (old + 1u == (gen + 1u) * nloc) {
            __builtin_amdgcn_fence(__ATOMIC_RELEASE, "agent");
            asm volatile("s_waitcnt vmcnt(0)" ::: "memory");
            const unsigned og = xb_add(&bar[XB_TOP], 1u);
            const unsigned tg = og / nx;
            if (og + 1u == (tg + 1u) * nx) xb_add(&bar[XB_TOPGEN], 1u);
            else XB_SPIN(xb_ld(&bar[XB_TOPGEN]) == tg, bar);
            __builtin_amdgcn_fence(__ATOMIC_ACQUIRE, "agent");
            xb_add(&bar[XB_XGEN(b.x)], 1u);
            asm volatile("s_waitcnt vmcnt(0)" ::: "memory");
        } else {
            XB_SPIN(xb_ld(&bar[XB_XGEN(b.x)]) == gen, bar);
            __builtin_amdgcn_fence(__ATOMIC_ACQUIRE, "agent");
            asm volatile("s_waitcnt vmcnt(0)" ::: "memory");
        }
    }
    __syncthreads();
}

namespace pg8 {
constexpr int BM = 256, BK = 64, HALF = 128, HTB = HALF * BK * 2, STAGE_BYTES = 8 * HTB, NXCD = 8, WGM = 8;
__host__ __device__ __forceinline__ int lds_byte(int r, int c) { const int st = (r >> 4) * 2 + (c >> 5), rr = r & 15, cc = c & 31, ob = rr * 64 + cc * 2; return st * 1024 + (ob ^ (((ob >> 9) & 1) << 5)); }
__host__ __device__ __forceinline__ void stage_rc(int b, int& R, int& C) { const int st = b / 1024, sb = b % 1024, swz = sb ^ (((sb >> 9) & 1) << 5); R = (st >> 1) * 16 + swz / 64; C = (st & 1) * 32 + (swz % 64) / 2; }
__host__ __device__ __forceinline__ int perm32(int rho) { const int n = rho >> 4, i = rho & 15; return 8 * (i >> 2) + 4 * n + (i & 3); }

struct Unit { const char* a; const char* b; int pm, pn, aux; };
struct Gemm { int lda, ldb, nt; size_t gstride; };

struct StaticOrder {
    int nM, nN, nwg, G, c;
    __device__ void init(int M_, int N_, int G_, int c_) { nM = M_ / BM; nN = N_ / BM; nwg = nM * nN; G = G_; c = c_; }
    __device__ bool next(int i, int& pm, int& pn) const {
        const long L = (long)i * G + c; if (L >= nwg) return false;
        int wgid = (int)L; { const int q = nwg / NXCD, r = nwg % NXCD, xcd = wgid % NXCD, off = wgid / NXCD; wgid = (xcd < r ? xcd * (q + 1) : r * (q + 1) + (xcd - r) * q) + off; }
        const int nig = WGM * nN, gid = wgid / nig, fm = gid * WGM, gsz = (nM - fm) < WGM ? (nM - fm) : WGM;
        pm = fm + ((wgid % nig) % gsz); pn = (wgid % nig) / gsz; return true;
    }
};

template <class Epi, class Sched, int KGRP>
__device__ __forceinline__ void gemm_phase(LAS unsigned char* lds, const Gemm g, const Sched& S, const Epi& E) {
    int tid_ = threadIdx.x; asm volatile("" : "+v"(tid_));
    const int tid = tid_, wid = __builtin_amdgcn_readfirstlane(tid >> 6), lane = tid & 63, wr = wid >> 2, wc = wid & 3, fr = lane & 15, fq = lane >> 4;
    const int nt = g.nt;
    unsigned voffA[2], voffB[2];
#pragma unroll
    for (int i = 0; i < 2; ++i) { int R, C; stage_rc(tid * 16 + i * 8192, R, C); const int Rb = (R & ~31) + perm32(R & 31);
        voffA[i] = (unsigned)(R * g.lda + C) * 2u; voffB[i] = (unsigned)(Rb * g.ldb + C) * 2u; }
    const size_t kstep = (size_t)(BK * 2);
    const size_t hstepA = (size_t)HALF * g.lda * 2, hstepB = (size_t)HALF * g.ldb * 2;
    const unsigned ldsw = (unsigned)wid * 1024u;
    const int aoff = lds_byte(wr * 64 + fr, fq * 8), boff = lds_byte(wc * 32 + fr, fq * 8);
    auto koffA = [&](int t) -> size_t { if constexpr (KGRP > 0) return (size_t)(t / KGRP) * g.gstride + (size_t)(t % KGRP) * kstep; else return (size_t)t * kstep; };
#define PG8_SA(b, h) (((b) * 2 + (h)) * HTB)
#define PG8_SB(b, h) ((4 + (b) * 2 + (h)) * HTB)
#define PG8_STAGE(bufoff, gbase, voff) do { _Pragma("unroll") for (int _i = 0; _i < 2; ++_i) \
        __builtin_amdgcn_global_load_lds((const unsigned*)((const char*)(gbase) + (voff)[_i]), (LAS unsigned*)(lds + (bufoff) + ldsw + _i * 8192), 16, 0, 0); } while (0)
#define PG8_LDA(dst, b, h) do { _Pragma("unroll") for (int m = 0; m < 4; ++m) _Pragma("unroll") for (int k = 0; k < 2; ++k) dst[m][k] = *(const LAS bf16x8*)(lds + PG8_SA(b, h) + aoff + m * 2048 + k * 1024); } while (0)
#define PG8_LDB(dst, b, h) do { _Pragma("unroll") for (int n = 0; n < 2; ++n) _Pragma("unroll") for (int k = 0; k < 2; ++k) dst[n][k] = *(const LAS bf16x8*)(lds + PG8_SB(b, h) + boff + n * 2048 + k * 1024); } while (0)
#define PG8_MMA(ai, bj, At, Bt) do { __builtin_amdgcn_s_setprio(1); _Pragma("unroll") for (int m = 0; m < 4; ++m) _Pragma("unroll") for (int n = 0; n < 2; ++n) _Pragma("unroll") for (int k = 0; k < 2; ++k) \
        acc[ai][bj][m][n] = __builtin_amdgcn_mfma_f32_16x16x32_bf16(Bt[n][k], At[m][k], acc[ai][bj][m][n], 0, 0, 0); __builtin_amdgcn_s_setprio(0); } while (0)
#define PG8_WAIT_V(n) asm volatile("s_waitcnt vmcnt(" #n ")" ::: "memory")
#define PG8_WAIT_L(n) asm volatile("s_waitcnt lgkmcnt(" #n ")" ::: "memory")
#define PG8_BAR __builtin_amdgcn_s_barrier()
#define PG8_SCHED __builtin_amdgcn_sched_barrier(0)
    Unit cur, nxt; int ui = 0;
    if (!S.next(0, cur)) return;
    f32x4 acc[2][2][4][2];
#pragma unroll
    for (int a = 0; a < 2; ++a)
#pragma unroll
        for (int b = 0; b < 2; ++b)
#pragma unroll
            for (int m = 0; m < 4; ++m)
#pragma unroll
                for (int n = 0; n < 2; ++n) acc[a][b][m][n] = (f32x4){0.f, 0.f, 0.f, 0.f};
    bf16x8 At[4][2], B0[2][2], B1[2][2];
    const char* cA = cur.a; const char* cB = cur.b;
    PG8_STAGE(PG8_SB(0, 0), cB, voffB); PG8_STAGE(PG8_SB(0, 1), cB + hstepB, voffB); PG8_STAGE(PG8_SA(0, 0), cA, voffA); PG8_STAGE(PG8_SA(0, 1), cA + hstepA, voffA);
    if (wr == 1) PG8_BAR;
    PG8_WAIT_V(2); PG8_BAR;
    { const char* a1p = cA + koffA(1);
      PG8_STAGE(PG8_SB(1, 0), cB + kstep, voffB); PG8_STAGE(PG8_SA(1, 0), a1p, voffA); PG8_STAGE(PG8_SB(1, 1), cB + hstepB + kstep, voffB); }
    PG8_WAIT_V(6); PG8_BAR;
    for (;;) {
        const bool has_next = S.next(ui + 1, nxt);
        const char* nA = has_next ? nxt.a : cA; const char* nB = has_next ? nxt.b : cB;
        for (int t = 0; t < nt; t += 2) {
            const bool last = (t == nt - 2);
            const char* a1 = cA + koffA(t + 1);
            const char* a2 = last ? nA : cA + koffA(t + 2); const char* b2 = last ? nB : cB + (size_t)(t + 2) * kstep;
            const char* a3 = last ? nA + koffA(1) : cA + koffA(t + 3); const char* b3 = b2 + kstep;
            PG8_LDB(B0, 0, 0); PG8_LDB(B1, 0, 1); PG8_SCHED; PG8_LDA(At, 0, 0); PG8_STAGE(PG8_SA(1, 1), a1 + hstepA, voffA);
            PG8_WAIT_V(8); PG8_WAIT_L(0); PG8_BAR; PG8_MMA(0, 0, At, B0); PG8_MMA(0, 1, At, B1); PG8_BAR; PG8_SCHED;
            PG8_LDA(At, 0, 1); PG8_STAGE(PG8_SB(0, 0), b2, voffB); PG8_STAGE(PG8_SB(0, 1), b2 + hstepB, voffB); PG8_STAGE(PG8_SA(0, 0), a2, voffA);
            PG8_WAIT_V(8); PG8_WAIT_L(0); PG8_BAR; PG8_MMA(1, 0, At, B0); PG8_MMA(1, 1, At, B1); PG8_BAR; PG8_SCHED;
            PG8_LDB(B0, 1, 0); PG8_LDB(B1, 1, 1); PG8_SCHED; PG8_LDA(At, 1, 0); PG8_STAGE(PG8_SA(0, 1), a2 + hstepA, voffA);
            PG8_WAIT_V(8); PG8_WAIT_L(0); PG8_BAR; PG8_MMA(0, 0, At, B0); PG8_MMA(0, 1, At, B1); PG8_BAR; PG8_SCHED;
            PG8_LDA(At, 1, 1); PG8_STAGE(PG8_SB(1, 0), b3, voffB); PG8_STAGE(PG8_SB(1, 1), b3 + hstepB, voffB); PG8_STAGE(PG8_SA(1, 0), a3, voffA);
            PG8_WAIT_V(8); PG8_WAIT_L(0); PG8_BAR; PG8_MMA(1, 0, At, B0); PG8_MMA(1, 1, At, B1); PG8_BAR; PG8_SCHED;
        }
        if (wr == 0) PG8_BAR;
        const bool keep = E(acc, cur, wr, wc, fr, fq);
        if (!has_next) break;
        if (!keep) {
#pragma unroll
            for (int a = 0; a < 2; ++a)
#pragma unroll
                for (int b = 0; b < 2; ++b)
#pragma unroll
                    for (int m = 0; m < 4; ++m)
#pragma unroll
                        for (int n = 0; n < 2; ++n) acc[a][b][m][n] = (f32x4){0.f, 0.f, 0.f, 0.f};
        }
        cur = nxt; cA = nA; cB = nB; ++ui;
        if (wr == 1) PG8_BAR;
    }
    PG8_WAIT_V(0);
    PG8_BAR;
#undef PG8_SA
#undef PG8_SB
#undef PG8_STAGE
#undef PG8_LDA
#undef PG8_LDB
#undef PG8_MMA
#undef PG8_WAIT_V
#undef PG8_WAIT_L
#undef PG8_BAR
#undef PG8_SCHED
}
}
using pg8::Unit; using pg8::Gemm;
typedef f32x4 Acc[2][2][4][2];

struct SchedStd {
    pg8::StaticOrder so; const char* A; const char* B; size_t tA, tB;
    __device__ void init(const bf16_t* A_, int lda, const bf16_t* B_, int ldb, int M_, int N_, int G, int c) { so.init(M_, N_, G, c); A = (const char*)A_; B = (const char*)B_; tA = (size_t)256 * lda * 2; tB = (size_t)256 * ldb * 2; }
    __device__ bool next(int i, Unit& u) const { int pm, pn; if (!so.next(i, pm, pn)) return false; u.pm = pm; u.pn = pn; u.aux = 0; u.a = A + pm * tA; u.b = B + pn * tB; return true; }
};

struct EpiBf16 {
    bf16_t* O; int ldc;
    __device__ __forceinline__ bool operator()(Acc& acc, const Unit& u, int wr, int wc, int fr, int fq) const {
        const int row0 = u.pm * 256 + wr * 64 + fr, col0 = u.pn * 256 + wc * 32 + 8 * fq;
#pragma unroll
        for (int ai = 0; ai < 2; ++ai)
#pragma unroll
            for (int m = 0; m < 4; ++m) { bf16_t* rowp = O + (size_t)(row0 + ai * 128 + m * 16) * ldc + col0;
#pragma unroll
                for (int bj = 0; bj < 2; ++bj) { const f32x4 v0 = acc[ai][bj][m][0], v1 = acc[ai][bj][m][1];
                    u32x4 w; w.x = cvtpk(v0[0], v0[1]); w.y = cvtpk(v0[2], v0[3]); w.z = cvtpk(v1[0], v1[1]); w.w = cvtpk(v1[2], v1[3]);
                    *(u32x4*)(rowp + bj * 128) = w; } }
        return false;
    }
};
struct EpiSwiGLU {
    bf16_t* O; int ldc;
    __device__ __forceinline__ bool operator()(Acc& acc, const Unit& u, int wr, int wc, int fr, int fq) const {
        const int row0 = u.pm * 256 + wr * 64 + fr, col0 = u.pn * 128 + wc * 32 + 8 * fq;
#pragma unroll
        for (int ai = 0; ai < 2; ++ai)
#pragma unroll
            for (int m = 0; m < 4; ++m) { bf16_t* rowp = O + (size_t)(row0 + ai * 128 + m * 16) * ldc + col0;
                float h[8];
#pragma unroll
                for (int n = 0; n < 2; ++n)
#pragma unroll
                    for (int e = 0; e < 4; ++e) { const float gt = acc[ai][0][m][n][e], up = acc[ai][1][m][n][e]; h[n * 4 + e] = gt * sigmoidf_(gt) * up; }
                u32x4 w; w.x = cvtpk(h[0], h[1]); w.y = cvtpk(h[2], h[3]); w.z = cvtpk(h[4], h[5]); w.w = cvtpk(h[6], h[7]);
                *(u32x4*)rowp = w; }
        return false;
    }
};
struct EpiSlab {
    float* P;
    __device__ __forceinline__ bool operator()(Acc& acc, const Unit& u, int wr, int wc, int fr, int fq) const {
        float* base = P + (size_t)u.aux * 65536;
#pragma unroll
        for (int ai = 0; ai < 2; ++ai)
#pragma unroll
            for (int m = 0; m < 4; ++m) { float* rowp = base + (size_t)(ai * 128 + wr * 64 + m * 16 + fr) * 256 + wc * 32 + 8 * fq;
#pragma unroll
                for (int bj = 0; bj < 2; ++bj) { *(f32x4*)(rowp + bj * 128) = acc[ai][bj][m][0]; *(f32x4*)(rowp + bj * 128 + 4) = acc[ai][bj][m][1]; } }
        return false;
    }
};
struct EpiQKV {
    bf16_t* Q; bf16_t* KV;
    __device__ __forceinline__ bool operator()(Acc& acc, const Unit& u, int wr, int wc, int fr, int fq) const {
        EpiBf16 e{u.aux ? KV : Q, u.aux ? 2048 : 1536}; return e(acc, u, wr, wc, fr, fq);
    }
};
struct EpiMerge {
    const bf16_t* Z; bf16_t* O;
    __device__ __forceinline__ bool operator()(Acc& acc, const Unit& u, int wr, int wc, int fr, int fq) const {
        const int row0 = u.pm * 256 + wr * 64 + fr, col0 = u.pn * 256 + wc * 32 + 8 * fq;
#pragma unroll
        for (int ai = 0; ai < 2; ++ai)
#pragma unroll
            for (int m = 0; m < 4; ++m) { const size_t row = (size_t)(row0 + ai * 128 + m * 16);
#pragma unroll
                for (int bj = 0; bj < 2; ++bj) { const int col = col0 + bj * 128;
                    const u32x4 gbw = *(const u32x4*)(Z + row * DINP + ZO_GB + col);
                    float gb[8] = {sigmoidf_(bflo(gbw.x)), sigmoidf_(bfhi(gbw.x)), sigmoidf_(bflo(gbw.y)), sigmoidf_(bfhi(gbw.y)), sigmoidf_(bflo(gbw.z)), sigmoidf_(bfhi(gbw.z)), sigmoidf_(bflo(gbw.w)), sigmoidf_(bfhi(gbw.w))};
                    if (u.aux == 0) {
                        const u32x4 gaw = *(const u32x4*)(Z + row * DINP + ZO_GA + col);
                        float ga[8] = {sigmoidf_(bflo(gaw.x)), sigmoidf_(bfhi(gaw.x)), sigmoidf_(bflo(gaw.y)), sigmoidf_(bfhi(gaw.y)), sigmoidf_(bflo(gaw.z)), sigmoidf_(bfhi(gaw.z)), sigmoidf_(bflo(gaw.w)), sigmoidf_(bfhi(gaw.w))};
#pragma unroll
                        for (int n = 0; n < 2; ++n)
#pragma unroll
                            for (int e = 0; e < 4; ++e) acc[ai][bj][m][n][e] *= ga[n * 4 + e] / gb[n * 4 + e];
                    } else {
                        float h[8];
#pragma unroll
                        for (int n = 0; n < 2; ++n)
#pragma unroll
                            for (int e = 0; e < 4; ++e) h[n * 4 + e] = acc[ai][bj][m][n][e] * gb[n * 4 + e];
                        u32x4 w; w.x = cvtpk(h[0], h[1]); w.y = cvtpk(h[2], h[3]); w.z = cvtpk(h[4], h[5]); w.w = cvtpk(h[6], h[7]);
                        *(u32x4*)(O + row * 2048 + col) = w;
                    } } }
        return u.aux == 0;
    }
};

struct Args { const float* in[30]; float* out; unsigned char* ws; int ph_lo, ph_hi; };
enum { I_X = 0, I_POS, I_RELB, I_F1PRE, I_F1POST, I_F1G, I_F1U, I_F1D, I_MPRE, I_MPOST, I_WIN, I_QNG, I_WQUP, I_KVNG, I_WUK, I_WUV, I_PEK, I_W1K, I_W2K, I_PEV, I_W1V, I_W2V, I_WA, I_WB, I_WOUT,
       I_F2PRE, I_F2POST, I_F2G, I_F2U, I_F2D };
struct Frame {
    LAS unsigned char* lds; int tid, lane, wave, G, cu;
    const float* const* in; float* out; unsigned char* ws;
};

__device__ __forceinline__ void launder(Frame& F) { unsigned long long w_ = (unsigned long long)F.ws; unsigned lo_ = (unsigned)w_, hi_ = (unsigned)(w_ >> 32);
    int cu_ = F.cu; asm volatile("" : "+v"(F.tid), "+v"(F.lane), "+v"(lo_), "+v"(hi_), "+v"(cu_));
    lo_ = (unsigned)__builtin_amdgcn_readfirstlane((int)lo_); hi_ = (unsigned)__builtin_amdgcn_readfirstlane((int)hi_); F.ws = (unsigned char*)(((unsigned long long)hi_ << 32) | lo_); F.cu = __builtin_amdgcn_readfirstlane(cu_); }
__device__ __forceinline__ unsigned cvt_offb(unsigned row, unsigned ch) { return 256u * row + 16u * (ch ^ (((row & 3u) << 2) | ((row >> 2) & 3u))); }
struct CvtJob { int in_idx, K, N, ldk, koff, mode, row_off; size_t dst_off; };
__device__ __forceinline__ CvtJob cvt_job(int j) {
    switch (j) {
    case 0:  return CvtJob{I_F1G, D, FF, D, 0, 1, 0, WO_GU1};
    case 1:  return CvtJob{I_F1U, D, FF, D, 0, 1, 128, WO_GU1};
    case 2:  return CvtJob{I_F1D, FF, D, FF, 0, 0, 0, WO_D1};
    case 3:  return CvtJob{I_F2G, D, FF, D, 0, 1, 0, WO_GU2};
    case 4:  return CvtJob{I_F2U, D, FF, D, 0, 1, 128, WO_GU2};
    case 5:  return CvtJob{I_F2D, FF, D, FF, 0, 0, 0, WO_D2};
    case 6:  return CvtJob{I_WIN, D, DIN, D, 0, 0, 0, WO_IN};
    case 7:  return CvtJob{I_WQUP, 512, 1536, 512, 0, 0, 0, WO_Q};
    case 8:  return CvtJob{I_WUK, 512, 1024, 512, 0, 0, 0, WO_UKV};
    case 9:  return CvtJob{I_WUV, 512, 1024, 512, 0, 0, 1024, WO_UKV};
    case 10: return CvtJob{I_W1K, 6144, 256, 6144, 0, 0, 0, WO_1K};
    case 11: return CvtJob{I_W1V, 4096, 256, 4096, 0, 0, 0, WO_1V};
    case 12: return CvtJob{I_WA, 1024, 2048, 2048, 0, 0, 0, WO_AB};
    case 13: return CvtJob{I_WB, 1024, 2048, 2048, 1024, 0, 0, WO_AB};
    default: return CvtJob{I_WOUT, 2048, 2048, 2048, 0, 0, 0, WO_OUT};
    }
}
constexpr int N_CVT_JOBS = 15;
constexpr int CVT_ITEMS_PER_LAYER = 6096;
__device__ __forceinline__ void cvt_items(Frame& F, int L, int first, int stride, int count) {
    typedef short v4i16_t __attribute__((ext_vector_type(4)));
    if (count <= 0 || first >= CVT_ITEMS_PER_LAYER) return;
    bf16_t* wbase = (bf16_t*)(F.ws + WS_W) + (size_t)L * WO_END;
    const int tid = F.tid, lane = F.lane, w = F.wave;
    int j = 0, base = 0, flat = first, done = 0; CvtJob J = cvt_job(0); int n = (J.K / 128) * ((J.N + 127) / 128);
    bool have = true;
#define P0_SEEK() do { if (flat >= CVT_ITEMS_PER_LAYER || done >= count) { have = false; break; } while (flat >= base + n) { base += n; ++j; J = cvt_job(j); n = (J.K / 128) * ((J.N + 127) / 128); } } while (0)
#define P0_LOAD() do { const int it_ = flat - base, ntn_ = (J.N + 127) >> 7, kb_ = it_ / ntn_, nb_ = it_ - kb_ * ntn_; const float* W_ = F.in[J.in_idx] + (size_t)L * J.K * J.N; \
    _Pragma("unroll") for (int i = 0; i < 8; ++i) { const int c = tid + 512 * i, k = c >> 5, nn = nb_ * 128 + 4 * (c & 31); \
        v[i] = (nn < J.N) ? *(const f32x4*)(W_ + (size_t)(kb_ * 128 + k) * J.N + nn) : (f32x4){0.f, 0.f, 0.f, 0.f}; } } while (0)
    P0_SEEK();
    f32x4 v[8];
    if (have) P0_LOAD();
    int pb = 0;
    while (have) {
        const CvtJob cJ = J; const int it = flat - base;
        LAS unsigned char* buf = F.lds + pb * 32768;
#pragma unroll
        for (int i = 0; i < 8; ++i) { const int c = tid + 512 * i, k = c >> 5, nch = c & 31;
            *(LAS u32x2*)(buf + cvt_offb(k, nch >> 1) + 8 * (nch & 1)) = (u32x2){cvtpk(v[i].x, v[i].y), cvtpk(v[i].z, v[i].w)}; }
        asm volatile("s_waitcnt lgkmcnt(0)" ::: "memory"); __builtin_amdgcn_s_barrier(); asm volatile("" ::: "memory");
        flat += stride; ++done; P0_SEEK();
        if (have) P0_LOAD();
        const int ntn = (cJ.N + 127) >> 7, kb = it / ntn, nb = it - kb * ntn, k0 = kb * 128, n0 = nb * 128;
        const int c4 = w & 3, ks0 = (w >> 2) * 4;
        const unsigned h = lane >> 5, blk = (lane >> 4) & 1, q = (lane & 15) >> 2, p = lane & 3;
        const int nl = 32 * c4 + (lane & 31);
        const int rbase = cJ.mode ? ((n0 >> 7) * 256 + cJ.row_off) : (cJ.row_off + n0);
        bf16_t* dst = wbase + cJ.dst_off + (size_t)(rbase + nl) * cJ.ldk + cJ.koff + k0 + 8 * h;
#pragma unroll
        for (int kk = 0; kk < 4; ++kk) { const int ks = ks0 + kk;
            const v4i16_t lo = __builtin_amdgcn_ds_read_tr16_b64_v4i16((LAS v4i16_t*)(buf + cvt_offb(16 * ks + 8 * h + q, 4 * c4 + 2 * blk + (p >> 1)) + 8 * (p & 1)));
            const v4i16_t hi = __builtin_amdgcn_ds_read_tr16_b64_v4i16((LAS v4i16_t*)(buf + cvt_offb(16 * ks + 8 * h + 4 + q, 4 * c4 + 2 * blk + (p >> 1)) + 8 * (p & 1)));
            const bf16x8 o = {lo[0], lo[1], lo[2], lo[3], hi[0], hi[1], hi[2], hi[3]};
            if (n0 + nl < cJ.N) *(bf16x8*)(dst + 16 * ks) = o; }
        pb ^= 1;
    }
#undef P0_SEEK
#undef P0_LOAD
    __syncthreads();
}
constexpr int FIL_GU = 10, FIL_WIN = 10, FIL_P6 = 3, FIL_CMP = 10;
constexpr int FB_GU0 = 0, FB_WIN = FB_GU0 + 128 * FIL_GU, FB_P6 = FB_WIN + 192 * FIL_WIN, FB_CMP = FB_P6 + 192 * FIL_P6, FB_GU1 = FB_CMP + 192 * FIL_CMP, FB_DRAIN = FB_GU1 + 128 * FIL_GU;
__device__ __forceinline__ void cvt_filler(Frame& F, int l, int slot_base, int c0, int k) {
    if (l + 1 >= NL || F.G != 256 || F.cu < c0) return;
    cvt_items(F, l + 1, slot_base + (F.cu - c0) * k, 1, k);
}
__device__ __forceinline__ void cvt_drain(Frame& F, int l) {
    if (l + 1 >= NL) return;
    const int b0 = (F.G == 256) ? FB_DRAIN : 0;
    cvt_items(F, l + 1, b0 + F.cu, F.G, CVT_ITEMS_PER_LAYER);
}
__device__ __forceinline__ void p0_prologue(Frame& F) {
    cvt_items(F, 0, F.cu, F.G, CVT_ITEMS_PER_LAYER);
    __syncthreads();
    {
        const f32x4* xs = (const f32x4*)F.in[I_X]; f32x4* xd = (f32x4*)(F.ws + WS_X);
        for (size_t i = (size_t)F.cu * 512 + F.tid; i < (size_t)M * D / 4; i += (size_t)F.G * 512) xd[i] = xs[i];
        const int* pos = (const int*)F.in[I_POS]; f32x2* rope = (f32x2*)(F.ws + WS_ROPE);
        for (int i = F.cu * 512 + F.tid; i < M * 32; i += F.G * 512) {
            const float ang = (float)pos[i >> 5] * ROPE_INV[i & 31];
            const double rev = (double)ang * 0.15915494309189535; const float fr = (float)(rev - __builtin_rint(rev));
            rope[i] = (f32x2){__builtin_amdgcn_cosf(fr), __builtin_amdgcn_sinf(fr)};
        }
        float* tbl = (float*)(F.ws + WS_TBL);
        if (F.cu == 0) for (int i = F.tid; i < 8 * 132; i += 512) { const int h = i / 132, d = i % 132; const float tv = F.in[I_RELB][REL_BUCKET[d > 128 ? 128 : d] * 8 + h]; tbl[i] = tv; ((float*)(F.ws + WS_TBL + 16384))[i] = tv * 1.4426950408889634f; }
        {
            float* pp = (float*)(F.ws + WS_TBL + 32768);
            for (int item = F.cu; item < NL * 160; item += F.G) {
                const int l = item / 160, r = item % 160, kv = r >= 96, ch = kv ? r - 96 : r, Kk = kv ? 4096 : 6144;
                const float* pe = F.in[kv ? I_PEV : I_PEK] + (size_t)l * Kk + ch * 64; const float* w1 = F.in[kv ? I_W1V : I_W1K] + ((size_t)l * Kk + ch * 64) * 256;
                const int c = F.tid & 255, hf = F.tid >> 8; float sacc = 0.f;
#pragma unroll 8
                for (int k = hf * 32; k < hf * 32 + 32; ++k) sacc += pe[k] * w1[(size_t)k * 256 + c];
                LAS float* red = (LAS float*)(F.lds + 65536);
                __syncthreads();
                if (hf) red[c] = sacc;
                __syncthreads();
                if (!hf) pp[((size_t)(l * 2 + kv) * 96 + ch) * 256 + c] = sacc + red[c];
            }
        }
    }
}
__device__ __forceinline__ void pe_bias_reduce(Frame& F) {
    const float* pp = (const float*)(F.ws + WS_TBL + 32768);
    for (int u = F.cu; u < NL * 2; u += F.G) if (F.tid < 256) {
        const int kv = u & 1, nch = kv ? 64 : 96; float s = 0.f;
        for (int ch = 0; ch < nch; ++ch) s += pp[((size_t)u * 96 + ch) * 256 + F.tid];
        ((float*)(F.ws + WS_TBL + 8192))[u * 256 + F.tid] = s;
    }
}

__device__ __forceinline__ void thin_first_norm(Frame& F, const float* g) {
    const int gw = F.cu * 8 + F.wave, NGW = F.G * 8;
    const float* X = (const float*)(F.ws + WS_X); bf16_t* U = (bf16_t*)(F.ws + WS_U);
    for (int m = gw; m < M; m += NGW) {
        const f32x4* xr = (const f32x4*)(X + (size_t)m * D) + F.lane; f32x4 v[8]; float s = 0.f;
#pragma unroll
        for (int j = 0; j < 8; ++j) { v[j] = xr[64 * j]; s += (v[j].x * v[j].x + v[j].y * v[j].y) + (v[j].z * v[j].z + v[j].w * v[j].w); }
        const float r = 1.0f / sqrtf(wave_sum(s) * (1.f / D) + EPS);
        u32x2* o = (u32x2*)(U + (size_t)m * D) + F.lane;
#pragma unroll
        for (int j = 0; j < 8; ++j) { const f32x4 gg = ((const f32x4*)g)[F.lane + 64 * j]; o[64 * j] = (u32x2){cvtpk(v[j].x * r * gg.x, v[j].y * r * gg.y), cvtpk(v[j].z * r * gg.z, v[j].w * r * gg.w)}; }
    }
}
__device__ __forceinline__ void thin_post_norm(Frame& F, float coef, const float* gpost, const float* gpre, float* outp) {
    const int gw = F.cu * 8 + F.wave, NGW = F.G * 8;
    float* X = (float*)(F.ws + WS_X); bf16_t* U = (bf16_t*)(F.ws + WS_U); const bf16_t* Y = (const bf16_t*)(F.ws + WS_Y);
    for (int m = gw; m < M; m += NGW) {
        f32x4* xr = (f32x4*)(X + (size_t)m * D) + F.lane; const u32x2* yr = (const u32x2*)(Y + (size_t)m * D) + F.lane;
        f32x4 y[8]; float s = 0.f;
#pragma unroll
        for (int j = 0; j < 8; ++j) { const u32x2 w = yr[64 * j]; y[j] = (f32x4){bflo(w.x), bfhi(w.x), bflo(w.y), bfhi(w.y)}; s += (y[j].x * y[j].x + y[j].y * y[j].y) + (y[j].z * y[j].z + y[j].w * y[j].w); }
        const float r = coef / sqrtf(wave_sum(s) * (1.f / D) + EPS);
        float s2 = 0.f;
#pragma unroll
        for (int j = 0; j < 8; ++j) { const f32x4 gg = ((const f32x4*)gpost)[F.lane + 64 * j]; f32x4 x = xr[64 * j];
            x.x += y[j].x * r * gg.x; x.y += y[j].y * r * gg.y; x.z += y[j].z * r * gg.z; x.w += y[j].w * r * gg.w; y[j] = x;
            s2 += (x.x * x.x + x.y * x.y) + (x.z * x.z + x.w * x.w);
            if (outp) ((f32x4*)(outp + (size_t)m * D))[F.lane + 64 * j] = x; else xr[64 * j] = x; }
        if (gpre) {
            const float r2 = 1.0f / sqrtf(wave_sum(s2) * (1.f / D) + EPS);
            u32x2* o = (u32x2*)(U + (size_t)m * D) + F.lane;
#pragma unroll
            for (int j = 0; j < 8; ++j) { const f32x4 gg = ((const f32x4*)gpre)[F.lane + 64 * j]; o[64 * j] = (u32x2){cvtpk(y[j].x * r2 * gg.x, y[j].y * r2 * gg.y), cvtpk(y[j].z * r2 * gg.z, y[j].w * r2 * gg.w)}; }
        }
    }
}
__device__ __forceinline__ void thin_mix(Frame& F, const float* gq, const float* gkv) {
    const int gw = F.cu * 8 + F.wave, NGW = F.G * 8;
    const bf16_t* Z = (const bf16_t*)(F.ws + WS_Z); bf16_t* C = (bf16_t*)(F.ws + WS_CQKV); bf16_t* KPE = (bf16_t*)(F.ws + WS_KPE); const f32x2* rope = (const f32x2*)(F.ws + WS_ROPE);
    for (int m = gw; m < M; m += NGW) {
        const bf16_t* zr = Z + (size_t)m * DINP;
#pragma unroll
        for (int part = 0; part < 2; ++part) {
            const u32x4 w = *((const u32x4*)(zr + part * 512) + F.lane);
            float v[8] = {bflo(w.x), bfhi(w.x), bflo(w.y), bfhi(w.y), bflo(w.z), bfhi(w.z), bflo(w.w), bfhi(w.w)}; float s = 0.f;
#pragma unroll
            for (int e = 0; e < 8; ++e) s += v[e] * v[e];
            const float r = 1.0f / sqrtf(wave_sum(s) * (1.f / 512.f) + EPS);
            const float* g = (part ? gkv : gq) + 8 * F.lane; const f32x4 g0 = *(const f32x4*)g, g1 = *(const f32x4*)(g + 4);
            u32x4 o; o.x = cvtpk(v[0] * r * g0.x, v[1] * r * g0.y); o.y = cvtpk(v[2] * r * g0.z, v[3] * r * g0.w); o.z = cvtpk(v[4] * r * g1.x, v[5] * r * g1.y); o.w = cvtpk(v[6] * r * g1.z, v[7] * r * g1.w);
            *((u32x4*)(C + (size_t)m * 1024 + part * 512) + F.lane) = o;
        }
        if (F.lane < 32) {
            const float x1 = bf1(zr[ZO_KR + F.lane]), x2 = bf1(zr[ZO_KR + 32 + F.lane]); const f32x2 cs = rope[(size_t)m * 32 + F.lane];
            const unsigned a = cvtpk(x1 * cs.x - x2 * cs.y, x1 * cs.y + x2 * cs.x);
            KPE[(size_t)m * 64 + F.lane] = (bf16_t)(a & 0xffffu); KPE[(size_t)m * 64 + 32 + F.lane] = (bf16_t)(a >> 16);
        }
    }
}
__device__ __forceinline__ void cmp_stage2_unit(Frame& F, int unit, int l) {
    const int kv = unit >> 6, u = unit & 63, g = u >> 5, r0 = (u & 31) * 16;
    const int NO = kv ? 128 : 192;
    const float* part = (const float*)(F.ws + WS_PART); const float* pb = (const float*)(F.ws + WS_TBL + 8192) + (l * 2 + kv) * 256;
    const float* w2 = F.in[kv ? I_W2V : I_W2K] + (size_t)l * 256 * NO;
    LAS float* hidT = (LAS float*)F.lds;
    __syncthreads();
    {
        const int row = F.tid >> 5, c0 = (F.tid & 31) * 8, rp = r0 + row, rt = rp >> 8, rr = rp & 255;
        f32x4 s0 = *(const f32x4*)(pb + c0), s1 = *(const f32x4*)(pb + c0 + 4);
#pragma unroll
        for (int s = 0; s < 8; ++s) { const float* p = part + (size_t)((((kv * 2 + g) * 2 + rt) * 8) + s) * 65536 + (size_t)rr * 256 + c0; s0 += *(const f32x4*)p; s1 += *(const f32x4*)(p + 4); }
        float h[8] = {s0.x, s0.y, s0.z, s0.w, s1.x, s1.y, s1.z, s1.w};
#pragma unroll
        for (int e = 0; e < 8; ++e) hidT[(c0 + e) * 16 + row] = h[e] * sigmoidf_(h[e]);
    }
    __syncthreads();
    const int n = F.tid & 255, rg = F.tid >> 8;
    if (n < NO) {
        float a[8] = {0.f, 0.f, 0.f, 0.f, 0.f, 0.f, 0.f, 0.f};
#pragma unroll 4
        for (int c = 0; c < 256; ++c) { const float wv = w2[c * NO + n]; const f32x4 h0 = *(const LAS f32x4*)(hidT + c * 16 + rg * 8), h1 = *(const LAS f32x4*)(hidT + c * 16 + rg * 8 + 4);
            a[0] += h0.x * wv; a[1] += h0.y * wv; a[2] += h0.z * wv; a[3] += h0.w * wv; a[4] += h1.x * wv; a[5] += h1.y * wv; a[6] += h1.z * wv; a[7] += h1.w * wv; }
        bf16_t* dst = (bf16_t*)(F.ws + WS_KC + (kv ? 524288 : 0));
#pragma unroll
        for (int e = 0; e < 8; ++e) { const int rp = r0 + rg * 8 + e, b = rp >> 7, nn = rp & 127; dst[(size_t)((b * 2 + g) * 128 + nn) * NO + n] = (bf16_t)(cvtpk(a[e], 0.f) & 0xffffu); }
    }
}
template <bool ROPE>
__device__ __forceinline__ void load_q(Frame& F, const bf16_t* qp, float scale, LAS float* qs, const f32x2* rope_row) {
    if (F.lane < 24) { const u32x4 w = *((const u32x4*)qp + F.lane); LAS float* d = qs + 8 * F.lane;
        d[0] = bflo(w.x) * scale; d[1] = bfhi(w.x) * scale; d[2] = bflo(w.y) * scale; d[3] = bfhi(w.y) * scale; d[4] = bflo(w.z) * scale; d[5] = bfhi(w.z) * scale; d[6] = bflo(w.w) * scale; d[7] = bfhi(w.w) * scale; }
    if (ROPE) { if (F.lane < 32) { const float x1 = qs[128 + F.lane], x2 = qs[160 + F.lane]; const f32x2 cs = rope_row[F.lane]; qs[128 + F.lane] = x1 * cs.x - x2 * cs.y; qs[160 + F.lane] = x1 * cs.y + x2 * cs.x; } }
}
__device__ __forceinline__ float dot8(const u32x4 w, const LAS float* q) {
    const f32x4 a = *(const LAS f32x4*)q, b = *(const LAS f32x4*)(q + 4);
    return (bflo(w.x) * a.x + bfhi(w.x) * a.y) + (bflo(w.y) * a.z + bfhi(w.y) * a.w) + (bflo(w.z) * b.x + bfhi(w.z) * b.y) + (bflo(w.w) * b.z + bfhi(w.w) * b.w);
}
template <int MODE>
__device__ __forceinline__ void naive_row(Frame& F, int b, int t, int head, float gate, float& o0, float& o1, LAS float* sc, const LAS float* qs, unsigned selmask, int& nk_out) {
    const int g = head >> 2; const size_t mb = (size_t)b * SEQ;
    const bf16_t* Z = (const bf16_t*)(F.ws + WS_Z); const bf16_t* KV = (const bf16_t*)(F.ws + WS_KV); const bf16_t* KPE = (const bf16_t*)(F.ws + WS_KPE);
    const bf16_t* KC = (const bf16_t*)(F.ws + WS_KC); const bf16_t* VC = (const bf16_t*)(F.ws + WS_KC + 524288);
    const float* tbl = (const float*)(F.ws + WS_TBL) + head * 132; const int* pos = (const int*)F.in[I_POS] + mb;
    const int k0 = (MODE == 2) ? (t > 511 ? t - 511 : 0) : 0;
    const int k1 = (MODE == 3) ? (t < 31 ? -1 : (t - 31) / 16) : t;
    nk_out = k1 - k0 + 1;
    if (k1 < k0) return;
    const int qpos = (MODE != 0) ? pos[t] : 0;
    float mx = -INFINITY;
    for (int kb = k0; kb <= k1; kb += 64) {
        const int k = kb + F.lane; bool valid = k <= k1;
        if (MODE == 1) valid = valid && ((selmask >> (k >> 6)) & 1u);
        float s = -INFINITY;
        if (valid) {
            const bf16_t* p1; const bf16_t* p2;
            if (MODE == 0) { p1 = KV + (mb + k) * 2048 + head * 128; p2 = KPE + (mb + k) * 64; }
            else if (MODE == 1) { p1 = Z + (mb + k) * DINP + ZO_KS + g * 192; p2 = p1 + 128; }
            else if (MODE == 2) { p1 = Z + (mb + k) * DINP + ZO_KW + g * 192; p2 = p1 + 128; }
            else { p1 = KC + (size_t)((b * 2 + g) * 128 + k) * 192; p2 = p1 + 128; }
            float d = 0.f;
#pragma unroll
            for (int c = 0; c < 16; ++c) d += dot8(*((const u32x4*)p1 + c), qs + 8 * c);
#pragma unroll
            for (int c = 0; c < 8; ++c) d += dot8(*((const u32x4*)p2 + c), qs + 128 + 8 * c);
            if (MODE != 0) { const int kp = (MODE == 3) ? pos[16 * k + 31] : pos[k]; int dd = qpos - kp; dd = dd < 0 ? 0 : (dd > 128 ? 128 : dd); d += tbl[dd]; }
            s = d;
        }
        if (k <= k1) sc[k - k0] = s;
        mx = fmaxf(mx, s);
    }
    mx = wave_max(mx);
    float sum = 0.f;
    for (int kb = k0; kb <= k1; kb += 64) { const int k = kb + F.lane; if (k <= k1) { const float p = __expf(sc[k - k0] - mx); sc[k - k0] = p; sum += p; } }
    sum = wave_sum(sum);
    const float inv = 1.0f / sum;
    float a0 = 0.f, a1 = 0.f;
    for (int k = k0; k <= k1; ++k) {
        if (MODE == 1) { if (!((selmask >> (k >> 6)) & 1u)) { k |= 63; continue; } }
        const float p = sc[k - k0];
        const bf16_t* vp;
        if (MODE == 0) vp = KV + (mb + k) * 2048 + 1024 + head * 128;
        else if (MODE == 1) vp = Z + (mb + k) * DINP + ZO_VS + g * 128;
        else if (MODE == 2) vp = Z + (mb + k) * DINP + ZO_VW + g * 128;
        else vp = VC + (size_t)((b * 2 + g) * 128 + k) * 128;
        const unsigned w = *((const unsigned*)vp + F.lane);
        a0 += p * bflo(w); a1 += p * bfhi(w);
    }
    o0 += gate * inv * a0; o1 += gate * inv * a1;
    if (MODE == 3) { for (int kb = 0; kb <= k1; kb += 64) { const int k = kb + F.lane; if (k <= k1) sc[k] *= inv; } }
}
__device__ __forceinline__ void naive_cmp_phase(Frame& F) {
    const int gw = F.cu * 8 + F.wave, NGW = F.G * 8;
    LAS float* sc = (LAS float*)(F.lds + F.wave * 8192); LAS float* qs = (LAS float*)(F.lds + 65536 + F.wave * 1024); LAS float* ps = (LAS float*)(F.lds + 65536 + 8192 + F.wave * 512);
    const bf16_t* Z = (const bf16_t*)(F.ws + WS_Z); float* OC = (float*)(F.ws + WS_OC); unsigned* SEL = (unsigned*)(F.ws + WS_SEL);
    for (int r = gw; r < M * 2; r += NGW) {
        const int g = r & 1, m = r >> 1, b = m / SEQ, t = m % SEQ;
        ps[F.lane] = 0.f; ps[F.lane + 64] = 0.f;
        for (int j = 0; j < 4; ++j) {
            const int head = g * 4 + j; int nk = 0;
            load_q<false>(F, Z + (size_t)m * DINP + ZO_NQ + head * 192, 0.07216878364870322f, qs, nullptr);
            float o0 = 0.f, o1 = 0.f;
            const float g0 = sigmoidf_(bf1(Z[(size_t)m * DINP + ZO_NG + head * 3 + 0]));
            naive_row<3>(F, b, t, head, g0, o0, o1, sc, qs, 0u, nk);
            *(f32x2*)(OC + (size_t)m * 1024 + head * 128 + 2 * F.lane) = (f32x2){o0, o1};
            if (F.lane < nk) ps[F.lane] += sc[F.lane];
            if (F.lane + 64 < nk) ps[F.lane + 64] += sc[F.lane + 64];
        }
        const int mm = F.lane & 31; float imp = 0.f;
#pragma unroll
        for (int n = -1; n < 4; ++n) { const int nn = 4 * mm + n; if (nn >= 0 && nn < 128) imp += ps[nn]; }
        const int cur = t >> 6; const bool valid = mm <= cur, forced = valid && (mm == 0 || mm >= cur - 1);
        const float scv = forced ? 1e6f : (valid ? imp : -1.0f);
        int rank = 0;
#pragma unroll
        for (int o = 0; o < 32; ++o) { const float v = __shfl(scv, o); rank += (v > scv || (v == scv && o < mm)) ? 1 : 0; }
        const bool sel = (rank < 16) && (scv >= 0.f) && (F.lane < 32);
        const unsigned long long bal = __ballot(sel);
        if (F.lane == 0) SEL[(size_t)(b * 2 + g) * SEQ + t] = (unsigned)bal;
    }
}
__device__ __forceinline__ void naive_attn_phase(Frame& F) {
    const int gw = F.cu * 8 + F.wave, NGW = F.G * 8;
    LAS float* sc = (LAS float*)(F.lds + F.wave * 8192); LAS float* qs = (LAS float*)(F.lds + 65536 + F.wave * 1024);
    const bf16_t* Z = (const bf16_t*)(F.ws + WS_Z); const bf16_t* QM = (const bf16_t*)(F.ws + WS_QM); bf16_t* AB = (bf16_t*)(F.ws + WS_AB);
    const float* OC = (const float*)(F.ws + WS_OC); const unsigned* SEL = (const unsigned*)(F.ws + WS_SEL); const f32x2* rope = (const f32x2*)(F.ws + WS_ROPE);
    for (int r = gw; r < M * 8; r += NGW) {
        const int head = r & 7, m = r >> 3, b = m / SEQ, t = m % SEQ; int nk;
        load_q<true>(F, QM + (size_t)m * 1536 + head * 192, 0.07216878364870322f, qs, rope + (size_t)m * 32);
        float o0 = 0.f, o1 = 0.f;
        naive_row<0>(F, b, t, head, 1.0f, o0, o1, sc, qs, 0u, nk);
        *((unsigned*)(AB + (size_t)m * 2048 + head * 128) + F.lane) = cvtpk(o0, o1);
    }
    for (int r = gw; r < M * 8; r += NGW) {
        const int head = r & 7, m = r >> 3, b = m / SEQ, t = m % SEQ, g = head >> 2; int nk;
        const unsigned selmask = (unsigned)__builtin_amdgcn_readfirstlane((int)SEL[(size_t)(b * 2 + g) * SEQ + t]);
        load_q<false>(F, Z + (size_t)m * DINP + ZO_NQ + head * 192, 0.07216878364870322f, qs, nullptr);
        const float g1 = sigmoidf_(bf1(Z[(size_t)m * DINP + ZO_NG + head * 3 + 1])), g2 = sigmoidf_(bf1(Z[(size_t)m * DINP + ZO_NG + head * 3 + 2]));
        const f32x2 oc = *(const f32x2*)(OC + (size_t)m * 1024 + head * 128 + 2 * F.lane);
        float o0 = oc.x, o1 = oc.y;
        naive_row<1>(F, b, t, head, g1, o0, o1, sc, qs, selmask, nk);
        naive_row<2>(F, b, t, head, g2, o0, o1, sc, qs, 0u, nk);
        *((unsigned*)(AB + (size_t)m * 2048 + 1024 + head * 128) + F.lane) = cvtpk(o0, o1);
    }
}

namespace att {
typedef float f32x16 __attribute__((ext_vector_type(16)));
typedef short s16x4 __attribute__((ext_vector_type(4)));
typedef int i32x4 __attribute__((ext_vector_type(4)));
constexpr int KROW = 400, KBUF = 64 * KROW, VBUF = 64 * 256;
constexpr int L_K = 0, L_V = 2 * KBUF, L_KPOS = L_V + 2 * VBUF, L_KPMAX = L_KPOS + 512, L_TBL = L_KPMAX + 64, L_MISC = L_TBL + 8 * 132 * 4;
static_assert(L_MISC + 256 <= RING_BYTES, "attention LDS map");
constexpr float SL = 0.07216878364870322f * 1.4426950408889634f;
__device__ const unsigned char CLS_TYPE[40] = {1,1,1,1,1,1,1,1,1,0,1,1,1,1,0,1,1,1,1,0,1,1,1,1,0,1,1,1,0,1,1,0,1,1,0,1,1,0,1,1};
__device__ const unsigned char CLS_QB[40] = {31,30,29,28,27,26,25,24,23,7,22,21,20,19,6,18,17,16,15,5,14,13,12,11,4,10,9,8,3,7,6,2,5,4,1,3,2,0,1,0};
__device__ const unsigned short CLS_START[41] = {0,8,16,24,32,40,48,56,64,72,104,112,120,128,136,168,176,184,192,200,232,240,248,256,264,296,304,312,320,352,360,368,400,408,416,448,456,464,496,504,512};
__device__ __forceinline__ unsigned offb(unsigned row, unsigned ch) { return 256u * row + 16u * (ch ^ (((row & 3u) << 2) | ((row >> 2) & 3u))); }
struct Src { const bf16_t* k1; const bf16_t* k2; const bf16_t* v; int ldk1, ldk2, ldv; };
struct Stage { u32x4 k[3]; u32x4 v[2]; int kp; };
template <bool SAMELD = true>
__device__ __forceinline__ void stage_load(Stage& st, const Src& s, int tile, int tid, const int* posb) {
    const unsigned vo1 = (unsigned)((tid >> 4) * s.ldk1 + (tid & 15) * 8) * 2u, vo2 = (unsigned)((tid >> 3) * s.ldk2 + (tid & 7) * 8) * 2u;
    const char* b1 = (const char*)s.k1 + (size_t)tile * 64 * s.ldk1 * 2; const char* b2 = (const char*)s.k2 + (size_t)tile * 64 * s.ldk2 * 2; const char* bv = (const char*)s.v + (size_t)tile * 64 * s.ldv * 2;
    st.k[0] = *(const u32x4*)(b1 + vo1); st.k[1] = *(const u32x4*)(b1 + (size_t)32 * s.ldk1 * 2 + vo1); st.k[2] = *(const u32x4*)(b2 + vo2);
    const unsigned vov = SAMELD ? vo1 : (unsigned)((tid >> 4) * s.ldv + (tid & 15) * 8) * 2u;
    st.v[0] = *(const u32x4*)(bv + vov); st.v[1] = *(const u32x4*)(bv + (size_t)32 * s.ldv * 2 + vov);
    if (posb != nullptr && tid < 64) st.kp = posb[tile * 64 + tid];
}
__device__ __forceinline__ void stage_store(const Stage& st, LAS unsigned char* lds, int buf, int tid, bool haspos) {
    const int rowA = tid >> 4, chA = tid & 15;
    LAS unsigned char* ka = lds + L_K + buf * KBUF + rowA * KROW + chA * 16;
    *(LAS u32x4*)ka = st.k[0]; *(LAS u32x4*)(ka + 32 * KROW) = st.k[1];
    *(LAS u32x4*)(lds + L_K + buf * KBUF + (tid >> 3) * KROW + (16 + (tid & 7)) * 16) = st.k[2];
    LAS unsigned char* va = lds + L_V + buf * VBUF + offb(rowA, chA);
    *(LAS u32x4*)va = st.v[0]; *(LAS u32x4*)(va + 8192) = st.v[1];
    if (haspos && tid < 64) { ((LAS int*)(lds + L_KPOS))[buf * 64 + tid] = st.kp; int mx = st.kp;
#pragma unroll
        for (int o = 1; o < 64; o <<= 1) { const int t = __shfl_xor(mx, o); mx = t > mx ? t : mx; }
        if (tid == 0) ((LAS int*)(lds + L_KPMAX))[buf] = mx; }
}
__device__ __forceinline__ s16x4 vtr(const LAS unsigned char* p) { typedef short v4i16_t __attribute__((ext_vector_type(4))); return __builtin_bit_cast(s16x4, __builtin_amdgcn_ds_read_tr16_b64_v4i16((LAS v4i16_t*)p)); }

__device__ __forceinline__ unsigned vtr_off(int lane_, int c, int tp) {
    const unsigned q4 = (lane_ & 15) >> 2, p = lane_ & 3, blk = (lane_ >> 4) & 1, h2 = lane_ >> 5;
    return 256u * (8u * tp + 4u * h2 + q4) + 16u * ((((unsigned)c ^ q4) << 2) | ((2u * blk + (p >> 1)) ^ (2u * tp + h2))) + 8u * (p & 1u);
}
#define ATT_ZERO16 {0.f,0.f,0.f,0.f,0.f,0.f,0.f,0.f,0.f,0.f,0.f,0.f,0.f,0.f,0.f,0.f}
template <int MODE>
__device__ __forceinline__ void run_pass(Frame& F, const Src& src, unsigned tmask, const bf16x8 (&qf)[12], f32x16 (&oacc)[4], float& m_run, float& l_run,
                                         int tq, int tq_wmin, int tq_wmax, unsigned selq, int qpos, int qpos_wmin, int head, const int* posb) {
    if (tmask == 0u) return;
    const int tid = F.tid, lane = F.lane, r = lane & 31, hh = lane >> 5;
    LAS unsigned char* lds = F.lds;
    int tile = __builtin_ctz(tmask); unsigned rem = tmask & (tmask - 1u);
    Stage st; st.kp = 0;
    stage_load(st, src, tile, tid, posb); stage_store(st, lds, 0, tid, posb != nullptr); __syncthreads();
    int buf = 0;
    const LAS float* tblh = (const LAS float*)(lds + L_TBL) + head * 132;
    for (;;) {
        const int nxt = rem ? __builtin_ctz(rem) : -1;
        if (nxt >= 0) stage_load(st, src, nxt, tid, posb);
        const bool active = (MODE != 0) || (tile * 64 <= tq_wmax);
        if (active) {
            const LAS unsigned char* kb_ = lds + L_K + buf * KBUF + r * KROW + 16 * hh;
            const LAS unsigned char* vbuf = lds + L_V + buf * VBUF;
            bool far = true; if (MODE != 0) { const int kpmax = __builtin_amdgcn_readfirstlane(((const LAS int*)(lds + L_KPMAX))[buf]); far = (qpos_wmin - kpmax >= 128); }
            int lim = tq - tile * 64 - 4 * hh;
            if (MODE == 1) { if (!((selq >> tile) & 1u)) lim = -1; }
            const bool need = (MODE == 1) || (MODE == 2) || (tile * 64 + 63 > tq_wmin);
#pragma unroll
            for (int kb = 0; kb < 2; ++kb) {
                f32x16 sa = ATT_ZERO16;
#pragma unroll
                for (int s = 0; s < 12; ++s) { const bf16x8 a0 = *(const LAS bf16x8*)(kb_ + kb * 32 * KROW + 32 * s); sa = __builtin_amdgcn_mfma_f32_32x32x16_bf16(a0, qf[s], sa, 0, 0, 0); }
                float x[16];
                if (MODE == 0) {
#pragma unroll
                    for (int i = 0; i < 16; ++i) x[i] = sa[i] * SL;
                } else if (far) { const float cb = tblh[128];
#pragma unroll
                    for (int i = 0; i < 16; ++i) x[i] = sa[i] * SL + cb;
                } else {
                    const LAS int* kp = (const LAS int*)(lds + L_KPOS) + buf * 64 + 4 * hh + 32 * kb;
#pragma unroll
                    for (int g4 = 0; g4 < 4; ++g4) { const i32x4 kv = *(const LAS i32x4*)(kp + 8 * g4);
#pragma unroll
                        for (int e = 0; e < 4; ++e) { int d = qpos - kv[e]; d = d < 0 ? 0 : (d > 128 ? 128 : d); x[4 * g4 + e] = sa[4 * g4 + e] * SL + tblh[d]; } }
                }
                if (need) {
#pragma unroll
                    for (int i = 0; i < 16; ++i) { const int ci = 32 * kb + 8 * (i >> 2) + (i & 3); if (ci > lim) x[i] = -INFINITY; if (MODE == 2) { if (ci <= lim - 512) x[i] = -INFINITY; } }
                }
                float ml = x[0];
#pragma unroll
                for (int i = 1; i < 16; ++i) ml = fmaxf(ml, x[i]);
                ml = fmaxf(ml, __shfl_xor(ml, 32));
                const float mnew = fmaxf(m_run, ml), alpha = __builtin_amdgcn_exp2f(m_run - mnew);
                m_run = mnew;
                float ps = 0.f;
#pragma unroll
                for (int i = 0; i < 16; ++i) { x[i] = __builtin_amdgcn_exp2f(x[i] - mnew); ps += x[i]; }
                l_run = l_run * alpha + ps;
                if (!__all(alpha == 1.0f)) {
#pragma unroll
                    for (int c = 0; c < 4; ++c) oacc[c] = oacc[c] * alpha;
                }
                bf16x8 pf[2];
#pragma unroll
                for (int k2 = 0; k2 < 2; ++k2) { u32x4 w; w.x = cvtpk(x[8 * k2 + 0], x[8 * k2 + 1]); w.y = cvtpk(x[8 * k2 + 2], x[8 * k2 + 3]); w.z = cvtpk(x[8 * k2 + 4], x[8 * k2 + 5]); w.w = cvtpk(x[8 * k2 + 6], x[8 * k2 + 7]); pf[k2] = __builtin_bit_cast(bf16x8, w); }
#pragma unroll
                for (int c = 0; c < 4; ++c) { int lane_ = lane; asm volatile("" : "+v"(lane_)); const unsigned v0 = vtr_off(lane_, c, 0), v1 = vtr_off(lane_, c, 1);
#pragma unroll
                    for (int k2 = 0; k2 < 2; ++k2) { const int ks = 2 * kb + k2; const s16x4 lo = vtr(vbuf + v0 + ks * 4096), hi = vtr(vbuf + v1 + ks * 4096);
                        const bf16x8 a = {lo[0], lo[1], lo[2], lo[3], hi[0], hi[1], hi[2], hi[3]};
                        oacc[c] = __builtin_amdgcn_mfma_f32_32x32x16_bf16(a, pf[k2], oacc[c], 0, 0, 0); } }
            }
        }
        if (nxt >= 0) stage_store(st, lds, buf ^ 1, tid, posb != nullptr);
        __syncthreads();
        if (nxt < 0) break;
        tile = nxt; rem &= rem - 1u; buf ^= 1;
    }
}
template <bool ROPE>
__device__ __forceinline__ void load_qfrags(bf16x8 (&qf)[12], const bf16_t* qrow, int hh, const f32x2* rope_row) {
#pragma unroll
    for (int s = 0; s < 12; ++s) qf[s] = *(const bf16x8*)(qrow + 16 * s + 8 * hh);
    if (ROPE) {
#pragma unroll
        for (int pr = 0; pr < 2; ++pr) {
            const int i0 = 16 * pr + 8 * hh; bf16x8 a = qf[8 + pr], b = qf[10 + pr];
#pragma unroll
            for (int j = 0; j < 8; ++j) { const f32x2 cs = rope_row[i0 + j]; const float x1 = bf1((bf16_t)a[j]), x2 = bf1((bf16_t)b[j]);
                const unsigned w = cvtpk(x1 * cs.x - x2 * cs.y, x1 * cs.y + x2 * cs.x); a[j] = (short)(w & 0xffffu); b[j] = (short)(w >> 16); }
            qf[8 + pr] = a; qf[10 + pr] = b;
        }
    }
}
__device__ __forceinline__ void mla_unit(Frame& F, int b, int h, int qb) {
    const int lane = F.lane, r = lane & 31, hh = lane >> 5, w = F.wave;
    const int t0 = 256 * qb, tq = t0 + 32 * w + r; const size_t m = (size_t)b * SEQ + tq;
    const bf16_t* KV = (const bf16_t*)(F.ws + WS_KV);
    Src src{KV + (size_t)b * SEQ * 2048 + h * 128, (const bf16_t*)(F.ws + WS_KPE) + (size_t)b * SEQ * 64, KV + (size_t)b * SEQ * 2048 + 1024 + h * 128, 2048, 64, 2048};
    bf16x8 qf[12]; load_qfrags<true>(qf, (const bf16_t*)(F.ws + WS_QM) + m * 1536 + h * 192, hh, (const f32x2*)(F.ws + WS_ROPE) + m * 32);
    f32x16 oacc[4] = {ATT_ZERO16, ATT_ZERO16, ATT_ZERO16, ATT_ZERO16}; float m_run = -1e30f, l_run = 0.f;
    const unsigned tmask = (qb == 7) ? 0xffffffffu : ((1u << (4 * qb + 4)) - 1u);
    run_pass<0>(F, src, tmask, qf, oacc, m_run, l_run, tq, t0 + 32 * w, t0 + 32 * w + 31, 0u, 0, 0, h, nullptr);
    const float inv = 1.0f / (l_run + __shfl_xor(l_run, 32));
    bf16_t* o = (bf16_t*)(F.ws + WS_AB) + m * 2048 + h * 128 + 4 * hh;
#pragma unroll
    for (int c = 0; c < 4; ++c)
#pragma unroll
        for (int g4 = 0; g4 < 4; ++g4) *(u32x2*)(o + 32 * c + 8 * g4) = (u32x2){cvtpk(oacc[c][4 * g4] * inv, oacc[c][4 * g4 + 1] * inv), cvtpk(oacc[c][4 * g4 + 2] * inv, oacc[c][4 * g4 + 3] * inv)};
}
__device__ __forceinline__ void nsa_unit(Frame& F, int b, int g, int qb) {
    const int lane = F.lane, r = lane & 31, hh = lane >> 5, w = F.wave, head = 4 * g + (w >> 1);
    const int t0 = 64 * qb, tq = t0 + 32 * (w & 1) + r; const size_t m = (size_t)b * SEQ + tq;
    const bf16_t* Zb = (const bf16_t*)(F.ws + WS_Z) + (size_t)b * SEQ * DINP; const bf16_t* zr = (const bf16_t*)(F.ws + WS_Z) + m * DINP;
    const unsigned* SELb = (const unsigned*)(F.ws + WS_SEL) + (size_t)(b * 2 + g) * SEQ; const int* posb = (const int*)F.in[I_POS] + (size_t)b * SEQ;
    LAS unsigned* misc = (LAS unsigned*)(F.lds + L_MISC);
    if (w == 0) { unsigned v = SELb[t0 + lane];
#pragma unroll
        for (int o = 1; o < 64; o <<= 1) v |= (unsigned)__shfl_xor((int)v, o);
        if (lane == 0) misc[4] = v; }
    const unsigned selq = SELb[tq]; const int qpos = posb[tq]; int qmin = qpos;
#pragma unroll
    for (int o = 1; o < 64; o <<= 1) { const int t = __shfl_xor(qmin, o); qmin = t < qmin ? t : qmin; }
    qmin = __builtin_amdgcn_readfirstlane(qmin);
    bf16x8 qf[12]; load_qfrags<false>(qf, zr + ZO_NQ + head * 192, hh, nullptr);
    __syncthreads();
    const unsigned causal = (qb == 31) ? 0xffffffffu : ((2u << qb) - 1u);
    const unsigned umask = (unsigned)__builtin_amdgcn_readfirstlane((int)misc[4]) & causal;
    const int wlo = qb > 8 ? qb - 8 : 0; const unsigned wmask = causal & ~((1u << wlo) - 1u);
    f32x16 oacc[4] = {ATT_ZERO16, ATT_ZERO16, ATT_ZERO16, ATT_ZERO16}; float m_run = -1e30f, l_run = 0.f;
    {
        Src src{Zb + ZO_KS + g * 192, Zb + ZO_KS + g * 192 + 128, Zb + ZO_VS + g * 128, DINP, DINP, DINP};
        run_pass<1>(F, src, umask, qf, oacc, m_run, l_run, tq, t0 + 32 * (w & 1), t0 + 32 * (w & 1) + 31, selq, qpos, qmin, head, posb);
        asm volatile("" ::: "memory");
        const size_t m1 = (size_t)b * SEQ + t0 + 32 * (w & 1) + (F.lane & 31);
        const float g1 = sigmoidf_(bf1(((const bf16_t*)(F.ws + WS_Z))[m1 * DINP + ZO_NG + head * 3 + 1]));
        bf16_t* o = (bf16_t*)(F.ws + WS_AB) + m1 * 2048 + 1024 + head * 128 + 4 * (F.lane >> 5); const float* oc = (const float*)(F.ws + WS_OC) + m1 * 1024 + head * 128 + 4 * (F.lane >> 5);
        const float inv = g1 / (l_run + __shfl_xor(l_run, 32));
#pragma unroll
        for (int c = 0; c < 4; ++c)
#pragma unroll
            for (int g4 = 0; g4 < 4; ++g4) { const f32x4 cv = *(const f32x4*)(oc + 32 * c + 8 * g4);
                *(u32x2*)(o + 32 * c + 8 * g4) = (u32x2){cvtpk(oacc[c][4 * g4] * inv + cv.x, oacc[c][4 * g4 + 1] * inv + cv.y), cvtpk(oacc[c][4 * g4 + 2] * inv + cv.z, oacc[c][4 * g4 + 3] * inv + cv.w)}; }
    }
#pragma unroll
    for (int c = 0; c < 4; ++c) oacc[c] = (f32x16)ATT_ZERO16;
    m_run = -1e30f; l_run = 0.f;
    {
        Src src{Zb + ZO_KW + g * 192, Zb + ZO_KW + g * 192 + 128, Zb + ZO_VW + g * 128, DINP, DINP, DINP};
        run_pass<2>(F, src, wmask, qf, oacc, m_run, l_run, tq, t0 + 32 * (w & 1), t0 + 32 * (w & 1) + 31, 0u, qpos, qmin, head, posb);
        asm volatile("" ::: "memory");
        const size_t m1 = (size_t)b * SEQ + t0 + 32 * (w & 1) + (F.lane & 31);
        const float g2 = sigmoidf_(bf1(((const bf16_t*)(F.ws + WS_Z))[m1 * DINP + ZO_NG + head * 3 + 2]));
        bf16_t* o = (bf16_t*)(F.ws + WS_AB) + m1 * 2048 + 1024 + head * 128 + 4 * (F.lane >> 5);
        const float inv = g2 / (l_run + __shfl_xor(l_run, 32));
#pragma unroll
        for (int c = 0; c < 4; ++c)
#pragma unroll
            for (int g4 = 0; g4 < 4; ++g4) { const u32x2 pv = *(const u32x2*)(o + 32 * c + 8 * g4);
                *(u32x2*)(o + 32 * c + 8 * g4) = (u32x2){cvtpk(oacc[c][4 * g4] * inv + bflo(pv.x), oacc[c][4 * g4 + 1] * inv + bfhi(pv.x)), cvtpk(oacc[c][4 * g4 + 2] * inv + bflo(pv.y), oacc[c][4 * g4 + 3] * inv + bfhi(pv.y))}; }
    }
}
__device__ __forceinline__ void cmp_unit(Frame& F, int b, int g, int qb) {
    const int tid = F.tid, lane = F.lane, r = lane & 31, hh = lane >> 5, w = F.wave;
    const int t0 = 256 * qb, tq = t0 + 32 * w + r; const size_t m = (size_t)b * SEQ + tq;
    LAS unsigned char* lds = F.lds;
    const int* posb = (const int*)F.in[I_POS] + (size_t)b * SEQ;
    {
        Src src{(const bf16_t*)(F.ws + WS_KC) + (size_t)(b * 2 + g) * 128 * 192, (const bf16_t*)(F.ws + WS_KC) + (size_t)(b * 2 + g) * 128 * 192 + 128, (const bf16_t*)(F.ws + WS_KC + 524288) + (size_t)(b * 2 + g) * 128 * 128, 192, 192, 128};
        Stage st; st.kp = 0;
        stage_load<false>(st, src, 0, tid, nullptr); stage_store(st, lds, 0, tid, false);
        stage_load<false>(st, src, 1, tid, nullptr); stage_store(st, lds, 1, tid, false);
        if (tid < 128) { int kt = 16 * tid + 31; kt = kt > SEQ - 1 ? SEQ - 1 : kt; ((LAS int*)(lds + L_KPOS))[tid] = posb[kt]; }
    }
    __syncthreads();
    const int qpos = posb[tq];
    const int nmax = tq >= 31 ? (tq - 31) >> 4 : -1;
    float imp[16];
#pragma unroll
    for (int i = 0; i < 16; ++i) imp[i] = 0.f;
    const LAS unsigned char* kb_ = lds + L_K + r * KROW + 16 * hh;
    const LAS unsigned char* vbuf = lds + L_V;
    const bf16_t* zr = (const bf16_t*)(F.ws + WS_Z) + m * DINP;
#pragma unroll 1
    for (int j = 0; j < 4; ++j) {
        const int head = 4 * g + j;
        const LAS float* tblh = (const LAS float*)(lds + L_TBL) + head * 132;
        bf16x8 qf[12]; load_qfrags<false>(qf, zr + ZO_NQ + head * 192, hh, nullptr);
        float m_run = -1e30f, l_run = 0.f;
#define CMP_SCORES(kb) \
                f32x16 sa = ATT_ZERO16; \
                _Pragma("unroll") for (int s = 0; s < 12; ++s) { const bf16x8 a0 = *(const LAS bf16x8*)(kb_ + (kb) * 32 * KROW + 32 * s); sa = __builtin_amdgcn_mfma_f32_32x32x16_bf16(a0, qf[s], sa, 0, 0, 0); } \
                float x[16]; \
                { const LAS int* kp = (const LAS int*)(lds + L_KPOS) + 4 * hh + 32 * (kb); int nm_ = nmax; asm volatile("" : "+v"(nm_)); const int lim = nm_ - 32 * (kb) - 4 * hh; \
                _Pragma("unroll") for (int g4 = 0; g4 < 4; ++g4) { const i32x4 kv = *(const LAS i32x4*)(kp + 8 * g4); \
                    _Pragma("unroll") for (int e = 0; e < 4; ++e) { int d = qpos - kv[e]; d = d < 0 ? 0 : (d > 128 ? 128 : d); const float v = sa[4 * g4 + e] * SL + tblh[d]; x[4 * g4 + e] = (8 * g4 + e > lim) ? -INFINITY : v; } } }
#pragma unroll
        for (int kb = 0; kb < 4; ++kb) {
            CMP_SCORES(kb)
            float ml = x[0];
#pragma unroll
            for (int i = 1; i < 16; ++i) ml = fmaxf(ml, x[i]);
            ml = fmaxf(ml, __shfl_xor(ml, 32));
            const float mnew = fmaxf(m_run, ml), alpha = __builtin_amdgcn_exp2f(m_run - mnew); m_run = mnew;
            float ps = 0.f;
#pragma unroll
            for (int i = 0; i < 16; ++i) ps += __builtin_amdgcn_exp2f(x[i] - mnew);
            l_run = l_run * alpha + ps;
            asm volatile("" ::: "memory");
        }
        const float lt = l_run + __shfl_xor(l_run, 32), inv = lt > 0.f ? 1.0f / lt : 0.f;
        f32x16 oacc[4] = {ATT_ZERO16, ATT_ZERO16, ATT_ZERO16, ATT_ZERO16};
        float carry = 0.f;
#pragma unroll
        for (int kb = 0; kb < 4; ++kb) {
            CMP_SCORES(kb)
#pragma unroll
            for (int i = 0; i < 16; ++i) x[i] = __builtin_amdgcn_exp2f(x[i] - m_run) * inv;
#pragma unroll
            for (int g4 = 0; g4 < 4; ++g4) { const float e3 = x[4 * g4 + 3], sw = __shfl_xor(e3, 32);
                imp[4 * kb + g4] += ((x[4 * g4] + x[4 * g4 + 1]) + (x[4 * g4 + 2] + e3)) + (hh ? sw : carry); carry = sw; }
            bf16x8 pf[2];
#pragma unroll
            for (int k2 = 0; k2 < 2; ++k2) { u32x4 wv; wv.x = cvtpk(x[8 * k2 + 0], x[8 * k2 + 1]); wv.y = cvtpk(x[8 * k2 + 2], x[8 * k2 + 3]); wv.z = cvtpk(x[8 * k2 + 4], x[8 * k2 + 5]); wv.w = cvtpk(x[8 * k2 + 6], x[8 * k2 + 7]); pf[k2] = __builtin_bit_cast(bf16x8, wv); }
#pragma unroll
            for (int c = 0; c < 4; ++c) { int lane_ = lane; asm volatile("" : "+v"(lane_)); const unsigned v0 = vtr_off(lane_, c, 0), v1 = vtr_off(lane_, c, 1);
#pragma unroll
                for (int k2 = 0; k2 < 2; ++k2) { const int ks = 2 * kb + k2; const s16x4 lo = vtr(vbuf + v0 + ks * 4096), hi = vtr(vbuf + v1 + ks * 4096);
                    const bf16x8 a = {lo[0], lo[1], lo[2], lo[3], hi[0], hi[1], hi[2], hi[3]};
                    oacc[c] = __builtin_amdgcn_mfma_f32_32x32x16_bf16(a, pf[k2], oacc[c], 0, 0, 0); } }
            asm volatile("" ::: "memory");
        }
#undef CMP_SCORES
        {
            const float g0 = sigmoidf_(bf1(zr[ZO_NG + head * 3 + 0]));
            float* oc = (float*)(F.ws + WS_OC) + m * 1024 + head * 128 + 4 * hh;
#pragma unroll
            for (int c = 0; c < 4; ++c)
#pragma unroll
                for (int g4 = 0; g4 < 4; ++g4) *(f32x4*)(oc + 32 * c + 8 * g4) = (f32x4){oacc[c][4 * g4] * g0, oacc[c][4 * g4 + 1] * g0, oacc[c][4 * g4 + 2] * g0, oacc[c][4 * g4 + 3] * g0};
        }
    }
    {
        LAS float* impl = (LAS float*)(lds + 90112);
#pragma unroll
        for (int i = 0; i < 4; ++i) *(LAS f32x4*)(impl + (w * 64 + lane) * 16 + 4 * i) = (f32x4){imp[4 * i], imp[4 * i + 1], imp[4 * i + 2], imp[4 * i + 3]};
        asm volatile("s_waitcnt lgkmcnt(0)" ::: "memory");
        int lane2 = F.tid & 63; asm volatile("" : "+v"(lane2));
        const int hh2 = lane2 >> 5;
        const int cur = (t0 + 32 * w + (lane2 & 31)) >> 6; float own[16], oth[16];
#pragma unroll
        for (int i = 0; i < 4; ++i) { const f32x4 a = *(const LAS f32x4*)(impl + (w * 64 + lane2) * 16 + 4 * i), c = *(const LAS f32x4*)(impl + (w * 64 + (lane2 ^ 32)) * 16 + 4 * i);
            own[4 * i] = a.x; own[4 * i + 1] = a.y; own[4 * i + 2] = a.z; own[4 * i + 3] = a.w; oth[4 * i] = c.x; oth[4 * i + 1] = c.y; oth[4 * i + 2] = c.z; oth[4 * i + 3] = c.w; }
#pragma unroll
        for (int i = 0; i < 16; ++i) { const int mo = 2 * i + hh2, mp = 2 * i + 1 - hh2; const bool vo = mo <= cur, fo = vo && (mo == 0 || mo >= cur - 1), vp = mp <= cur, fp = vp && (mp == 0 || mp >= cur - 1);
            own[i] = fo ? 1e6f : (vo ? own[i] : -1.0f); oth[i] = fp ? 1e6f : (vp ? oth[i] : -1.0f); }
        unsigned bits = 0u;
#pragma unroll
        for (int i = 0; i < 16; ++i) { const float v = own[i]; int rank = 0;
#pragma unroll
            for (int k = 0; k < 16; ++k) {
                if (k < i) rank += (own[k] >= v) ? 1 : 0; else if (k > i) rank += (own[k] > v) ? 1 : 0;
                if (k < i) rank += (oth[k] >= v) ? 1 : 0; else if (k > i) rank += (oth[k] > v) ? 1 : 0; else rank += hh2 ? ((oth[k] >= v) ? 1 : 0) : ((oth[k] > v) ? 1 : 0);
                asm volatile("" : "+v"(rank)); }
            if (rank < 16 && v >= 0.f) bits |= 1u << (2 * i + hh2); }
        bits |= (unsigned)__shfl_xor((int)bits, 32);
        if (hh2 == 0) ((unsigned*)(F.ws + WS_SEL))[(size_t)(b * 2 + g) * SEQ + t0 + 32 * w + (lane2 & 31)] = bits;
    }
    __syncthreads();
}
__device__ __forceinline__ void cmp_phase(Frame& F) {
    LAS float* tblL = (LAS float*)(F.lds + L_TBL); const float* tg = (const float*)(F.ws + WS_TBL + 16384);
    for (int i = F.tid; i < 8 * 132; i += 512) tblL[i] = tg[i];
    __syncthreads();
    for (int u = F.cu; u < 64; u += F.G) cmp_unit(F, u >> 4, (u >> 3) & 1, u & 7);
}
constexpr int CW_QUEUE = 8192;
__device__ __forceinline__ void attn_phase(Frame& F, int l, int qoff = 0) {
    LAS float* tblL = (LAS float*)(F.lds + L_TBL); const float* tg = (const float*)(F.ws + WS_TBL + 16384);
    for (int i = F.tid; i < 8 * 132; i += 512) tblL[i] = tg[i];
    LAS unsigned* misc = (LAS unsigned*)(F.lds + L_MISC);
    unsigned* qctr = (unsigned*)(F.ws + WS_CTL) + CW_QUEUE + 64 * l + qoff;
    __syncthreads();
    for (;;) {
        launder(F);
        if (F.tid == 0) misc[0] = __hip_atomic_fetch_add(qctr, 1u, __ATOMIC_RELAXED, __HIP_MEMORY_SCOPE_AGENT);
        __syncthreads();
        const int u = __builtin_amdgcn_readfirstlane((int)misc[0]);
        __syncthreads();
        if (u >= 256) break;
        mla_unit(F, (u & 31) >> 3, u & 7, 7 - (u >> 5));
    }
    for (;;) {
        launder(F);
        if (F.tid == 0) misc[0] = __hip_atomic_fetch_add(qctr + 16, 1u, __ATOMIC_RELAXED, __HIP_MEMORY_SCOPE_AGENT);
        __syncthreads();
        const int u = __builtin_amdgcn_readfirstlane((int)misc[0]);
        __syncthreads();
        if (u >= 256) break;
        nsa_unit(F, (u & 7) >> 1, u & 1, 31 - (u >> 3));
    }
}
}

struct SchedCmp {
    const char* Zb; const char* Wb; int c0, c, kv;
    __device__ bool next(int i, Unit& u) const {
        const int j = c - c0; if (i != 0 || j < 0 || j >= 32) return false;
        const int g = j >> 4, rt = (j >> 3) & 1, s = j & 7;
        u.a = Zb + ((size_t)(kv ? ZO_VC + 128 * g : ZO_KC + 192 * g) + (size_t)rt * 256 * 16 * DINP + (size_t)s * 4 * DINP) * 2;
        u.b = Wb + (size_t)s * (kv ? 8 : 12) * 64 * 2; u.pm = 0; u.pn = 0; u.aux = kv * 32 + j; return true;
    }
};
struct SchedQKV {
    const char* C; const char* WQ; const char* WUKV; int G, c;
    __device__ bool next(int i, Unit& u) const {
        int j = i * G + c; if (j >= 448) return false;
        if (j < 192) { u.aux = 0; u.pn = j / 32; u.pm = j % 32; u.a = C + (size_t)u.pm * 256 * 1024 * 2; u.b = WQ + (size_t)u.pn * 256 * 512 * 2; }
        else { j -= 192; u.aux = 1; u.pn = j / 32; u.pm = j % 32; u.a = C + ((size_t)u.pm * 256 * 1024 + 512) * 2; u.b = WUKV + (size_t)u.pn * 256 * 512 * 2; }
        return true;
    }
};
struct SchedMerge {
    const char* A; const char* W; int G, c;
    __device__ bool next(int i, Unit& u) const {
        const int ti = (i >> 1) * G + c, kh = i & 1; if (ti >= 256) return false;
        u.pm = ti % 32; u.pn = ti / 32; u.aux = kh;
        u.a = A + ((size_t)u.pm * 256 * 2048 + kh * 1024) * 2; u.b = W + ((size_t)u.pn * 256 * 2048 + kh * 1024) * 2; return true;
    }
};

constexpr int NPH = 2 + NL * 14;
__global__ void __launch_bounds__(512, 2) fwd(Args args) {
    extern __shared__ __attribute__((aligned(16))) unsigned char lds_raw[];
    Frame F;
    F.lds = (LAS unsigned char*)lds_raw; F.tid = threadIdx.x; F.lane = F.tid & 63; F.wave = __builtin_amdgcn_readfirstlane(F.tid >> 6); F.G = gridDim.x; F.cu = blockIdx.x;
    F.in = args.in; F.out = args.out; F.ws = args.ws;
    volatile LAS unsigned* MISC = (volatile LAS unsigned*)(F.lds + MISC_OFF);
    for (int u = F.tid; u < (LDS_BYTES - RING_BYTES) / 4; u += 512) ((LAS unsigned*)(F.lds + RING_BYTES))[u] = 0u;
    __syncthreads();
    unsigned* ctl = (unsigned*)(F.ws + WS_CTL);
    XcdBarrier bar; bar.bar = ctl + CW_BAR; bar.x = 0; bar.st = MISC + 8;
    if (!MK_PER_PHASE) bar = xcd_barrier_post(ctl + CW_BAR, MISC + 8);
    const int lo = args.ph_lo, hi = args.ph_hi; int pc = 0;
#define PH_IF launder(F); if (pc >= lo && pc < hi)
#define PH_END do { const bool both_ = (pc >= lo) && (pc + 1 < hi); ++pc; if (both_) xcd_barrier(bar); } while (0)
#define U ((bf16_t*)(F.ws + WS_U))
#define H ((bf16_t*)(F.ws + WS_H))
#define Y ((bf16_t*)(F.ws + WS_Y))
#define Z ((bf16_t*)(F.ws + WS_Z))
#define CQKV ((bf16_t*)(F.ws + WS_CQKV))
#define QM ((bf16_t*)(F.ws + WS_QM))
#define KV ((bf16_t*)(F.ws + WS_KV))
#define AB ((bf16_t*)(F.ws + WS_AB))
#define MG ((bf16_t*)(F.ws + WS_MG))
#define WL ((const bf16_t*)(F.ws + WS_W) + (size_t)l * WO_END)

    PH_IF { p0_prologue(F);
#if PROBE_DUP == 10
        __syncthreads(); p0_prologue(F);
#endif
    } PH_END;
    PH_IF { pe_bias_reduce(F); thin_first_norm(F, F.in[I_F1PRE]); } PH_END;
    for (int l = 0; l < NL; ++l) {
        for (int f = 0; f < 2; ++f) {
            PH_IF {
                Gemm g{D, D, D / 64, 0}; SchedStd S; S.init(U, D, WL + (f ? WO_GU2 : WO_GU1), D, M, 2 * FF, F.G, F.cu); EpiSwiGLU E{H, FF};
                pg8::gemm_phase<EpiSwiGLU, SchedStd, 0>(F.lds, g, S, E);
                cvt_filler(F, l, f ? FB_GU1 : FB_GU0, 128, FIL_GU);
#if PROBE_DUP == 1
                pg8::gemm_phase<EpiSwiGLU, SchedStd, 0>(F.lds, g, S, E);
#endif
            } PH_END;
            PH_IF {
                Gemm g{FF, FF, FF / 64, 0}; SchedStd S; S.init(H, FF, WL + (f ? WO_D2 : WO_D1), FF, M, D, F.G, F.cu); EpiBf16 E{Y, D};
                pg8::gemm_phase<EpiBf16, SchedStd, 0>(F.lds, g, S, E);
            } PH_END;
            PH_IF {
#if PROBE_DUP == 11
                thin_post_norm(F, 0.0f, F.in[I_F1POST] + (size_t)l * D, F.in[I_MPRE] + (size_t)l * D, nullptr); __syncthreads();
#endif
                if (f == 0) thin_post_norm(F, 0.5f, F.in[I_F1POST] + (size_t)l * D, F.in[I_MPRE] + (size_t)l * D, nullptr);
                else { thin_post_norm(F, 0.5f, F.in[I_F2POST] + (size_t)l * D, (l + 1 < NL) ? F.in[I_F1PRE] + (size_t)(l + 1) * D : nullptr, (l + 1 < NL) ? nullptr : F.out); __syncthreads(); cvt_drain(F, l); }
            } PH_END;
            if (f == 0) {
                PH_IF {
                    Gemm g{D, D, D / 64, 0}; SchedStd S; S.init(U, D, WL + WO_IN, D, M, DINP, F.G, F.cu); EpiBf16 E{Z, DINP};
                    pg8::gemm_phase<EpiBf16, SchedStd, 0>(F.lds, g, S, E);
                    cvt_filler(F, l, FB_WIN, 64, FIL_WIN);
                } PH_END;
                PH_IF {
                    thin_mix(F, F.in[I_QNG] + (size_t)l * 512, F.in[I_KVNG] + (size_t)l * 512);
                    __syncthreads();
                    EpiSlab E{(float*)(F.ws + WS_PART)};
                    { Gemm g{16 * DINP, 6144, 12, (size_t)DINP * 2}; SchedCmp S{(const char*)Z, (const char*)(WL + WO_1K), 0, F.cu, 0}; pg8::gemm_phase<EpiSlab, SchedCmp, 3>(F.lds, g, S, E); }
                    { Gemm g{16 * DINP, 4096, 8, (size_t)DINP * 2}; SchedCmp S{(const char*)Z, (const char*)(WL + WO_1V), 32, F.cu, 1}; pg8::gemm_phase<EpiSlab, SchedCmp, 2>(F.lds, g, S, E); }
                    cvt_filler(F, l, FB_P6, 64, FIL_P6);
#if PROBE_DUP == 4
                    __syncthreads(); thin_mix(F, F.in[I_QNG] + (size_t)l * 512, F.in[I_KVNG] + (size_t)l * 512); __syncthreads();
                    { Gemm g{16 * DINP, 6144, 12, (size_t)DINP * 2}; SchedCmp S{(const char*)Z, (const char*)(WL + WO_1K), 64, F.cu, 0}; pg8::gemm_phase<EpiSlab, SchedCmp, 3>(F.lds, g, S, E); }
#endif
                } PH_END;
                PH_IF {
                    { Gemm g{1024, 512, 8, 0}; SchedQKV S{(const char*)CQKV, (const char*)(WL + WO_Q), (const char*)(WL + WO_UKV), F.G, F.cu}; EpiQKV E{QM, KV};
                      pg8::gemm_phase<EpiQKV, SchedQKV, 0>(F.lds, g, S, E); }
                    for (int u = F.G - 1 - F.cu; u < 128; u += F.G) cmp_stage2_unit(F, u, l);
#if PROBE_DUP == 5
                    __syncthreads();
                    { Gemm g{1024, 512, 8, 0}; SchedQKV S{(const char*)CQKV, (const char*)(WL + WO_Q), (const char*)(WL + WO_UKV), F.G, F.cu}; EpiQKV E{QM, KV};
                      pg8::gemm_phase<EpiQKV, SchedQKV, 0>(F.lds, g, S, E); }
                    for (int u = F.G - 1 - F.cu; u < 128; u += F.G) cmp_stage2_unit(F, u, l);
#endif
                } PH_END;
                PH_IF { att::cmp_phase(F); cvt_filler(F, l, FB_CMP, 64, FIL_CMP);
#if PROBE_DUP == 6
                __syncthreads(); att::cmp_phase(F);
#endif
                } PH_END;
                PH_IF { att::attn_phase(F, l);
#if PROBE_DUP == 7
                __syncthreads(); att::attn_phase(F, l, 32);
#endif
                } PH_END;
                PH_IF {
                    Gemm g{2048, 2048, 16, 0}; SchedMerge S{(const char*)AB, (const char*)(WL + WO_AB), F.G, F.cu}; EpiMerge E{Z, MG};
                    pg8::gemm_phase<EpiMerge, SchedMerge, 0>(F.lds, g, S, E);
                } PH_END;
                PH_IF {
                    Gemm g{2048, 2048, 32, 0}; SchedStd S; S.init(MG, 2048, WL + WO_OUT, 2048, M, D, F.G, F.cu); EpiBf16 E{Y, D};
                    pg8::gemm_phase<EpiBf16, SchedStd, 0>(F.lds, g, S, E);
                } PH_END;
                PH_IF { thin_post_norm(F, 1.0f, F.in[I_MPOST] + (size_t)l * D, F.in[I_F2PRE] + (size_t)l * D, nullptr); } PH_END;
            }
        }
    }
#undef PH_IF
#undef PH_END
#undef U
#undef H
#undef Y
#undef Z
#undef CQKV
#undef QM
#undef KV
#undef AB
#undef MG
#undef WL
}

extern "C" void kernel_launch(void* const* d_in, const int* in_sizes, int n_in, void* d_out, int out_size, void* d_ws, size_t ws_size, hipStream_t stream) {
    static int grid = 0;
    if (grid == 0) {
        if (n_in != 30 || in_sizes[0] != M * D || out_size != M * D || ws_size < WS_END) { fprintf(stderr, "kernel_launch: unexpected shapes / workspace (n_in %d, ws %zu < %zu)\n", n_in, ws_size, (size_t)WS_END); grid = -1; return; }
        int dev = 0, cus = 0, per_cu = 0;
        if (hipGetDevice(&dev) != hipSuccess || hipDeviceGetAttribute(&cus, hipDeviceAttributeMultiprocessorCount, dev) != hipSuccess) { grid = -1; return; }
        if (hipFuncSetAttribute((const void*)fwd, hipFuncAttributeMaxDynamicSharedMemorySize, LDS_BYTES) != hipSuccess) { fprintf(stderr, "kernel_launch: hipFuncSetAttribute failed\n"); grid = -1; return; }
        if (hipOccupancyMaxActiveBlocksPerMultiprocessor(&per_cu, (const void*)fwd, 512, LDS_BYTES) != hipSuccess || per_cu < 1) { fprintf(stderr, "kernel_launch: occupancy query says %d\n", per_cu); }
        (void)hipGetLastError();
        grid = cus;
    }
    if (grid < 0) return;
    (void)hipMemsetAsync((char*)d_ws + WS_CTL, 0, CTL_ZERO_BYTES, stream);
    Args a{};
    for (int i = 0; i < 30; ++i) a.in[i] = (const float*)d_in[i];
    a.out = (float*)d_out; a.ws = (unsigned char*)d_ws;
#if MK_PER_PHASE
    for (int p = 0; p < NPH; ++p) { a.ph_lo = p; a.ph_hi = p + 1; hipLaunchKernelGGL(fwd, dim3(grid), dim3(512), LDS_BYTES, stream, a); }
#else
    a.ph_lo = 0; a.ph_hi = NPH; hipLaunchKernelGGL(fwd, dim3(grid), dim3(512), LDS_BYTES, stream, a);
#endif
}
```
